# Optimizing an MI355X kernel written in HIP

```python
import math
import jax, jax.numpy as jnp
from jax import lax
import numpy as np

D_MODEL = 1024
BATCH = 16
SEQ = 4096
DEPTH = 4

ATTN_HEADS = 8
ATTN_HEAD_DIM = 64
ATTN_WIDTH = ATTN_HEADS * ATTN_HEAD_DIM
Q_BLOCK = 128
SSM_GROUPS = 32
SSM_GROUP_CH = 16
SSM_WIDTH = SSM_GROUPS * SSM_GROUP_CH
SSM_STATE = 64
D_FF = 4 * D_MODEL
N_IN = 3 * ATTN_WIDTH + ATTN_HEADS + SSM_WIDTH + 2 * D_MODEL
RMS_EPS = 1e-6
DT_MIN = 1e-3
DT_MAX = 1e-1

kernel_name = 'fox_s5_gated_hybrid_trunk'


def rmsnorm(x, g):
    xf = x.astype(jnp.float32)
    xf = xf * lax.rsqrt(jnp.mean(xf * xf, axis=-1, keepdims=True) + RMS_EPS)
    return (xf * g.astype(jnp.float32)).astype(x.dtype)


def forgetting_attention(q, k, v, log_f):
    seq = q.shape[2]
    scale = ATTN_HEAD_DIM ** -0.5
    cum = jnp.cumsum(log_f, axis=-1)
    outs = []
    for i in range(seq // Q_BLOCK):
        lo, hi = i * Q_BLOCK, (i + 1) * Q_BLOCK
        s = jnp.einsum('bhqd,bhkd->bhqk', q[:, :, lo:hi], k[:, :, :hi]).astype(jnp.float32) * scale
        s = s + cum[:, :, lo:hi, None] - cum[:, :, None, :hi]
        causal = (lo + jnp.arange(Q_BLOCK))[:, None] >= jnp.arange(hi)[None, :]
        p = jax.nn.softmax(jnp.where(causal, s, -jnp.inf), axis=-1)
        outs.append(jnp.einsum('bhqk,bhkd->bhqd', p.astype(v.dtype), v[:, :, :hi]))
    return jnp.concatenate(outs, axis=2)


def _linear_recurrence(e1, e2):
    a1, b1 = e1
    a2, b2 = e2
    return a1 * a2, a2 * b1 + b2


def s5_ssm(u, lam_re, lam_im, log_dt, b_re, b_im, c_re, c_im, d_skip):
    bsz, seq, _ = u.shape
    f32 = jnp.float32
    ug = u.astype(f32).reshape(bsz, seq, SSM_GROUPS, SSM_GROUP_CH)
    lam = lax.complex(lam_re.astype(f32), lam_im.astype(f32))
    dt = jnp.exp(log_dt.astype(f32))[:, None]
    lam_bar = jnp.exp(lam * dt)
    b_mat = lax.complex(b_re.astype(f32), b_im.astype(f32))
    b_bar = ((lam_bar - 1.0) / lam)[:, :, None] * b_mat
    bu = jnp.einsum('bsgc,gpc->bsgp', ug.astype(jnp.complex64), b_bar)
    a = jnp.broadcast_to(lam_bar[None, None], (1, seq, SSM_GROUPS, SSM_STATE))
    _, states = lax.associative_scan(_linear_recurrence, (a, bu), axis=1)
    c_mat = lax.complex(c_re.astype(f32), c_im.astype(f32))
    y = jnp.einsum('bsgp,gcp->bsgc', states, c_mat).real
    y = y + d_skip.astype(f32).reshape(SSM_GROUPS, SSM_GROUP_CH) * ug
    return y.reshape(bsz, seq, SSM_WIDTH).astype(u.dtype)


def hybrid_layer(x, norm_mix, w_in, b_forget, lam_re, lam_im, log_dt, b_re, b_im,
                 c_re, c_im, d_skip, w_glu, b_glu, w_branch_a, w_branch_b, w_out,
                 norm_mlp, w_mlp_up, w_mlp_down):
    bsz, seq, _ = x.shape
    h = rmsnorm(x, norm_mix)
    proj = h @ w_in
    o1 = ATTN_WIDTH
    o2 = o1 + ATTN_WIDTH
    o3 = o2 + ATTN_WIDTH
    o4 = o3 + ATTN_HEADS
    o5 = o4 + SSM_WIDTH
    o6 = o5 + D_MODEL
    q, k, v, f_logit, u, gate_a, gate_b = jnp.split(proj, [o1, o2, o3, o4, o5, o6], axis=-1)

    def heads(t):
        return t.reshape(bsz, seq, ATTN_HEADS, ATTN_HEAD_DIM).transpose(0, 2, 1, 3)
    log_f = jax.nn.log_sigmoid((f_logit + b_forget).astype(jnp.float32)).transpose(0, 2, 1)
    y_a = forgetting_attention(heads(q), heads(k), heads(v), log_f)
    y_a = y_a.transpose(0, 2, 1, 3).reshape(bsz, seq, ATTN_WIDTH)

    y_b = jax.nn.gelu(s5_ssm(u, lam_re, lam_im, log_dt, b_re, b_im, c_re, c_im, d_skip))
    y_b = y_b * jax.nn.sigmoid(y_b @ w_glu + b_glu)

    mixed = jax.nn.sigmoid(gate_a) * (y_a @ w_branch_a) + jax.nn.sigmoid(gate_b) * (y_b @ w_branch_b)
    x = x + mixed @ w_out

    h = rmsnorm(x, norm_mlp)
    x = x + jnp.square(jax.nn.relu(h @ w_mlp_up)) @ w_mlp_down
    return x


def setup_inputs(seed: int = 0) -> dict:
    key = jax.random.key(seed)
    ks = jax.random.split(key, 24)
    f32 = jnp.float32
    L, G, P, C = DEPTH, SSM_GROUPS, SSM_STATE, SSM_GROUP_CH

    def nrm(k, shape, scale):
        return jax.random.normal(k, shape, f32) * scale

    n_idx = jnp.arange(P, dtype=f32)
    return {
        'x': nrm(ks[0], (BATCH, SEQ, D_MODEL), 1.0),
        'norm_mix': 1.0 + nrm(ks[1], (L, D_MODEL), 0.02),
        'w_in': nrm(ks[2], (L, D_MODEL, N_IN), D_MODEL ** -0.5),
        'b_forget': jax.random.uniform(ks[3], (L, ATTN_HEADS), f32, 1.0, 5.0),
        'ssm_lambda_re': -0.5 + nrm(ks[4], (L, G, P), 0.01),
        'ssm_lambda_im': jnp.pi * n_idx + nrm(ks[5], (L, G, P), 0.01),
        'ssm_log_dt': jax.random.uniform(ks[6], (L, G), f32, math.log(DT_MIN), math.log(DT_MAX)),
        'ssm_b_re': nrm(ks[7], (L, G, P, C), (2 * C) ** -0.5),
        'ssm_b_im': nrm(ks[8], (L, G, P, C), (2 * C) ** -0.5),
        'ssm_c_re': nrm(ks[9], (L, G, C, P), P ** -0.5),
        'ssm_c_im': nrm(ks[10], (L, G, C, P), P ** -0.5),
        'ssm_d': nrm(ks[11], (L, SSM_WIDTH), 1.0),
        'w_glu': nrm(ks[12], (L, SSM_WIDTH, SSM_WIDTH), SSM_WIDTH ** -0.5),
        'b_glu': nrm(ks[13], (L, SSM_WIDTH), 0.01),
        'w_branch_a': nrm(ks[14], (L, ATTN_WIDTH, D_MODEL), ATTN_WIDTH ** -0.5),
        'w_branch_b': nrm(ks[15], (L, SSM_WIDTH, D_MODEL), SSM_WIDTH ** -0.5),
        'w_out': nrm(ks[16], (L, D_MODEL, D_MODEL), D_MODEL ** -0.5),
        'norm_mlp': 1.0 + nrm(ks[17], (L, D_MODEL), 0.02),
        'w_mlp_up': nrm(ks[18], (L, D_MODEL, D_FF), D_MODEL ** -0.5),
        'w_mlp_down': nrm(ks[19], (L, D_FF, D_MODEL), D_FF ** -0.5),
        'norm_final': 1.0 + nrm(ks[20], (D_MODEL,), 0.02),
    }


def reference(x, norm_mix, w_in, b_forget, ssm_lambda_re, ssm_lambda_im, ssm_log_dt,
              ssm_b_re, ssm_b_im, ssm_c_re, ssm_c_im, ssm_d, w_glu, b_glu,
              w_branch_a, w_branch_b, w_out, norm_mlp, w_mlp_up, w_mlp_down, norm_final):
    for l in range(DEPTH):
        x = hybrid_layer(x, norm_mix[l], w_in[l], b_forget[l], ssm_lambda_re[l], ssm_lambda_im[l],
                         ssm_log_dt[l], ssm_b_re[l], ssm_b_im[l], ssm_c_re[l], ssm_c_im[l],
                         ssm_d[l], w_glu[l], b_glu[l], w_branch_a[l], w_branch_b[l], w_out[l],
                         norm_mlp[l], w_mlp_up[l], w_mlp_down[l])
    return rmsnorm(x, norm_final)
```

```cpp
#include <hip/hip_runtime.h>
#include <hip/hip_cooperative_groups.h>
#include <cstdio>
#include <cstdint>
namespace pg8 {
#define PG8_LAS __attribute__((address_space(3)))
typedef unsigned short bf16_t;
typedef short bf16x8 __attribute__((ext_vector_type(8)));
typedef float f32x4 __attribute__((ext_vector_type(4)));
typedef unsigned u32x4 __attribute__((ext_vector_type(4)));
constexpr int BM = 256, BK = 64, HALF = 128, HTB = HALF * BK * 2  , STAGE_BYTES = 8 * HTB, NXCD = 8, WGM = 8;

__host__ __device__ __forceinline__ int lds_byte(int r, int c) { const int st = (r >> 4) * 2 + (c >> 5), rr = r & 15, cc = c & 31, ob = rr * 64 + cc * 2; return st * 1024 + (ob ^ (((ob >> 9) & 1) << 5)); }
__host__ __device__ __forceinline__ void stage_rc(int b, int& R, int& C) { const int st = b / 1024, sb = b % 1024, swz = sb ^ (((sb >> 9) & 1) << 5); R = (st >> 1) * 16 + swz / 64; C = (st & 1) * 32 + (swz % 64) / 2; }
__host__ __device__ __forceinline__ int perm32(int rho) { const int n = rho >> 4, i = rho & 15; return 8 * (i >> 2) + 4 * n + (i & 3); }

struct Unit { int pm, pn; };
struct Gemm { const bf16_t* A; const bf16_t* Bt; int M, N, K; };

struct StaticOrder {
    int nM, nN, nwg, G, c;
    __host__ __device__ void init(int M, int N, int G_, int c_) { nM = M / BM; nN = N / BM; nwg = nM * nN; G = G_; c = c_; }
    __host__ __device__ bool next(int i, Unit& u) const {
        const long L = (long)i * G + c; if (L >= nwg) return false;
        int wgid = (int)L; { const int q = nwg / NXCD, r = nwg % NXCD, xcd = wgid % NXCD, off = wgid / NXCD; wgid = (xcd < r ? xcd * (q + 1) : r * (q + 1) + (xcd - r) * q) + off; }
        const int nig = WGM * nN, gid = wgid / nig, fm = gid * WGM, gsz = (nM - fm) < WGM ? (nM - fm) : WGM;
        u.pm = fm + ((wgid % nig) % gsz); u.pn = (wgid % nig) / gsz; return true;
    }
    __device__ __forceinline__ void a_ready(const Unit&) const {}
    __device__ __forceinline__ void done(const Unit&) const {}
};

typedef float f32x2c_t __attribute__((ext_vector_type(2))); typedef __bf16 bf16x2c_t __attribute__((ext_vector_type(2)));
__device__ __forceinline__ unsigned cvt_pk_bf16(float lo, float hi) { f32x2c_t v = {lo, hi}; bf16x2c_t b = __builtin_convertvector(v, bf16x2c_t); return __builtin_bit_cast(unsigned, b); }
typedef float f32x2 __attribute__((ext_vector_type(2)));
__device__ __forceinline__ f32x2 gelu_pk(f32x2 v) {
    const f32x2 av = __builtin_elementwise_abs(v), d = av * 0.2316418882f + 1.0f;
    f32x2 t; t.x = __builtin_amdgcn_rcpf(d.x); t.y = __builtin_amdgcn_rcpf(d.y);
    f32x2 q = t * 0.5307027145f + (-0.7265760135f); q = q * t + 0.7107068705f; q = q * t + (-0.142248368f); q = q * t + 0.127414796f; q = q * t;
    const f32x2 s = (v * v) * (-0.72134752044f);
    f32x2 e; e.x = __builtin_amdgcn_exp2f(s.x); e.y = __builtin_amdgcn_exp2f(s.y);
    const f32x2 m = v * (q * e), r = v - m;
    f32x2 o; o.x = v.x < 0.f ? m.x : r.x; o.y = v.y < 0.f ? m.y : r.y; return o;
}

constexpr float LOG2E = 1.4426950408889634f;
constexpr float QC2 = 0.125f * 1.4426950408889634f;
__device__ __forceinline__ float sigm(float x) { return __builtin_amdgcn_rcpf(1.0f + __builtin_amdgcn_exp2f(-x * LOG2E)); }
__device__ __forceinline__ float gelu_tanh(float x) { const float z = 1.5957691216057308f * (x + 0.044715f * x * x * x); return x * sigm(z); }
__device__ __forceinline__ u32x4 pack8(const f32x4 v0, const f32x4 v1) { u32x4 w; w.x = cvt_pk_bf16(v0[0], v0[1]); w.y = cvt_pk_bf16(v0[2], v0[3]); w.z = cvt_pk_bf16(v1[0], v1[1]); w.w = cvt_pk_bf16(v1[2], v1[3]); return w; }
__device__ __forceinline__ float bf_lo(unsigned w) { return __uint_as_float(w << 16); }
__device__ __forceinline__ float bf_hi(unsigned w) { return __uint_as_float(w & 0xffff0000u); }
#define EPI_LOOP_BEGIN \
    _Pragma("unroll") for (int ai = 0; ai < 2; ++ai) _Pragma("unroll") for (int m = 0; m < 4; ++m) { const int row = u.pm * BM + ai * HALF + wr * 64 + m * 16 + fr; \
    _Pragma("unroll") for (int bj = 0; bj < 2; ++bj) { const int ct = bj * HALF + wc * 32 + 8 * fq; f32x4 v0 = acc[ai][bj][m][0], v1 = acc[ai][bj][m][1];
#define EPI_LOOP_END } }
#define EPI_SIG(v0, v1) do { _Pragma("unroll") for (int e_ = 0; e_ < 4; ++e_) { v0[e_] = sigm(v0[e_]); v1[e_] = sigm(v1[e_]); } } while (0)

struct EpiInProj {
    static constexpr bool PERM = true, AFTER_DRAIN = false;
    bf16_t *Q, *AS, *GA; size_t qkv_stride, gate_stride;
    __device__ __forceinline__ void operator()(const f32x4 (&acc)[2][2][4][2], const Unit& u, int wr, int wc, int fr, int fq) const {
        const int pn = u.pn;
        if (pn < 6) {
            bf16_t* base = Q + (size_t)(pn >> 1) * qkv_stride; const float sc = pn < 2 ? QC2 : 1.0f; const int cb = (pn & 1) * 256;
            EPI_LOOP_BEGIN v0 = v0 * sc; v1 = v1 * sc; *(u32x4*)(base + (size_t)row * 512 + cb + ct) = pack8(v0, v1); EPI_LOOP_END
        } else if (pn < 8) {
            const int cb = (pn - 6) * 256;
            EPI_LOOP_BEGIN const int j = cb + ct; const int g = j >> 4;
                *(u32x4*)(AS + ((size_t)(g * 4096 + (row >> 4))) * 384 + (row & 15) * 16 + (j & 15)) = pack8(v0, v1); EPI_LOOP_END
        } else {
            bf16_t* base = GA + (size_t)((pn - 8) >> 2) * gate_stride; const int cb = ((pn - 8) & 3) * 256;
            EPI_LOOP_BEGIN EPI_SIG(v0, v1); *(u32x4*)(base + (size_t)row * 1024 + cb + ct) = pack8(v0, v1); EPI_LOOP_END
        }
    }
};
struct EpiSsmState {
    static constexpr bool PERM = true, AFTER_DRAIN = false;
    float* SLOC;
    __device__ __forceinline__ void operator()(const f32x4 (&acc)[2][2][4][2], const Unit& u, int wr, int wc, int fr, int fq) const {
        EPI_LOOP_BEGIN if (bj == 0) { float* d = SLOC + (size_t)row * 128 + ct; *(f32x4*)d = v0; *(f32x4*)(d + 4) = v1; } EPI_LOOP_END
    }
};
struct EpiSsmY {
    static constexpr bool PERM = true, AFTER_DRAIN = false;
    bf16_t* YB;
    __device__ __forceinline__ void operator()(const f32x4 (&acc)[2][2][4][2], const Unit& u, int wr, int wc, int fr, int fq) const {
        EPI_LOOP_BEGIN const int g = row >> 12, cr = row & 4095, tl = ct >> 4, c0 = ct & 15;
            _Pragma("unroll") for (int e = 0; e < 4; ++e) { v0[e] = gelu_tanh(v0[e]); v1[e] = gelu_tanh(v1[e]); }
            *(u32x4*)(YB + ((size_t)(cr * 16 + tl)) * 512 + g * 16 + c0) = pack8(v0, v1); EPI_LOOP_END
    }
};
struct EpiGlu {
    static constexpr bool PERM = true, AFTER_DRAIN = false;
    const bf16_t* YB; bf16_t* O; const float* bias;
    __device__ __forceinline__ void operator()(const f32x4 (&acc)[2][2][4][2], const Unit& u, int wr, int wc, int fr, int fq) const {
        EPI_LOOP_BEGIN const int col = u.pn * BM + ct; const f32x4 b0 = *(const f32x4*)(bias + col), b1 = *(const f32x4*)(bias + col + 4);
            const u32x4 y = *(const u32x4*)(YB + (size_t)row * 512 + col);
            v0 = v0 + b0; v1 = v1 + b1; EPI_SIG(v0, v1);
            v0[0] *= bf_lo(y.x); v0[1] *= bf_hi(y.x); v0[2] *= bf_lo(y.y); v0[3] *= bf_hi(y.y); v1[0] *= bf_lo(y.z); v1[1] *= bf_hi(y.z); v1[2] *= bf_lo(y.w); v1[3] *= bf_hi(y.w);
            *(u32x4*)(O + (size_t)row * 512 + col) = pack8(v0, v1); EPI_LOOP_END
    }
};
template <bool ADD> struct EpiGate {
    static constexpr bool PERM = true, AFTER_DRAIN = false;
    const bf16_t* G; bf16_t* O;
    __device__ __forceinline__ void operator()(const f32x4 (&acc)[2][2][4][2], const Unit& u, int wr, int wc, int fr, int fq) const {
        EPI_LOOP_BEGIN const size_t off = (size_t)row * 1024 + u.pn * BM + ct; const u32x4 gt = *(const u32x4*)(G + off);
            v0[0] *= bf_lo(gt.x); v0[1] *= bf_hi(gt.x); v0[2] *= bf_lo(gt.y); v0[3] *= bf_hi(gt.y); v1[0] *= bf_lo(gt.z); v1[1] *= bf_hi(gt.z); v1[2] *= bf_lo(gt.w); v1[3] *= bf_hi(gt.w);
            if (ADD) { const u32x4 o = *(const u32x4*)(O + off);
                v0[0] += bf_lo(o.x); v0[1] += bf_hi(o.x); v0[2] += bf_lo(o.y); v0[3] += bf_hi(o.y); v1[0] += bf_lo(o.z); v1[1] += bf_hi(o.z); v1[2] += bf_lo(o.w); v1[3] += bf_hi(o.w); }
            *(u32x4*)(O + off) = pack8(v0, v1); EPI_LOOP_END
    }
};
struct EpiResid {
    static constexpr bool PERM = true, AFTER_DRAIN = false;
    bf16_t* X;
    __device__ __forceinline__ void operator()(const f32x4 (&acc)[2][2][4][2], const Unit& u, int wr, int wc, int fr, int fq) const {
        EPI_LOOP_BEGIN const size_t off = (size_t)row * 1024 + u.pn * BM + ct; const u32x4 o = *(const u32x4*)(X + off);
            v0[0] += bf_lo(o.x); v0[1] += bf_hi(o.x); v0[2] += bf_lo(o.y); v0[3] += bf_hi(o.y); v1[0] += bf_lo(o.z); v1[1] += bf_hi(o.z); v1[2] += bf_lo(o.w); v1[3] += bf_hi(o.w);
            *(u32x4*)(X + off) = pack8(v0, v1); EPI_LOOP_END
    }
};
struct EpiRelu2 {
    static constexpr bool PERM = true, AFTER_DRAIN = false;
    bf16_t* O;
    __device__ __forceinline__ void operator()(const f32x4 (&acc)[2][2][4][2], const Unit& u, int wr, int wc, int fr, int fq) const {
        EPI_LOOP_BEGIN _Pragma("unroll") for (int e = 0; e < 4; ++e) { const float a = fmaxf(v0[e], 0.f), b = fmaxf(v1[e], 0.f); v0[e] = a * a; v1[e] = b * b; }
            *(u32x4*)(O + (size_t)row * 4096 + u.pn * BM + ct) = pack8(v0, v1); EPI_LOOP_END
    }
};
struct SsmOrder {
    int G, c;
    __device__ __forceinline__ bool next(int i, Unit& u) const { const int L = i * G + c; if (L >= 512) return false; u.pm = L; u.pn = L >> 4; return true; }
    __device__ __forceinline__ void a_ready(const Unit&) const {}
    __device__ __forceinline__ void done(const Unit&) const {}
};

template <class Epi, class Sched, bool ALIGN_EPI = false, bool SP2 = false>
__device__ __forceinline__ void gemm_phase(PG8_LAS unsigned char* lds, const Gemm g, const Sched& S, const Epi& E) {
    int tid_ = threadIdx.x; asm volatile("" : "+v"(tid_));
    const int tid = tid_, wid = __builtin_amdgcn_readfirstlane(tid >> 6), lane = tid & 63, wr = wid >> 2, wc = wid & 3, fr = lane & 15, fq = lane >> 4;
    const int K = g.K, nt = K / BK;
    unsigned voffA[2], voffB[2];
#pragma unroll
    for (int i = 0; i < 2; ++i) { int R, C; stage_rc(tid * 16 + i * 8192, R, C); const int Rb = Epi::PERM ? ((R & ~31) + perm32(R & 31)) : R;
        voffA[i] = (unsigned)(R * K + C) * 2u; voffB[i] = (unsigned)(Rb * K + C) * 2u; }
    const size_t kstep = (size_t)(BK * 2);
    const size_t hstep = (size_t)HALF * K * 2;
    const size_t tstep = 2 * hstep;
    const unsigned ldsw = (unsigned)wid * 1024u;
    const int aoff = lds_byte(wr * 64 + fr, fq * 8), boff = lds_byte(wc * 32 + fr, fq * 8);
#define PG8_SA(b, h) (((b) * 2 + (h)) * HTB)
#define PG8_SB(b, h) ((4 + (b) * 2 + (h)) * HTB)
#define PG8_STAGE(bufoff, gbase, voff) do { _Pragma("unroll") for (int _i = 0; _i < 2; ++_i) \
        __builtin_amdgcn_global_load_lds((const unsigned*)((const char*)(gbase) + (voff)[_i]), (PG8_LAS unsigned*)(lds + (bufoff) + ldsw + _i * 8192), 16, 0, 0); } while (0)
#define PG8_LDA(dst, b, h) do { _Pragma("unroll") for (int m = 0; m < 4; ++m) _Pragma("unroll") for (int k = 0; k < 2; ++k) dst[m][k] = *(const PG8_LAS bf16x8*)(lds + PG8_SA(b, h) + aoff + m * 2048 + k * 1024); } while (0)
#define PG8_LDB(dst, b, h) do { _Pragma("unroll") for (int n = 0; n < 2; ++n) _Pragma("unroll") for (int k = 0; k < 2; ++k) dst[n][k] = *(const PG8_LAS bf16x8*)(lds + PG8_SB(b, h) + boff + n * 2048 + k * 1024); } while (0)
#define PG8_MMA(ai, bj, At, Bt) do { __builtin_amdgcn_s_setprio(1); _Pragma("unroll") for (int m = 0; m < 4; ++m) _Pragma("unroll") for (int n = 0; n < 2; ++n) _Pragma("unroll") for (int k = 0; k < 2; ++k) \
        acc[ai][bj][m][n] = __builtin_amdgcn_mfma_f32_16x16x32_bf16(Bt[n][k], At[m][k], acc[ai][bj][m][n], 0, 0, 0); __builtin_amdgcn_s_setprio(0); } while (0)
#define PG8_WAIT_V(n) asm volatile("s_waitcnt vmcnt(" #n ")" ::: "memory")
#define PG8_WAIT_L(n) asm volatile("s_waitcnt lgkmcnt(" #n ")" ::: "memory")
#define PG8_BAR __builtin_amdgcn_s_barrier()
#define PG8_SCHED __builtin_amdgcn_sched_barrier(0)
    Unit cur, nxt; int ui = 0;
    if (!S.next(0, cur)) return;
    f32x4 acc[2][2][4][2];
#pragma unroll
    for (int a = 0; a < 2; ++a)
#pragma unroll
        for (int b = 0; b < 2; ++b)
#pragma unroll
            for (int m = 0; m < 4; ++m)
#pragma unroll
                for (int n = 0; n < 2; ++n) acc[a][b][m][n] = (f32x4){0.f, 0.f, 0.f, 0.f};
    bf16x8 At[4][2], B0[2][2], B1[2][2];
    const char* cA = (const char*)g.A + (size_t)cur.pm * tstep; const char* cB = (const char*)g.Bt + (size_t)cur.pn * tstep;
    S.a_ready(cur);
    if constexpr (SP2) {
        PG8_STAGE(PG8_SB(0, 0), cB, voffB); PG8_STAGE(PG8_SB(0, 1), cB + hstep, voffB); PG8_STAGE(PG8_SA(0, 0), cA, voffA); PG8_STAGE(PG8_SA(0, 1), cA + hstep, voffA);
        if (wr == 1) PG8_BAR;
        PG8_WAIT_V(2); PG8_BAR;
        PG8_STAGE(PG8_SB(1, 0), cB + kstep, voffB); PG8_STAGE(PG8_SA(1, 0), cA + kstep, voffA); PG8_STAGE(PG8_SB(1, 1), cB + hstep + kstep, voffB);
        PG8_WAIT_V(6); PG8_BAR;
    } else {
        PG8_STAGE(PG8_SB(0, 0), cB, voffB); PG8_STAGE(PG8_SA(0, 0), cA, voffA); PG8_STAGE(PG8_SB(0, 1), cB + hstep, voffB); PG8_STAGE(PG8_SA(0, 1), cA + hstep, voffA);
        if (wr == 1) PG8_BAR;
        PG8_WAIT_V(4); PG8_BAR;
        PG8_STAGE(PG8_SB(1, 0), cB + kstep, voffB); PG8_STAGE(PG8_SA(1, 0), cA + kstep, voffA); PG8_STAGE(PG8_SB(1, 1), cB + hstep + kstep, voffB);
        PG8_WAIT_V(6); PG8_BAR;
    }
    for (;;) {
        const bool has_next = S.next(ui + 1, nxt);
        const char* nA = has_next ? (const char*)g.A + (size_t)nxt.pm * tstep : cA; const char* nB = has_next ? (const char*)g.Bt + (size_t)nxt.pn * tstep : cB;
        for (int t = 0; t < nt; t += 2) {
            const bool last = (t == nt - 2);
            const char* a1 = cA + (size_t)(t + 1) * kstep;
            const char* a2 = last ? nA : cA + (size_t)(t + 2) * kstep; const char* b2 = last ? nB : cB + (size_t)(t + 2) * kstep;
            const char* a3 = a2 + kstep; const char* b3 = b2 + kstep;
            if (last && has_next) S.a_ready(nxt);
            if constexpr (SP2) {
            PG8_LDB(B0, 0, 0); PG8_LDB(B1, 0, 1); PG8_SCHED; PG8_LDA(At, 0, 0); PG8_STAGE(PG8_SA(1, 1), a1 + hstep, voffA);
            PG8_WAIT_V(8); PG8_WAIT_L(0); PG8_BAR; PG8_MMA(0, 0, At, B0); PG8_MMA(0, 1, At, B1); PG8_BAR; PG8_SCHED;
            PG8_LDA(At, 0, 1); PG8_STAGE(PG8_SB(0, 0), b2, voffB); PG8_STAGE(PG8_SB(0, 1), b2 + hstep, voffB); PG8_STAGE(PG8_SA(0, 0), a2, voffA);
            PG8_WAIT_V(8); PG8_WAIT_L(0); PG8_BAR; PG8_MMA(1, 0, At, B0); PG8_MMA(1, 1, At, B1); PG8_BAR; PG8_SCHED;
            PG8_LDB(B0, 1, 0); PG8_LDB(B1, 1, 1); PG8_SCHED; PG8_LDA(At, 1, 0); PG8_STAGE(PG8_SA(0, 1), a2 + hstep, voffA);
            PG8_WAIT_V(8); PG8_WAIT_L(0); PG8_BAR; PG8_MMA(0, 0, At, B0); PG8_MMA(0, 1, At, B1); PG8_BAR; PG8_SCHED;
            PG8_LDA(At, 1, 1); PG8_STAGE(PG8_SB(1, 0), b3, voffB); PG8_STAGE(PG8_SB(1, 1), b3 + hstep, voffB); PG8_STAGE(PG8_SA(1, 0), a3, voffA);
            PG8_WAIT_V(8); PG8_WAIT_L(0); PG8_BAR; PG8_MMA(1, 0, At, B0); PG8_MMA(1, 1, At, B1); PG8_BAR; PG8_SCHED;
            } else {
            PG8_LDB(B0, 0, 0); PG8_SCHED; PG8_LDA(At, 0, 0); PG8_STAGE(PG8_SA(1, 1), a1 + hstep, voffA);
            PG8_WAIT_L(8); PG8_BAR; PG8_WAIT_L(0); PG8_MMA(0, 0, At, B0); PG8_BAR; PG8_SCHED;
            PG8_LDB(B1, 0, 1); PG8_STAGE(PG8_SB(0, 0), b2, voffB);
            PG8_BAR; PG8_WAIT_L(0); PG8_MMA(0, 1, At, B1); PG8_BAR;
            PG8_LDA(At, 0, 1); PG8_STAGE(PG8_SA(0, 0), a2, voffA);
            PG8_BAR; PG8_WAIT_L(0); PG8_MMA(1, 0, At, B0); PG8_BAR; PG8_SCHED;
            PG8_STAGE(PG8_SB(0, 1), b2 + hstep, voffB);
            PG8_WAIT_V(6); PG8_BAR; PG8_MMA(1, 1, At, B1); PG8_BAR;
            PG8_LDB(B0, 1, 0); PG8_SCHED; PG8_LDA(At, 1, 0); PG8_STAGE(PG8_SA(0, 1), a2 + hstep, voffA);
            PG8_WAIT_L(8); PG8_BAR; PG8_WAIT_L(0); PG8_MMA(0, 0, At, B0); PG8_BAR; PG8_SCHED;
            PG8_LDB(B1, 1, 1); PG8_STAGE(PG8_SB(1, 0), b3, voffB);
            PG8_BAR; PG8_WAIT_L(0); PG8_MMA(0, 1, At, B1); PG8_BAR;
            PG8_LDA(At, 1, 1); PG8_STAGE(PG8_SA(1, 0), a3, voffA);
            PG8_BAR; PG8_WAIT_L(0); PG8_MMA(1, 0, At, B0); PG8_BAR; PG8_SCHED;
            PG8_STAGE(PG8_SB(1, 1), b3 + hstep, voffB);
            PG8_WAIT_V(6); PG8_BAR; PG8_MMA(1, 1, At, B1); PG8_BAR;
            }
        }
        if constexpr (ALIGN_EPI) { if (wr == 0) PG8_BAR; }
        if constexpr (!Epi::AFTER_DRAIN) { E(acc, cur, wr, wc, fr, fq); S.done(cur); }
        if (!has_next) break;
#pragma unroll
        for (int a = 0; a < 2; ++a)
#pragma unroll
            for (int b = 0; b < 2; ++b)
#pragma unroll
                for (int m = 0; m < 4; ++m)
#pragma unroll
                    for (int n = 0; n < 2; ++n) acc[a][b][m][n] = (f32x4){0.f, 0.f, 0.f, 0.f};
        cur = nxt; cA = nA; cB = nB; ++ui;
        if constexpr (ALIGN_EPI) { if (wr == 1) PG8_BAR; }
    }
    PG8_WAIT_V(0);
    if constexpr (!ALIGN_EPI) { if (wr == 0) PG8_BAR; }
    PG8_BAR;
    if constexpr (Epi::AFTER_DRAIN) { E.fused(acc, cur, wr, wc, fr, fq, lds, wid, lane); S.done(cur); }
#undef PG8_SA
#undef PG8_SB
#undef PG8_STAGE
#undef PG8_LDA
#undef PG8_LDB
#undef PG8_MMA
#undef PG8_WAIT_V
#undef PG8_WAIT_L
#undef PG8_BAR
#undef PG8_SCHED
}
}
#include <hip/hip_bf16.h>
#include <cmath>
namespace attn_body {
using bf16=__hip_bfloat16;
using bf16x8=__attribute__((ext_vector_type(8)))short;
using s16x4=__attribute__((ext_vector_type(4)))short;
using f32x16=__attribute__((ext_vector_type(16)))float;
using u32x4=__attribute__((ext_vector_type(4)))unsigned;
constexpr int BATCH=16,NHEAD=8,SEQ=4096,D=64,DM=NHEAD*D;
constexpr int NW=8,QBLK=32,QB=QBLK*NW,KVBLK=64,NQB=SEQ/QB;
constexpr int ATTN_PITCH=DM, ATTN_UNIT_ROWS=QB;
__device__ __forceinline__ int crow(int r,int hi){return (r&3)+8*(r>>2)+4*hi;}
#define SBAR() __builtin_amdgcn_sched_barrier(0)
__device__ __forceinline__ void cmask(f32x16&p0,f32x16&p1,int jb,int qrel,int hi){
  const float NEG=-INFINITY; int kb=64*jb+4*hi;
  #pragma unroll
  for(int r=0;r<16;++r){int kv=kb+(r&3)+8*(r>>2); if(kv>qrel)p0[r]=NEG; if(kv+32>qrel)p1[r]=NEG;}
}

constexpr int NSLOT=3, SLOTB=8192;
constexpr int LDS_K=0, LDS_V=NSLOT*SLOTB, LDS_WS=2*NSLOT*SLOTB, LDS_OST=LDS_WS+NW*64*4, LDS_BIAS=LDS_OST+NW*4096, LDS_BYTES=LDS_BIAS+SEQ*4;
constexpr float C2=0.125f*1.4426950408889634f;
__device__ __forceinline__ void glds16(const void*gsrc,unsigned lds_dst){unsigned keep;
  asm volatile("s_mov_b32 %0, m0\n\ts_mov_b32 m0, %2\n\ts_nop 0\n\tglobal_load_lds_dwordx4 %1, off\n\ts_mov_b32 m0, %0":"=&s"(keep):"v"(gsrc),"s"(lds_dst):"memory");}
__device__ __forceinline__ float max3f(float a,float b,float c){float r;asm("v_max3_f32 %0, %1, %2, %3":"=v"(r):"v"(a),"v"(b),"v"(c));return r;}
__device__ __forceinline__ float max2f(float a,float b){float r;asm("v_max_f32_e32 %0, %1, %2":"=v"(r):"v"(a),"v"(b));return r;}
__device__ __forceinline__ float fadd_s(float a,float b){float r;asm("v_add_f32_e32 %0, %1, %2":"=v"(r):"v"(a),"v"(b));return r;}
__device__ __forceinline__ float fsub_s(float a,float b){float r;asm("v_sub_f32_e32 %0, %1, %2":"=v"(r):"v"(a),"v"(b));return r;}
typedef float f32x4_t __attribute__((ext_vector_type(4))); typedef float f32x2_t __attribute__((ext_vector_type(2))); typedef __bf16 bf16x2_t __attribute__((ext_vector_type(2)));
__device__ __forceinline__ unsigned cvtpk_s(float lo,float hi){f32x2_t v={lo,hi};bf16x2_t b=__builtin_convertvector(v,bf16x2_t);return __builtin_bit_cast(unsigned,b);}
#define WAIT_BAR(N) asm volatile("s_waitcnt vmcnt(" #N ") lgkmcnt(0)\n\ts_barrier":::"memory")

__device__ __forceinline__ void qkt(f32x16&p0,f32x16&p1,const char*Kslot,const bf16x8*qr,const f32x16&negm,int r32,int hi){
  const char*kb=Kslot+hi*1024+r32*16;
  #pragma unroll
  for(int d0=0;d0<4;++d0){
    const bf16x8 b0=*reinterpret_cast<const bf16x8*>(kb+d0*2048);
    const bf16x8 b1=*reinterpret_cast<const bf16x8*>(kb+d0*2048+512);
    if(d0==0){p0=__builtin_amdgcn_mfma_f32_32x32x16_bf16(b0,qr[0],negm,0,0,0);p1=__builtin_amdgcn_mfma_f32_32x32x16_bf16(b1,qr[0],negm,0,0,0);}
    else{p0=__builtin_amdgcn_mfma_f32_32x32x16_bf16(b0,qr[d0],p0,0,0,0);p1=__builtin_amdgcn_mfma_f32_32x32x16_bf16(b1,qr[d0],p1,0,0,0);}}
}
typedef __attribute__((address_space(3))) const char* lds_cptr;
typedef short v4i16_t __attribute__((ext_vector_type(4)));
__device__ __forceinline__ void kload8(bf16x8*kf,lds_cptr kp){
  kf[0]=*(const __attribute__((address_space(3))) bf16x8*)(kp);      kf[1]=*(const __attribute__((address_space(3))) bf16x8*)(kp+512);
  kf[2]=*(const __attribute__((address_space(3))) bf16x8*)(kp+2048); kf[3]=*(const __attribute__((address_space(3))) bf16x8*)(kp+2560);
  kf[4]=*(const __attribute__((address_space(3))) bf16x8*)(kp+4096); kf[5]=*(const __attribute__((address_space(3))) bf16x8*)(kp+4608);
  kf[6]=*(const __attribute__((address_space(3))) bf16x8*)(kp+6144); kf[7]=*(const __attribute__((address_space(3))) bf16x8*)(kp+6656);
}
__device__ __forceinline__ void kload2(bf16x8*kf,lds_cptr kp,int j){ kf[2*j]=*(const __attribute__((address_space(3))) bf16x8*)(kp+j*2048); kf[2*j+1]=*(const __attribute__((address_space(3))) bf16x8*)(kp+j*2048+512); }
__device__ __forceinline__ s16x4 vtr(lds_cptr p){ return __builtin_bit_cast(s16x4,__builtin_amdgcn_ds_read_tr16_b64_v4i16((__attribute__((address_space(3))) v4i16_t*)p)); }
__device__ __forceinline__ float rowmax(const f32x16&p0,const f32x16&p1){
  float a=max3f(p0[0],p0[1],p1[0]),b=max3f(p0[2],p0[3],p1[1]);a=max3f(a,p1[2],p1[3]);
  #pragma unroll
  for(int r=4;r<16;r+=4){a=max3f(a,p0[r],p0[r+1]);b=max3f(b,p0[r+2],p0[r+3]);a=max3f(a,p1[r],p1[r+1]);b=max3f(b,p1[r+2],p1[r+3]);}
  const float m=max2f(a,b);
  auto rr=__builtin_amdgcn_permlane32_swap(__float_as_uint(m),__float_as_uint(m),false,false);
  return max2f(__uint_as_float(rr[0]),__uint_as_float(rr[1]));
}
__device__ __forceinline__ void pv(f32x16*o,int vb,bf16x8 pa0,bf16x8 pa1,bf16x8 pa2,bf16x8 pa3){
  #pragma unroll
  for(int d0=0;d0<2;++d0){s16x4 lo[4],hi[4];
    #pragma unroll
    for(int ks=0;ks<4;++ks){
      asm volatile("ds_read_b64_tr_b16 %0,%1 offset:%c2":"=&v"(lo[ks]):"v"(vb),"i"(d0*4096+ks*1024):"memory");
      asm volatile("ds_read_b64_tr_b16 %0,%1 offset:%c2":"=&v"(hi[ks]):"v"(vb),"i"(d0*4096+ks*1024+512):"memory");}
    asm volatile("s_waitcnt lgkmcnt(0)":::"memory");SBAR();
    #define PK(k) (bf16x8){lo[k][0],lo[k][1],lo[k][2],lo[k][3],hi[k][0],hi[k][1],hi[k][2],hi[k][3]}
    o[d0]=__builtin_amdgcn_mfma_f32_32x32x16_bf16(pa0,PK(0),o[d0],0,0,0);
    o[d0]=__builtin_amdgcn_mfma_f32_32x32x16_bf16(pa1,PK(1),o[d0],0,0,0);
    o[d0]=__builtin_amdgcn_mfma_f32_32x32x16_bf16(pa2,PK(2),o[d0],0,0,0);
    o[d0]=__builtin_amdgcn_mfma_f32_32x32x16_bf16(pa3,PK(3),o[d0],0,0,0);
    #undef PK
  }
}

#ifndef ATTN_STORE16
#define ATTN_STORE16(p,v) (*(u32x4*)(p)=(v))
#endif
template<int THRL> __device__ __forceinline__ void attn_unit(int b,int h,int qb,const bf16*Q,const bf16*__restrict__ K,const bf16*__restrict__ V,bf16*O,const float*__restrict__ BIASG,char*shm){
  int tid_=threadIdx.x; asm volatile("":"+v"(tid_)); const int tid=tid_,lane=tid&63,r32=lane&31,hi=lane>>5; const int wid=__builtin_amdgcn_readfirstlane(tid>>6);
  const long rowbase=(long)b*SEQ; const int q0=qb*QB;
  const bf16*Qw=Q+(rowbase+q0+wid*QBLK)*DM+h*D;
  const bf16*Kh=K+rowbase*DM+h*D,*Vh=V+rowbase*DM+h*D;
  const lds_cptr shm3=(lds_cptr)shm;
  const unsigned lds0=(unsigned)(uintptr_t)shm;
  float*wsf=(float*)(shm+LDS_WS)+wid*64;
  const bf16*ksrc=Kh+(long)lane*DM+wid*8;
  const bf16*vsrc=Vh+(long)(16*(wid&3)+(lane>>2))*DM+(wid>>2)*32+(lane&3)*8;
  const unsigned kdst=lds0+LDS_K+wid*1024, vdst=lds0+LDS_V+wid*1024;
  #define DMA_K(t,slot) glds16(ksrc+(long)(t)*KVBLK*DM,(unsigned)__builtin_amdgcn_readfirstlane(kdst+(slot)))
  #define DMA_V(t,slot) glds16(vsrc+(long)(t)*KVBLK*DM,(unsigned)__builtin_amdgcn_readfirstlane(vdst+(slot)))
  const int vb0=(int)(lds0+LDS_V)+((lane>>4)&1)*32+(lane&3)*8+(4*hi+((lane&15)>>2))*64;
  const char*Kbase=shm+LDS_K; bf16x8 kf[8];
  const lds_cptr kp0=shm3+LDS_K+hi*1024+r32*16; const lds_cptr vp0=shm3+LDS_V+((lane>>4)&1)*32+(lane&3)*8+(4*hi+((lane&15)>>2))*64;
  const int NT=(q0+QB)/KVBLK;
  const __attribute__((address_space(3))) float*biasl=(const __attribute__((address_space(3))) float*)(shm3+LDS_BIAS)+4*hi;
  #define ADDB(P0,P1,t) do{ const __attribute__((address_space(3))) float*bp_=biasl+64*(t); \
    _Pragma("unroll") for(int j_=0;j_<4;++j_){ const f32x4_t b0_=*(const __attribute__((address_space(3))) f32x4_t*)(bp_+8*j_), b1_=*(const __attribute__((address_space(3))) f32x4_t*)(bp_+32+8*j_); \
      _Pragma("unroll") for(int e_=0;e_<4;++e_){ P0[4*j_+e_]+=b0_[e_]; P1[4*j_+e_]+=b1_[e_]; } } }while(0)
  DMA_K(0,0);DMA_V(0,0);DMA_K(1,SLOTB);
  bf16x8 qr[4];
  #pragma unroll
  for(int d0=0;d0<4;++d0)qr[d0]=*reinterpret_cast<const bf16x8*>(&Qw[(long)r32*DM+d0*16+hi*8]);
  float mhat=0.f,l_reg=0.f;f32x16 o[2];o[0]=f32x16{};o[1]=f32x16{};f32x16 negm=f32x16{};asm volatile("":"+v"(negm));
  const int qrel=wid*QBLK+r32;
  #define CMASK(P0,P1,t) do{int jb_=(t)-(NT-4); if(jb_>=0)cmask(P0,P1,jb_,qrel,hi);}while(0)
  bool resc=false;
  #define START(P0,P1) do{ const float rm=rowmax(P0,P1); resc=false; \
    { const float dl=rm; mhat=fadd_s(mhat,dl); \
      _Pragma("unroll") for(int r=0;r<16;++r){P0[r]=fsub_s(P0[r],dl);P1[r]=fsub_s(P1[r],dl);} \
      _Pragma("unroll") for(int r=0;r<16;++r)negm[r]=-mhat; asm volatile("":"+v"(negm)); } \
    _Pragma("unroll") for(int r=0;r<16;++r)P0[r]=__builtin_amdgcn_exp2f(P0[r]); }while(0)
  #define RESC() do{ if(resc){ asm volatile("s_waitcnt lgkmcnt(0)":::"memory"); \
      _Pragma("unroll") for(int d_=0;d_<2;++d_) _Pragma("unroll") for(int r=0;r<16;++r)o[d_][r]*=wsf[crow(r,hi)]; } }while(0)
  f32x16 pA0,pA1,pB0,pB1;
  int sl_prev=0,sl_cur=0,sl_next=SLOTB;
  #define ROT() do{sl_prev=sl_cur;sl_cur=sl_next;sl_next=(sl_next==(NSLOT-1)*SLOTB)?0:sl_next+SLOTB;}while(0)
  DMA_K(2,2*SLOTB);
  { const float*gb=BIASG+(long)(b*NHEAD+h)*SEQ; __attribute__((address_space(3))) float*bl=(__attribute__((address_space(3))) float*)(shm3+LDS_BIAS);
    for(int i=tid*4;i<q0+QB;i+=NW*64*4){ const f32x4_t v=*(const f32x4_t*)(gb+i); *(__attribute__((address_space(3))) f32x4_t*)(bl+i)=v; } }
  WAIT_BAR(3);
  qkt(pA0,pA1,Kbase,qr,negm,r32,hi);asm volatile("s_nop 15\n\ts_nop 7":"+v"(pA0),"+v"(pA1));ADDB(pA0,pA1,0);CMASK(pA0,pA1,0);
  START(pA0,pA1);
  _Pragma("unroll") for(int r=0;r<16;++r)pA1[r]=__builtin_amdgcn_exp2f(pA1[r]);
  WAIT_BAR(0);
  DMA_K(3,0);DMA_V(1,SLOTB);
  ROT();
  kload8(kf,kp0+sl_cur);
  WAIT_BAR(2);
  s16x4 vlo[8],vhi[8]; u32x4 pw0,pw1,pw2,pw3;
  #define PKW(P,B) cvtpk_s(P[B],P[B+1])
  #define PAF(k) __builtin_bit_cast(bf16x8,pw##k)
  #define VFR(i) (bf16x8){vlo[i][0],vlo[i][1],vlo[i][2],vlo[i][3],vhi[i][0],vhi[i][1],vhi[i][2],vhi[i][3]}
  #define PIN(x) asm volatile("":"+v"(x))
  #define MX3(a,b,c) __builtin_fmaxf(__builtin_fmaxf((a),(b)),(c))
  #define GAPA(MF,A0,A1,A2,A3,W0,W1,PW) do{ MF; sacc+=A0; sacc+=A1; sacc+=A2; sacc+=A3; PIN(sacc); W0; W1; PIN(PW); SBAR(); }while(0)
  #define EX(v) __builtin_amdgcn_exp2f(v)
  #define GAPB(MF,X,B) do{ MF; X[B]=EX(X[B]); X[B+1]=EX(X[B+1]); X[B+2]=EX(X[B+2]); X[B+3]=EX(X[B+3]); PIN(X); SBAR(); }while(0)
  #define VRD(i) do{ vlo[i]=vtr(vp_+(((i)>>2)*4096+((i)&3)*1024)); vhi[i]=vtr(vp_+(((i)>>2)*4096+((i)&3)*1024+512)); }while(0)
  #define KRD(G,j) do{ if(G){ kload2(kf,kp0+sl_next,j); SBAR(); } }while(0)
  #define LDB4(off) (*(const __attribute__((address_space(3))) f32x4_t*)(bp_+(off)))
  #define BL0(t) do{ const __attribute__((address_space(3))) float*bp_=biasl+64*(t); bA0=LDB4(0); bA1=LDB4(8); bA2=LDB4(16); bA3=LDB4(24); }while(0)
  #define BL1(t) do{ const __attribute__((address_space(3))) float*bp_=biasl+64*(t); bB0=LDB4(32); bB1=LDB4(40); bB2=LDB4(48); bB3=LDB4(56); }while(0)
  #define BADD(C0,C1) do{ _Pragma("unroll") for(int e_=0;e_<4;++e_){ C0[e_]+=bA0[e_]; C0[4+e_]+=bA1[e_]; C0[8+e_]+=bA2[e_]; C0[12+e_]+=bA3[e_]; C1[e_]+=bB0[e_]; C1[4+e_]+=bB1[e_]; C1[8+e_]+=bB2[e_]; C1[12+e_]+=bB3[e_]; } }while(0)
  #define STEP(C0,C1,P0,P1,t,GK,GV,GL) do{ SBAR(); f32x4_t bA0,bA1,bA2,bA3,bB0,bB1,bB2,bB3; \
    const lds_cptr vp_=vp0+sl_prev; \
    VRD(0); SBAR(); float sacc=(P0[0]+P0[1]); \
    GAPA(C0=__builtin_amdgcn_mfma_f32_32x32x16_bf16(kf[0],qr[0],negm,0,0,0), P0[2],P0[3],P0[4],P0[5],     pw0[0]=PKW(P0,0), pw0[1]=PKW(P0,2), pw0); \
    VRD(4); SBAR(); GAPA(C1=__builtin_amdgcn_mfma_f32_32x32x16_bf16(kf[1],qr[0],negm,0,0,0), P0[6],P0[7],P0[8],P0[9],     pw0[2]=PKW(P0,4), pw0[3]=PKW(P0,6), pw0); \
    VRD(1); SBAR(); GAPA(C0=__builtin_amdgcn_mfma_f32_32x32x16_bf16(kf[2],qr[1],C0,0,0,0),   P0[10],P0[11],P0[12],P0[13], pw1[0]=PKW(P0,8), pw1[1]=PKW(P0,10), pw1); \
    VRD(5); SBAR(); GAPA(C1=__builtin_amdgcn_mfma_f32_32x32x16_bf16(kf[3],qr[1],C1,0,0,0),   P0[14],P0[15],P1[0],P1[1],   pw1[2]=PKW(P0,12),pw1[3]=PKW(P0,14), pw1); \
    VRD(2); SBAR(); GAPA(C0=__builtin_amdgcn_mfma_f32_32x32x16_bf16(kf[4],qr[2],C0,0,0,0),   P1[2],P1[3],P1[4],P1[5],     pw2[0]=PKW(P1,0), pw2[1]=PKW(P1,2), pw2); \
    VRD(6); SBAR(); GAPA(C1=__builtin_amdgcn_mfma_f32_32x32x16_bf16(kf[5],qr[2],C1,0,0,0),   P1[6],P1[7],P1[8],P1[9],     pw2[2]=PKW(P1,4), pw2[3]=PKW(P1,6), pw2); \
    VRD(3); SBAR(); GAPA(C0=__builtin_amdgcn_mfma_f32_32x32x16_bf16(kf[6],qr[3],C0,0,0,0),   P1[10],P1[11],P1[12],P1[13], pw3[0]=PKW(P1,8), pw3[1]=PKW(P1,10), pw3); \
    BL0(t); SBAR(); \
    VRD(7); SBAR(); GAPA(C1=__builtin_amdgcn_mfma_f32_32x32x16_bf16(kf[7],qr[3],C1,0,0,0),   P1[14],P1[15],0.f,0.f,       pw3[2]=PKW(P1,12),pw3[3]=PKW(P1,14), pw3); \
    BL1(t); SBAR(); \
    l_reg+=sacc; \
    if(GK){DMA_K((t)+3,sl_cur);} if(GV){DMA_V((t)+1,sl_next);} \
    BADD(C0,C1); CMASK(C0,C1,t); \
    { float a=MX3(C0[0],C0[1],C1[0]),b=MX3(C0[2],C0[3],C1[1]); a=MX3(a,C1[2],C1[3]); \
      _Pragma("unroll") for(int r=4;r<16;r+=4){a=MX3(a,C0[r],C0[r+1]);b=MX3(b,C0[r+2],C0[r+3]);a=MX3(a,C1[r],C1[r+1]);b=MX3(b,C1[r+2],C1[r+3]);} \
      float rm=__builtin_fmaxf(a,b); { auto rr=__builtin_amdgcn_permlane32_swap(__float_as_uint(rm),__float_as_uint(rm),false,false); rm=__builtin_fmaxf(__uint_as_float(rr[0]),__uint_as_float(rr[1])); } \
      resc=false; \
      if(__builtin_expect(__any(rm>(float)THRL),0)){ const float dl=__builtin_fmaxf(rm,0.f); mhat+=dl; \
        _Pragma("unroll") for(int r=0;r<16;++r){C0[r]-=dl;C1[r]-=dl;} \
        _Pragma("unroll") for(int r=0;r<16;++r)negm[r]=-mhat; asm volatile("":"+v"(negm)); \
        const float f=__builtin_amdgcn_exp2f(-dl); l_reg*=f; if(hi==0)wsf[r32]=f; resc=true; } } \
    SBAR(); \
    GAPB(o[0]=__builtin_amdgcn_mfma_f32_32x32x16_bf16(PAF(0),VFR(0),o[0],0,0,0), C0,0); \
    GAPB(o[1]=__builtin_amdgcn_mfma_f32_32x32x16_bf16(PAF(0),VFR(4),o[1],0,0,0), C0,4); \
    KRD(GL,0); GAPB(o[0]=__builtin_amdgcn_mfma_f32_32x32x16_bf16(PAF(1),VFR(1),o[0],0,0,0), C0,8); \
    KRD(GL,1); GAPB(o[1]=__builtin_amdgcn_mfma_f32_32x32x16_bf16(PAF(1),VFR(5),o[1],0,0,0), C0,12); \
    KRD(GL,2); GAPB(o[0]=__builtin_amdgcn_mfma_f32_32x32x16_bf16(PAF(2),VFR(2),o[0],0,0,0), C1,0); \
    KRD(GL,3); GAPB(o[1]=__builtin_amdgcn_mfma_f32_32x32x16_bf16(PAF(2),VFR(6),o[1],0,0,0), C1,4); \
    GAPB(o[0]=__builtin_amdgcn_mfma_f32_32x32x16_bf16(PAF(3),VFR(3),o[0],0,0,0), C1,8); \
    GAPB(o[1]=__builtin_amdgcn_mfma_f32_32x32x16_bf16(PAF(3),VFR(7),o[1],0,0,0), C1,12); \
    }while(0)
  int t=1;
  #undef CMASK
  #define CMASK(P0,P1,t) do{}while(0)
  for(;t+5<NT;t+=2){
    STEP(pB0,pB1,pA0,pA1,t,true,true,true);     WAIT_BAR(2); RESC(); ROT();
    STEP(pA0,pA1,pB0,pB1,t+1,true,true,true);   WAIT_BAR(2); RESC(); ROT();
  }
  #undef CMASK
  #define CMASK(P0,P1,t) do{int jb_=(t)-(NT-4); if(jb_>=0)cmask(P0,P1,jb_,qrel,hi);}while(0)
  #define ENDW(tt) do{ if((tt)+3<NT){WAIT_BAR(2);} else if((tt)+2<NT){WAIT_BAR(1);} else {WAIT_BAR(0);} }while(0)
  for(;t+1<NT;t+=2){
    STEP(pB0,pB1,pA0,pA1,t,(t+3<NT),(t+1<NT),(t+1<NT));       ENDW(t);   RESC(); ROT();
    STEP(pA0,pA1,pB0,pB1,t+1,(t+4<NT),(t+2<NT),(t+2<NT));     ENDW(t+1); RESC(); ROT();
  }
  STEP(pB0,pB1,pA0,pA1,NT-1,false,false,false); RESC();
  { float sacc=pB0[0]+pB0[1]; _Pragma("unroll") for(int r=2;r<16;++r)sacc+=pB0[r]; _Pragma("unroll") for(int r=0;r<16;++r)sacc+=pB1[r]; l_reg+=sacc;
    pw0=(u32x4){PKW(pB0,0),PKW(pB0,2),PKW(pB0,4),PKW(pB0,6)};pw1=(u32x4){PKW(pB0,8),PKW(pB0,10),PKW(pB0,12),PKW(pB0,14)};pw2=(u32x4){PKW(pB1,0),PKW(pB1,2),PKW(pB1,4),PKW(pB1,6)};pw3=(u32x4){PKW(pB1,8),PKW(pB1,10),PKW(pB1,12),PKW(pB1,14)};
    SBAR(); pv(o,vb0+sl_cur,PAF(0),PAF(1),PAF(2),PAF(3)); }
  #undef PKW
  #undef PAF
  #undef VFR
  #undef PIN
  #undef MX3
  #undef GAPA
  #undef GAPB
  #undef EX
  #undef VRD
  #undef KRD
  #undef STEP
  #undef ENDW
  {auto rr=__builtin_amdgcn_permlane32_swap(__float_as_uint(l_reg),__float_as_uint(l_reg),false,false);l_reg=__uint_as_float(rr[0])+__uint_as_float(rr[1]);}
  if(hi==0)wsf[32+r32]=l_reg;asm volatile("s_waitcnt lgkmcnt(0)":::"memory");
  float rli[16];
  #pragma unroll
  for(int r=0;r<16;++r)rli[r]=__builtin_amdgcn_rcpf(wsf[32+crow(r,hi)]);
  bf16*Ow=O+(rowbase+q0+wid*QBLK)*DM+h*D;
  { bf16*stg=(bf16*)(shm+LDS_OST)+wid*2048;
    #pragma unroll
    for(int r=0;r<16;++r){const int orow=crow(r,hi);
      #pragma unroll
      for(int d0=0;d0<2;++d0)stg[orow*64+d0*32+r32]=__float2bfloat16(o[d0][r]*rli[r]);}
    asm volatile("s_waitcnt lgkmcnt(0)":::"memory");
    #pragma unroll
    for(int i=0;i<4;++i){const int row=i*8+(lane>>3),ch=lane&7; const u32x4 v=*(const u32x4*)(stg+row*64+ch*8); ATTN_STORE16(Ow+(long)row*DM+ch*8,v);} }
  asm volatile("s_waitcnt lgkmcnt(0)\n\ts_barrier":::"memory");
  #undef ADDB
  #undef LDB4
  #undef BL0
  #undef BL1
  #undef BADD
  #undef DMA_K
  #undef DMA_V
  #undef CMASK
  #undef START
  #undef RESC
  #undef ROT
}
constexpr int ATTN_LDS_BYTES=LDS_BYTES;
struct AttnTensors { const bf16* Q; const bf16* K; const bf16* V; bf16* O; const float* BIAS; };
struct AttnUnit { int bh; int qb; };
struct StaticOrder {
  int vcu, grid;
  __device__ __forceinline__ explicit StaticOrder(int grid_,int block):vcu((grid_%8==0)?(block%8)*(grid_/8)+block/8:block),grid(grid_){}
  __device__ __forceinline__ bool next(int i,AttnUnit&u)const{ const int I=vcu+(i>>1)*grid; if(I>=BATCH*NHEAD*(NQB/2))return false; const int j=I%(NQB/2); u.bh=I/(NQB/2); u.qb=(i&1)?(NQB-1-j):j; return true; }
  __device__ __forceinline__ void a_ready(const AttnUnit&)const{}
  __device__ __forceinline__ void done(const AttnUnit&)const{}
};
template<class Sched,int THRL=64> __device__ __forceinline__ void attn_phase(char*lds,const AttnTensors&T,const Sched&S){
  AttnUnit u;
  for(int i=0;S.next(i,u);++i){ S.a_ready(u); attn_unit<THRL>(u.bh/NHEAD,u.bh%NHEAD,u.qb,T.Q,T.K,T.V,T.O,T.BIAS,lds); S.done(u); }
}
#undef SBAR
#undef WAIT_BAR
}
namespace cg = cooperative_groups;
constexpr int NWAVES = 8;
constexpr int BATCH = 16, SEQ = 4096, DMOD = 1024, DEPTH = 4, NHEADS = 8, AW = 512, SW = 512, NGRP = 32, GCH = 16, NST = 64, FF = 4096, NIN = 4104;
constexpr int M = BATCH * SEQ;
constexpr int CL = 16;
constexpr int NCR = M / CL;
constexpr int ASK = 384;
constexpr float RMS_EPS = 1e-6f;

constexpr size_t MiB = 1u << 20;
constexpr size_t WS_CTL = 0, CTL_ZERO_BYTES = 65536, WS_BARW = 16384;
constexpr int MISC_OFF = 131072 + 320;
constexpr size_t WS_WIN = 1 * MiB, WS_WUP = 9 * MiB, WS_WDN = 17 * MiB, WS_WOUT = 25 * MiB, WS_WA = 27 * MiB, WS_WB = 28 * MiB, WS_WGLU = 29 * MiB;
constexpr size_t WS_WSB = 30 * MiB, WS_WSY = 54 * MiB, WS_LPOW = 78 * MiB, SSM_W_LAYER = 6 * MiB;
constexpr size_t WS_LOGF = 79 * MiB, WS_BIAS = 81 * MiB;
constexpr size_t WS_H = 84 * MiB;
constexpr size_t WS_Q = 212 * MiB, WS_K = 276 * MiB, WS_V = 340 * MiB;
constexpr size_t WS_AS = 404 * MiB, WS_SLOC = 500 * MiB;
constexpr size_t WS_GA = 564 * MiB, WS_GB = 692 * MiB;
constexpr size_t WS_HID = 212 * MiB;
constexpr size_t WS_YB = WS_SLOC, WS_YB2 = WS_Q;
constexpr size_t WS_XB = 820 * MiB, WS_END = 948 * MiB;

constexpr int LDS_BYTES = 147456;
#define LAS __attribute__((address_space(3)))
typedef unsigned short bf16;
typedef unsigned v4u __attribute__((ext_vector_type(4)));
typedef float f32x4 __attribute__((ext_vector_type(4)));

__device__ __forceinline__ unsigned f2bf(float f) { unsigned u = __builtin_bit_cast(unsigned, f); return (u + 0x7fffu + ((u >> 16) & 1u)) >> 16; }
__device__ __forceinline__ unsigned pk2(float lo, float hi) { return f2bf(lo) | (f2bf(hi) << 16); }
__device__ __forceinline__ float wave_sum(float v, int lane) {
#pragma unroll
    for (int o = 1; o < 64; o <<= 1) v += __int_as_float(__builtin_amdgcn_ds_bpermute((lane ^ o) << 2, __float_as_int(v)));
    return v;
}
__device__ __forceinline__ void transpose_item(const float* W, int ldw, int K, int nblk, bf16* WT, int dst_row0, int src_col0, LAS float* scr, int item, int lane) {
    const int kb = item / nblk, nb = item % nblk, k0 = 64 * kb, n0 = 32 * nb;
#pragma unroll 8
    for (int i = 0; i < 32; ++i) { const int kk = 2 * i + (lane >> 5); scr[kk * 33 + (lane & 31)] = W[(size_t)(k0 + kk) * ldw + src_col0 + n0 + (lane & 31)]; }
    asm volatile("s_waitcnt lgkmcnt(0)" ::: "memory");
    const int c = lane & 7;
#pragma unroll
    for (int j = 0; j < 4; ++j) { const int n = (lane >> 3) + 8 * j; const LAS float* s = scr + (8 * c) * 33 + n;
        v4u o; o.x = pk2(s[0 * 33], s[1 * 33]); o.y = pk2(s[2 * 33], s[3 * 33]); o.z = pk2(s[4 * 33], s[5 * 33]); o.w = pk2(s[6 * 33], s[7 * 33]);
        *(v4u*)(WT + (size_t)(dst_row0 + n0 + n) * K + k0 + 8 * c) = o; }
    asm volatile("s_waitcnt lgkmcnt(0)" ::: "memory");
}

struct Args { const float* in[21]; float* out; unsigned char* ws; };

__device__ __forceinline__ void ssm_tables(const Args& a, int l, int g, unsigned char* ws, LAS unsigned char* lds, int tid) {
    typedef float f2 __attribute__((ext_vector_type(2)));
    LAS f2* P = (LAS f2*)lds;
    LAS f2* Qv = P + 17 * 64;
    LAS f2* Bb = Qv + 64;
    LAS f2* Cc = Bb + 64 * 16;
    LAS float* Km = (LAS float*)(Cc + 16 * 64);
    const float* lam_re = a.in[4] + (size_t)(l * NGRP + g) * NST; const float* lam_im = a.in[5] + (size_t)(l * NGRP + g) * NST;
    const float logdt = a.in[6][l * NGRP + g];
    const float* b_re = a.in[7] + (size_t)(l * NGRP + g) * NST * GCH; const float* b_im = a.in[8] + (size_t)(l * NGRP + g) * NST * GCH;
    const float* c_re = a.in[9] + (size_t)(l * NGRP + g) * GCH * NST; const float* c_im = a.in[10] + (size_t)(l * NGRP + g) * GCH * NST;
    const float* dsk = a.in[11] + (size_t)l * SW + g * GCH;
    const double dt = exp((double)logdt);
    for (int it = tid; it < 17 * 64; it += NWAVES * 64) { const int j = it >> 6, p = it & 63;
        const double ar = (double)lam_re[p] * dt, ai = (double)lam_im[p] * dt; const double mg = exp(ar * j), an = ai * j;
        const double pr = mg * cos(an), pi = mg * sin(an); P[it] = (f2){(float)pr, (float)pi};
        if (j == 1) { const double lr = lam_re[p], li = lam_im[p], nr = pr - 1.0, ni = pi, den = lr * lr + li * li;
            Qv[p] = (f2){(float)((nr * lr + ni * li) / den), (float)((ni * lr - nr * li) / den)}; } }
    __syncthreads();
    for (int it = tid; it < 1024; it += NWAVES * 64) { const int p = it >> 4; const f2 q = Qv[p]; const float br = b_re[it], bi = b_im[it];
        Bb[it] = (f2){q.x * br - q.y * bi, q.x * bi + q.y * br}; Cc[it] = (f2){c_re[it], c_im[it]}; }
    __syncthreads();
    for (int e = tid; e < 4096; e += NWAVES * 64) { const int ck = e & 15, c = (e >> 4) & 15, j = e >> 8; float s = 0.f;
        for (int p = 0; p < 64; ++p) { const f2 cc = Cc[c * 64 + p], pp = P[j * 64 + p], bb = Bb[p * 16 + ck];
            const float xr = cc.x * pp.x - cc.y * pp.y, xi = cc.x * pp.y + cc.y * pp.x; s += xr * bb.x - xi * bb.y; }
        Km[e] = s; }
    __syncthreads();
    bf16* WSB = (bf16*)(ws + WS_WSB + (size_t)l * SSM_W_LAYER) + (size_t)g * 256 * ASK; bf16* WSY = (bf16*)(ws + WS_WSY + (size_t)l * SSM_W_LAYER) + (size_t)g * 256 * ASK;
    for (int q = tid; q < 256 * 48; q += NWAVES * 64) { const int n = q / 48, k0 = (q % 48) * 8; float vy[8], vb[8];
        const int tl = n >> 4, c = n & 15;
        if (k0 < 256) { const int tk = k0 >> 4, ck0 = k0 & 15;
#pragma unroll
            for (int e = 0; e < 8; ++e) { float v = 0.f; if (tk <= tl) { v = Km[((tl - tk) * 16 + c) * 16 + ck0 + e]; if (tk == tl && ck0 + e == c) v += dsk[c]; } vy[e] = v; }
            if (n < 128) { const int p = n & 63; const f2 pw = P[(15 - tk) * 64 + p];
#pragma unroll
                for (int e = 0; e < 8; ++e) { const f2 bb = Bb[p * 16 + ck0 + e]; vb[e] = (n < 64) ? (pw.x * bb.x - pw.y * bb.y) : (pw.x * bb.y + pw.y * bb.x); } }
            else {
#pragma unroll
                for (int e = 0; e < 8; ++e) vb[e] = 0.f; }
        } else { const int p0 = (k0 - 256) & 63; const bool im = k0 >= 320;
#pragma unroll
            for (int e = 0; e < 8; ++e) { const f2 L = P[(tl + 1) * 64 + p0 + e], cc = Cc[c * 64 + p0 + e]; vy[e] = im ? -(cc.x * L.y + cc.y * L.x) : (cc.x * L.x - cc.y * L.y); vb[e] = 0.f; } }
        v4u oy, ob; oy.x = pk2(vy[0], vy[1]); oy.y = pk2(vy[2], vy[3]); oy.z = pk2(vy[4], vy[5]); oy.w = pk2(vy[6], vy[7]);
        ob.x = pk2(vb[0], vb[1]); ob.y = pk2(vb[2], vb[3]); ob.z = pk2(vb[4], vb[5]); ob.w = pk2(vb[6], vb[7]);
        *(v4u*)(WSY + (size_t)n * ASK + k0) = oy; *(v4u*)(WSB + (size_t)n * ASK + k0) = ob; }
    if (tid < 64) ((f2*)(ws + WS_LPOW))[(l * NGRP + g) * 64 + tid] = P[16 * 64 + tid];
    __syncthreads();
}

__device__ __forceinline__ float bperm(int lanesel, float v) { return __int_as_float(__builtin_amdgcn_ds_bpermute(lanesel << 2, __float_as_int(v))); }
template <bool FORGET, int R>
__device__ __forceinline__ void norm_rows(const float* X, const bf16* XBr, bf16* XBw, const float* gvec, bf16* H, const float* win  , const float* bfg, float* LOGF, int gw, int NGW, int lane) {
    f32x4 gv[4];
#pragma unroll
    for (int j = 0; j < 4; ++j) gv[j] = *((const f32x4*)gvec + lane + 64 * j);
    f32x4 wf[4][4][2];
    if (FORGET) {
#pragma unroll
        for (int j = 0; j < 4; ++j)
#pragma unroll
            for (int e = 0; e < 4; ++e) { const int k = 256 * j + 4 * lane + e; const float* wp = win + (size_t)k * NIN + 1536;
                wf[j][e][0] = *(const f32x4*)wp * gv[j][e]; wf[j][e][1] = *(const f32x4*)(wp + 4) * gv[j][e]; }
    }
    const int hsel = 4 * (lane & 1) + 2 * ((lane >> 1) & 1) + ((lane >> 2) & 1);
    const float bfv = FORGET ? bfg[hsel] : 0.f;
    for (int m0 = gw; m0 < M; m0 += NGW * R) {
        f32x4 v[R][4]; float s[R];
#pragma unroll
        for (int r = 0; r < R; ++r) { const int m = m0 + r * NGW; const size_t mr = (size_t)(m < M ? m : m0);
            if (X) { const f32x4* xr = (const f32x4*)(X + mr * DMOD) + lane; unsigned long long* xw = (unsigned long long*)(XBw + mr * DMOD) + lane;
#pragma unroll
                for (int j = 0; j < 4; ++j) { v[r][j] = xr[64 * j]; const unsigned lo = pk2(v[r][j].x, v[r][j].y), hi = pk2(v[r][j].z, v[r][j].w); xw[64 * j] = (unsigned long long)lo | ((unsigned long long)hi << 32);
                    v[r][j] = (f32x4){__uint_as_float(lo << 16), __uint_as_float(lo & 0xffff0000u), __uint_as_float(hi << 16), __uint_as_float(hi & 0xffff0000u)}; } }
            else { const unsigned long long* xr = (const unsigned long long*)(XBr + mr * DMOD) + lane;
#pragma unroll
                for (int j = 0; j < 4; ++j) { const unsigned long long w = xr[64 * j]; const unsigned lo = (unsigned)w, hi = (unsigned)(w >> 32);
                    v[r][j] = (f32x4){__uint_as_float(lo << 16), __uint_as_float(lo & 0xffff0000u), __uint_as_float(hi << 16), __uint_as_float(hi & 0xffff0000u)}; } } }
#pragma unroll
        for (int r = 0; r < R; ++r) { float t = 0.f;
#pragma unroll
            for (int j = 0; j < 4; ++j) t += (v[r][j].x * v[r][j].x + v[r][j].y * v[r][j].y) + (v[r][j].z * v[r][j].z + v[r][j].w * v[r][j].w);
            s[r] = t; }
#pragma unroll
        for (int o = 1; o < 64; o <<= 1)
#pragma unroll
            for (int r = 0; r < R; ++r) s[r] += bperm(lane ^ o, s[r]);
#pragma unroll
        for (int r = 0; r < R; ++r) { const int m = m0 + r * NGW; if (m >= M) break;
            const float rstd = 1.0f / sqrtf(s[r] * (1.f / DMOD) + RMS_EPS);
            unsigned long long* o8 = (unsigned long long*)(H + (size_t)m * DMOD) + lane;
#pragma unroll
            for (int j = 0; j < 4; ++j) { const f32x4 h = v[r][j] * rstd * gv[j]; o8[64 * j] = (unsigned long long)pk2(h.x, h.y) | ((unsigned long long)pk2(h.z, h.w) << 32); }
            if (FORGET) {
                f32x4 a0 = {0.f, 0.f, 0.f, 0.f}, a1 = {0.f, 0.f, 0.f, 0.f};
#pragma unroll
                for (int j = 0; j < 4; ++j)
#pragma unroll
                    for (int e = 0; e < 4; ++e) { a0 += wf[j][e][0] * v[r][j][e]; a1 += wf[j][e][1] * v[r][j][e]; }
                const bool b0 = lane & 1, b1 = lane & 2, b2 = lane & 4; float t4[4], t2[2];
#pragma unroll
                for (int i = 0; i < 4; ++i) { const float snd = b0 ? a0[i] : a1[i], kp = b0 ? a1[i] : a0[i]; t4[i] = kp + bperm(lane ^ 1, snd); }
#pragma unroll
                for (int i = 0; i < 2; ++i) { const float snd = b1 ? t4[i] : t4[2 + i], kp = b1 ? t4[2 + i] : t4[i]; t2[i] = kp + bperm(lane ^ 2, snd); }
                float w = (b2 ? t2[1] : t2[0]) + bperm(lane ^ 4, b2 ? t2[0] : t2[1]);
                w += bperm(lane ^ 8, w); w += bperm(lane ^ 16, w); w += bperm(lane ^ 32, w);
                if (lane < 8) { const float z = w * rstd + bfv;
                    const float ls = fminf(z, 0.f) - 0.6931471805599453f * __builtin_amdgcn_logf(1.0f + __builtin_amdgcn_exp2f(-fabsf(z) * 1.4426950408889634f));
                    LOGF[(size_t)m * 8 + hsel] = ls; }
            }
        }
    }
}
template <int R>
__device__ __forceinline__ void norm_rows_final(const bf16* XBr, float* OUT, const float* gvec, int gw, int NGW, int lane) {
    f32x4 gv[4];
#pragma unroll
    for (int j = 0; j < 4; ++j) gv[j] = *((const f32x4*)gvec + lane + 64 * j);
    for (int m0 = gw; m0 < M; m0 += NGW * R) {
        f32x4 v[R][4]; float s[R];
#pragma unroll
        for (int r = 0; r < R; ++r) { const int m = m0 + r * NGW; const unsigned long long* xr = (const unsigned long long*)(XBr + (size_t)(m < M ? m : m0) * DMOD) + lane;
#pragma unroll
            for (int j = 0; j < 4; ++j) { const unsigned long long w = xr[64 * j]; const unsigned lo = (unsigned)w, hi = (unsigned)(w >> 32);
                v[r][j] = (f32x4){__uint_as_float(lo << 16), __uint_as_float(lo & 0xffff0000u), __uint_as_float(hi << 16), __uint_as_float(hi & 0xffff0000u)}; } }
#pragma unroll
        for (int r = 0; r < R; ++r) { float t = 0.f;
#pragma unroll
            for (int j = 0; j < 4; ++j) t += (v[r][j].x * v[r][j].x + v[r][j].y * v[r][j].y) + (v[r][j].z * v[r][j].z + v[r][j].w * v[r][j].w);
            s[r] = t; }
#pragma unroll
        for (int o = 1; o < 64; o <<= 1)
#pragma unroll
            for (int r = 0; r < R; ++r) s[r] += bperm(lane ^ o, s[r]);
#pragma unroll
        for (int r = 0; r < R; ++r) { const int m = m0 + r * NGW; if (m >= M) break;
            const float rstd = 1.0f / sqrtf(s[r] * (1.f / DMOD) + RMS_EPS); f32x4* xw = (f32x4*)(OUT + (size_t)m * DMOD) + lane;
#pragma unroll
            for (int j = 0; j < 4; ++j) xw[64 * j] = v[r][j] * rstd * gv[j]; }
    }
}

#define XB_TMO      128
#define XB_XCNT(j)  (256  + 64 * (j))
#define XB_XSUB(j)  (1280 + 64 * (j))
#define XB_XGEN(j)  (2304 + 64 * (j))
#define XB_TOP      3328
#define XB_TOPGEN   3392
#define XCD_BAR_WORDS 3456
#define XB_SPIN_CAP (1u << 18)

__device__ __forceinline__ unsigned xb_ld(unsigned* p)              { return __hip_atomic_load(p, __ATOMIC_RELAXED, __HIP_MEMORY_SCOPE_AGENT); }
__device__ __forceinline__ unsigned xb_add(unsigned* p, unsigned v) { return __hip_atomic_fetch_add(p, v, __ATOMIC_RELAXED, __HIP_MEMORY_SCOPE_AGENT); }
__device__ __forceinline__ unsigned xb_xcc_id() { return (unsigned)__builtin_amdgcn_s_getreg((3 << 11) | 20) & 0xFu; }
#define XB_SPIN(cond, bar) do { unsigned _sp = 0; while (cond) { __builtin_amdgcn_s_sleep(1); \
    if ((++_sp & 255u) == 0u) { if (xb_ld(&(bar)[XB_TMO])) break; if (_sp > XB_SPIN_CAP) { atomicAdd(&(bar)[XB_TMO], 1u); break; } } } } while (0)

struct XcdBarrier {
    unsigned* bar; unsigned x;
    volatile LAS unsigned* st;
};

__device__ __forceinline__ XcdBarrier xcd_barrier_post(unsigned* bar, volatile LAS unsigned* st) {
    XcdBarrier b; b.bar = bar; b.x = xb_xcc_id(); b.st = st;
    if (threadIdx.x == 0) (void)xb_add(&bar[XB_XCNT(b.x)], 1u);
    return b;
}
__device__ __forceinline__ void xcd_barrier_complete(unsigned* bar, unsigned x, unsigned& nloc, unsigned& nx) {
    const unsigned G = gridDim.x * gridDim.y * gridDim.z;
    unsigned sum, cnt, mine, sp = 0u;
    for (;;) {
        sum = 0u; cnt = 0u; mine = 0u;
#pragma unroll
        for (unsigned j = 0; j < 16; ++j) { const unsigned c = xb_ld(&bar[XB_XCNT(j)]); sum += c; cnt += (c > 0u) ? 1u : 0u; mine = (j == x) ? c : mine; }
        if (sum == G) break;
        __builtin_amdgcn_s_sleep(1);
        if ((++sp & 255u) == 0u) { if (xb_ld(&bar[XB_TMO])) break; if (sp > XB_SPIN_CAP) { atomicAdd(&bar[XB_TMO], 1u); break; } }
    }
    nloc = mine > 0u ? mine : 1u; nx = cnt > 0u ? cnt : 1u;
}

__device__ __forceinline__ void xcd_barrier(const XcdBarrier& b) {
    asm volatile("s_waitcnt vmcnt(0)" ::: "memory");
    __syncthreads();
    if (threadIdx.x == 0) {
        unsigned* bar = b.bar;
        __builtin_amdgcn_s_waitcnt(0);
        unsigned nloc = b.st[0], nx = b.st[1];
        if (nloc == 0u) { xcd_barrier_complete(bar, b.x, nloc, nx); b.st[0] = nloc; b.st[1] = nx; }
        const unsigned old = xb_add(&bar[XB_XSUB(b.x)], 1u);
        const unsigned gen = old / nloc;
        if (old + 1u == (gen + 1u) * nloc) {
            __builtin_amdgcn_fence(__ATOMIC_RELEASE, "agent");
            asm volatile("s_waitcnt vmcnt(0)" ::: "memory");
            const unsigned og = xb_add(&bar[XB_TOP], 1u);
            const unsigned tg = og / nx;
            if (og + 1u == (tg + 1u) * nx) xb_add(&bar[XB_TOPGEN], 1u);
            else XB_SPIN(xb_ld(&bar[XB_TOPGEN]) == tg, bar);
            __builtin_amdgcn_fence(__ATOMIC_ACQUIRE, "agent");
            xb_add(&bar[XB_XGEN(b.x)], 1u);
            asm volatile("s_waitcnt vmcnt(0)" ::: "memory");
        } else {
            XB_SPIN(xb_ld(&bar[XB_XGEN(b.x)]) == gen, bar);
            __builtin_amdgcn_fence(__ATOMIC_ACQUIRE, "agent");
            asm volatile("s_waitcnt vmcnt(0)" ::: "memory");
        }
    }
    __syncthreads();
}
#ifndef PHMASK
#define PHMASK 0xFFFF
#endif
#ifndef SMALLK_ALIGN
#define SMALLK_ALIGN true
#endif
#ifndef BIGK_ALIGN
#define BIGK_ALIGN true
#endif
#ifndef DUPMASK
#define DUPMASK 0
#endif
__global__ void __launch_bounds__(NWAVES * 64, 2) fwd_megakernel(Args args) {
    extern __shared__ __attribute__((aligned(16))) unsigned char lds[];
    cg::grid_group grid = cg::this_grid();
    {
        volatile LAS unsigned* misc = (volatile LAS unsigned*)((LAS unsigned char*)lds + MISC_OFF);
        if (threadIdx.x < 32) misc[threadIdx.x] = 0u;
        __syncthreads();
    }
    XcdBarrier xbar = xcd_barrier_post((unsigned*)(args.ws + WS_CTL + WS_BARW), (volatile LAS unsigned*)((LAS unsigned char*)lds + MISC_OFF) + 8);
    if (args.ws == nullptr) grid.sync();
    LAS unsigned char* L = (LAS unsigned char*)lds;
    const int G = gridDim.x, bx = blockIdx.x, NGW = G * NWAVES;
#define TID_OPAQUE() int tid_ = threadIdx.x; asm volatile("" : "+v"(tid_)); const int tid = tid_, lane = tid & 63, wave = __builtin_amdgcn_readfirstlane(tid >> 6), gw = bx * NWAVES + wave; (void)tid; (void)lane; (void)gw
    float* out = args.out;
#define GASP __attribute__((address_space(1)))
#define WS_OPAQUE() GASP unsigned char* ws = (GASP unsigned char*)args.ws; asm volatile("" : "+s"(ws))
#define WSP(T, off) ((T*)(GASP T*)(ws + (off)))
#define GRID_SYNC1() xcd_barrier(xbar)
#ifdef DUPSYNC
#define GRID_SYNC() do { GRID_SYNC1(); GRID_SYNC1(); } while (0)
#else
#define GRID_SYNC() GRID_SYNC1()
#endif
    { TID_OPAQUE(); WS_OPAQUE(); for (int it = bx; it < DEPTH * NGRP; it += G) ssm_tables(args, it >> 5, it & 31, (unsigned char*)ws, L, tid); }
    for (int l_ = 0; l_ < DEPTH; ++l_) {
        int l = l_; asm volatile("" : "+s"(l));
#if (PHMASK >> 0) & 1
        for (int rep_ = 0; rep_ < (int)((DUPMASK >> 0) & 1) + 1; ++rep_) {
        {
            TID_OPAQUE(); WS_OPAQUE(); bf16* Win_t = WSP(bf16, WS_WIN); bf16* Wup_t = WSP(bf16, WS_WUP); bf16* Wdn_t = WSP(bf16, WS_WDN); bf16* Wout_t = WSP(bf16, WS_WOUT);
            bf16* Wa_t = WSP(bf16, WS_WA); bf16* Wb_t = WSP(bf16, WS_WB); bf16* Wglu_t = WSP(bf16, WS_WGLU); bf16* H = WSP(bf16, WS_H); float* LOGF = WSP(float, WS_LOGF);
            LAS float* scr = (LAS float*)(L + wave * 16384);
            const float* w_in = args.in[2] + (size_t)l * DMOD * NIN; const float* w_glu = args.in[12] + (size_t)l * SW * SW;
            const float* w_a = args.in[14] + (size_t)l * AW * DMOD; const float* w_b = args.in[15] + (size_t)l * SW * DMOD; const float* w_out = args.in[16] + (size_t)l * DMOD * DMOD;
            const float* w_up = args.in[18] + (size_t)l * DMOD * FF; const float* w_dn = args.in[19] + (size_t)l * FF * DMOD;
            constexpr int I_IN = 16 * 128, I_GLU = 8 * 16, I_A = 8 * 32, I_B = 8 * 32, I_OUT = 16 * 32, I_UP = 16 * 128, I_DN = 64 * 32;
            constexpr int NITEMS = I_IN + I_GLU + I_A + I_B + I_OUT + I_UP + I_DN;
            for (int it = gw; it < NITEMS; it += NGW) {
                int r = it;
                if (r < I_IN) { const int nb = r % 128; const int sc0 = (nb >= 48) ? 8 : 0;
                    transpose_item(w_in, NIN, DMOD, 128, Win_t, 0, sc0, scr, r, lane); continue; } r -= I_IN;
                if (r < I_GLU) { transpose_item(w_glu, SW, SW, 16, Wglu_t, 0, 0, scr, r, lane); continue; } r -= I_GLU;
                if (r < I_A) { transpose_item(w_a, DMOD, AW, 32, Wa_t, 0, 0, scr, r, lane); continue; } r -= I_A;
                if (r < I_B) { transpose_item(w_b, DMOD, SW, 32, Wb_t, 0, 0, scr, r, lane); continue; } r -= I_B;
                if (r < I_OUT) { transpose_item(w_out, DMOD, DMOD, 32, Wout_t, 0, 0, scr, r, lane); continue; } r -= I_OUT;
                if (r < I_UP) { transpose_item(w_up, FF, DMOD, 128, Wup_t, 0, 0, scr, r, lane); continue; } r -= I_UP;
                transpose_item(w_dn, DMOD, FF, 32, Wdn_t, 0, 0, scr, r, lane);
            }
            norm_rows<true, 2>(l == 0 ? args.in[0] : nullptr, WSP(bf16, WS_XB), WSP(bf16, WS_XB), args.in[1] + (size_t)l * DMOD, H, w_in, args.in[3] + (size_t)l * NHEADS, LOGF, gw, NGW, lane);
        }
        }
#endif
        GRID_SYNC();
#if (PHMASK >> 1) & 1
        for (int rep_ = 0; rep_ < (int)((DUPMASK >> 1) & 1) + 1; ++rep_) {
        {
            WS_OPAQUE(); bf16* H = WSP(bf16, WS_H); bf16* Win_t = WSP(bf16, WS_WIN); bf16* Qb = WSP(bf16, WS_Q); bf16* AS = WSP(bf16, WS_AS); bf16* GA = WSP(bf16, WS_GA);
            static_assert(WS_V - WS_K == WS_K - WS_Q, "Q|K|V equally spaced");
            pg8::Gemm g{H, Win_t, M, 4096, DMOD}; pg8::StaticOrder S; S.init(M, 4096, G, bx);
            pg8::EpiInProj E{Qb, AS, GA, (size_t)(WS_K - WS_Q) / 2, (size_t)(WS_GB - WS_GA) / 2};
            pg8::gemm_phase<pg8::EpiInProj, pg8::StaticOrder, BIGK_ALIGN, true>(L, g, S, E);
        }
        }
#endif
        GRID_SYNC();
#if (PHMASK >> 2) & 1
        for (int rep_ = 0; rep_ < (int)((DUPMASK >> 2) & 1) + 1; ++rep_) {
        {
            WS_OPAQUE(); bf16* AS = WSP(bf16, WS_AS); bf16* WSB_t = WSP(bf16, WS_WSB + (size_t)l * SSM_W_LAYER); float* SLOC = WSP(float, WS_SLOC);
            pg8::Gemm g{AS, WSB_t, NGRP * NCR, NGRP * 256, ASK}; pg8::SsmOrder S{G, bx};
            pg8::EpiSsmState E{SLOC};
            pg8::gemm_phase<pg8::EpiSsmState, pg8::SsmOrder, SMALLK_ALIGN, true>(L, g, S, E);
        }
        }
#endif
#if (PHMASK >> 3) & 1
        for (int rep_ = 0; rep_ < (int)((DUPMASK >> 3) & 1) + 1; ++rep_) {
        {
            typedef float f2 __attribute__((ext_vector_type(2)));
            TID_OPAQUE(); WS_OPAQUE(); bf16* AS = WSP(bf16, WS_AS); float* SLOC = WSP(float, WS_SLOC); float* LOGF = WSP(float, WS_LOGF); float* BIAS = WSP(float, WS_BIAS);
            if ((wave & 1) == 0) {
                for (int i = 0; i * G + bx < NGRP * BATCH; ++i) { if (wave != ((2 * i) & 7)) continue; const int it = i * G + bx; const int g = it >> 4, b = it & 15;
                    const f2 l16 = WSP(const f2, WS_LPOW)[(l * NGRP + g) * 64 + lane];
                    const float* sl = SLOC + ((size_t)(g * NCR + b * 256)) * 128 + lane; bf16* as = AS + ((size_t)(g * NCR + b * 256)) * ASK + 256 + lane;
                    float sr = 0.f, si = 0.f;
#pragma unroll 64
                    for (int ch = 0; ch < 256; ++ch) { as[(size_t)ch * ASK] = (bf16)f2bf(sr); as[(size_t)ch * ASK + 64] = (bf16)f2bf(si);
                        const float ar = sl[(size_t)ch * 128], ai = sl[(size_t)ch * 128 + 64];
                        const float nr = l16.x * sr - l16.y * si + ar, ni = l16.x * si + l16.y * sr + ai; sr = nr; si = ni; } }
            } else if ((gw & 3) == 1) {
                for (int sq = gw >> 2; sq < BATCH * NHEADS; sq += NGW >> 2) { const int b = sq >> 3, h = sq & 7;
                    const float* lf = LOGF + ((size_t)b * SEQ + lane * 64) * 8 + h; float tot = 0.f;
#pragma unroll
                    for (int i = 0; i < 64; ++i) tot += lf[i * 8];
                    float incl = tot;
#pragma unroll
                    for (int o = 1; o < 64; o <<= 1) { const float t = __int_as_float(__builtin_amdgcn_ds_bpermute((lane - o) << 2, __float_as_int(incl))); if (lane >= o) incl += t; }
                    float run = incl - tot; float* bo = BIAS + (size_t)sq * SEQ + lane * 64;
#pragma unroll
                    for (int i = 0; i < 64; ++i) { run += lf[i * 8]; bo[i] = -run * 1.4426950408889634f; } }
            }
        }
        }
#endif
        GRID_SYNC();
#if (PHMASK >> 4) & 1
        for (int rep_ = 0; rep_ < (int)((DUPMASK >> 4) & 1) + 1; ++rep_) {
        {
            WS_OPAQUE(); bf16* AS = WSP(bf16, WS_AS); bf16* WSY_t = WSP(bf16, WS_WSY + (size_t)l * SSM_W_LAYER); bf16* YB = WSP(bf16, WS_YB);
            pg8::Gemm g{AS, WSY_t, NGRP * NCR, NGRP * 256, ASK}; pg8::SsmOrder S{G, bx};
            pg8::EpiSsmY E{YB};
            pg8::gemm_phase<pg8::EpiSsmY, pg8::SsmOrder, SMALLK_ALIGN, true>(L, g, S, E);
        }
        {
            WS_OPAQUE(); bf16* Qb = WSP(bf16, WS_Q); bf16* Kb = WSP(bf16, WS_K); bf16* Vb = WSP(bf16, WS_V); float* BIAS = WSP(float, WS_BIAS);
            const attn_body::AttnTensors AT{(const attn_body::bf16*)Qb, (const attn_body::bf16*)Kb, (const attn_body::bf16*)Vb, (attn_body::bf16*)WSP(bf16, WS_H), BIAS};
            const attn_body::StaticOrder S(G, bx);
#ifndef NO_ATTN
            attn_body::attn_phase<attn_body::StaticOrder>((char*)lds, AT, S);
        }
#endif
        }
#endif
        GRID_SYNC();
#if (PHMASK >> 5) & 1
        for (int rep_ = 0; rep_ < (int)((DUPMASK >> 5) & 1) + 1; ++rep_) {
        {
            WS_OPAQUE(); bf16* YB = WSP(bf16, WS_YB); bf16* YB2 = WSP(bf16, WS_YB2); bf16* Wglu_t = WSP(bf16, WS_WGLU);
            pg8::Gemm g{YB, Wglu_t, M, SW, SW}; pg8::StaticOrder S; S.init(M, SW, G, bx);
            pg8::EpiGlu E{YB, YB2, args.in[13] + (size_t)l * SW};
            pg8::gemm_phase<pg8::EpiGlu, pg8::StaticOrder, SMALLK_ALIGN, true>(L, g, S, E);
        }
        }
#endif
#if (PHMASK >> 6) & 1
        for (int rep_ = 0; rep_ < (int)((DUPMASK >> 6) & 1) + 1; ++rep_) {
        {
            WS_OPAQUE(); bf16* Qb = WSP(bf16, WS_H)  ; bf16* Wa_t = WSP(bf16, WS_WA); bf16* GA = WSP(bf16, WS_GA); bf16* MIXED = WSP(bf16, WS_K)  ;
            pg8::Gemm g{Qb, Wa_t, M, DMOD, AW}; pg8::StaticOrder S; S.init(M, DMOD, G, bx);
            pg8::EpiGate<false> E{GA, MIXED};
            pg8::gemm_phase<pg8::EpiGate<false>, pg8::StaticOrder, SMALLK_ALIGN, true>(L, g, S, E);
        }
        }
#endif
        GRID_SYNC();
#if (PHMASK >> 7) & 1
        for (int rep_ = 0; rep_ < (int)((DUPMASK >> 7) & 1) + 1; ++rep_) {
        {
            WS_OPAQUE(); bf16* YB2 = WSP(bf16, WS_YB2); bf16* Wb_t = WSP(bf16, WS_WB); bf16* GB = WSP(bf16, WS_GB); bf16* MIXED = WSP(bf16, WS_K);
            pg8::Gemm g{YB2, Wb_t, M, DMOD, SW}; pg8::StaticOrder S; S.init(M, DMOD, G, bx);
            pg8::EpiGate<true> E{GB, rep_ ? WSP(bf16, WS_H) : MIXED};
            pg8::gemm_phase<pg8::EpiGate<true>, pg8::StaticOrder, SMALLK_ALIGN, true>(L, g, S, E);
        }
        }
#endif
        GRID_SYNC();
#if (PHMASK >> 8) & 1
        for (int rep_ = 0; rep_ < (int)((DUPMASK >> 8) & 1) + 1; ++rep_) {
        {
            WS_OPAQUE(); bf16* MIXED = WSP(bf16, WS_K); bf16* Wout_t = WSP(bf16, WS_WOUT);
            pg8::Gemm g{MIXED, Wout_t, M, DMOD, DMOD}; pg8::StaticOrder S; S.init(M, DMOD, G, bx);
            pg8::EpiResid E{rep_ ? WSP(bf16, WS_H) : WSP(bf16, WS_XB)};
            pg8::gemm_phase<pg8::EpiResid, pg8::StaticOrder, BIGK_ALIGN, true>(L, g, S, E);
        }
        }
#endif
        GRID_SYNC();
#if (PHMASK >> 9) & 1
        for (int rep_ = 0; rep_ < (int)((DUPMASK >> 9) & 1) + 1; ++rep_) {
        { TID_OPAQUE(); WS_OPAQUE(); norm_rows<false, 4>(nullptr, WSP(bf16, WS_XB), nullptr, args.in[17] + (size_t)l * DMOD, WSP(bf16, WS_H), nullptr, nullptr, nullptr, gw, NGW, lane); }
        }
#endif
        GRID_SYNC();
#if (PHMASK >> 10) & 1
        for (int rep_ = 0; rep_ < (int)((DUPMASK >> 10) & 1) + 1; ++rep_) {
        {
            WS_OPAQUE(); bf16* H = WSP(bf16, WS_H); bf16* Wup_t = WSP(bf16, WS_WUP); bf16* HID = WSP(bf16, WS_HID);
            pg8::Gemm g{H, Wup_t, M, FF, DMOD}; pg8::StaticOrder S; S.init(M, FF, G, bx);
            pg8::EpiRelu2 E{HID};
            pg8::gemm_phase<pg8::EpiRelu2, pg8::StaticOrder, BIGK_ALIGN, true>(L, g, S, E);
        }
        }
#endif
        GRID_SYNC();
#if (PHMASK >> 11) & 1
        for (int rep_ = 0; rep_ < (int)((DUPMASK >> 11) & 1) + 1; ++rep_) {
        {
            WS_OPAQUE(); bf16* HID = WSP(bf16, WS_HID); bf16* Wdn_t = WSP(bf16, WS_WDN);
            pg8::Gemm g{HID, Wdn_t, M, DMOD, FF}; pg8::StaticOrder S; S.init(M, DMOD, G, bx);
            pg8::EpiResid E{rep_ ? WSP(bf16, WS_H) : WSP(bf16, WS_XB)};
            pg8::gemm_phase<pg8::EpiResid, pg8::StaticOrder, BIGK_ALIGN, true>(L, g, S, E);
        }
        }
#endif
        GRID_SYNC();
    }
    { TID_OPAQUE(); WS_OPAQUE(); norm_rows_final<4>(WSP(bf16, WS_XB), out, args.in[20], gw, NGW, lane); }
}

extern "C" void kernel_launch(void* const* d_in, const int* in_sizes, int n_in, void* d_out, int out_size, void* d_ws, size_t ws_size, hipStream_t stream) {
    static int grid = 0;
    if (grid == 0) {
        if (n_in != 21 || in_sizes[0] != M * DMOD || out_size != M * DMOD || ws_size < WS_END) {
            fprintf(stderr, "kernel_launch: unexpected shapes: n_in %d in0 %d out %d ws %zu (need %zu)\n", n_in, n_in > 0 ? in_sizes[0] : -1, out_size, ws_size, (size_t)WS_END); grid = -1; return; }
        int dev = 0, cus = 0, per_cu = 0;
        hipGetDevice(&dev); hipDeviceGetAttribute(&cus, hipDeviceAttributeMultiprocessorCount, dev);
        if (hipFuncSetAttribute((const void*)fwd_megakernel, hipFuncAttributeMaxDynamicSharedMemorySize, LDS_BYTES) != hipSuccess) { fprintf(stderr, "kernel_launch: hipFuncSetAttribute failed\n"); grid = -1; return; }
        if (hipOccupancyMaxActiveBlocksPerMultiprocessor(&per_cu, (const void*)fwd_megakernel, NWAVES * 64, LDS_BYTES) != hipSuccess || per_cu < 1) per_cu = 1;
        (void)hipGetLastError();
        grid = cus * per_cu;
    }
    if (grid < 0) return;
    if (hipMemsetAsync((char*)d_ws + WS_CTL, 0, CTL_ZERO_BYTES, stream) != hipSuccess) { fprintf(stderr, "kernel_launch: hipMemsetAsync failed\n"); return; }
    Args a{};
    for (int i = 0; i < 21; ++i) a.in[i] = (const float*)d_in[i];
    a.out = (float*)d_out; a.ws = (unsigned char*)d_ws;
    void* kargs[] = {&a};
    hipError_t e = hipLaunchCooperativeKernel((const void*)fwd_megakernel, dim3(grid), dim3(NWAVES * 64), kargs, LDS_BYTES, stream);
    if (e != hipSuccess) fprintf(stderr, "cooperative launch failed: %s (grid %d)\n", hipGetErrorString(e), grid);
}
```

```cpp
#include <hip/hip_runtime.h>
#include <hip/hip_cooperative_groups.h>
#include <cstdio>
#include <cstdint>
namespace pg8 {
#define PG8_LAS __attribute__((address_space(3)))
typedef unsigned short bf16_t;
typedef short bf16x8 __attribute__((ext_vector_type(8)));
typedef float f32x4 __attribute__((ext_vector_type(4)));
typedef unsigned u32x4 __attribute__((ext_vector_type(4)));
constexpr int BM = 256, BK = 64, HALF = 128, HTB = HALF * BK * 2  , STAGE_BYTES = 8 * HTB, NXCD = 8, WGM = 8;

__host__ __device__ __forceinline__ int lds_byte(int r, int c) { const int st = (r >> 4) * 2 + (c >> 5), rr = r & 15, cc = c & 31, ob = rr * 64 + cc * 2; return st * 1024 + (ob ^ (((ob >> 9) & 1) << 5)); }
__host__ __device__ __forceinline__ void stage_rc(int b, int& R, int& C) { const int st = b / 1024, sb = b % 1024, swz = sb ^ (((sb >> 9) & 1) << 5); R = (st >> 1) * 16 + swz / 64; C = (st & 1) * 32 + (swz % 64) / 2; }
__host__ __device__ __forceinline__ int perm32(int rho) { const int n = rho >> 4, i = rho & 15; return 8 * (i >> 2) + 4 * n + (i & 3); }

struct Unit { int pm, pn; };
struct Gemm { const bf16_t* A; const bf16_t* Bt; int M, N, K; };

struct StaticOrder {
    int nM, nN, nwg, G, c;
    __host__ __device__ void init(int M, int N, int G_, int c_) { nM = M / BM; nN = N / BM; nwg = nM * nN; G = G_; c = c_; }
    __host__ __device__ bool next(int i, Unit& u) const {
        const long L = (long)i * G + c; if (L >= nwg) return false;
        int wgid = (int)L; { const int q = nwg / NXCD, r = nwg % NXCD, xcd = wgid % NXCD, off = wgid / NXCD; wgid = (xcd < r ? xcd * (q + 1) : r * (q + 1) + (xcd - r) * q) + off; }
        const int nig = WGM * nN, gid = wgid / nig, fm = gid * WGM, gsz = (nM - fm) < WGM ? (nM - fm) : WGM;
        u.pm = fm + ((wgid % nig) % gsz); u.pn = (wgid % nig) / gsz; return true;
    }
    __device__ __forceinline__ void a_ready(const Unit&) const {}
    __device__ __forceinline__ void done(const Unit&) const {}
};

typedef float f32x2c_t __attribute__((ext_vector_type(2))); typedef __bf16 bf16x2c_t __attribute__((ext_vector_type(2)));
__device__ __forceinline__ unsigned cvt_pk_bf16(float lo, float hi) { f32x2c_t v = {lo, hi}; bf16x2c_t b = __builtin_convertvector(v, bf16x2c_t); return __builtin_bit_cast(unsigned, b); }
typedef float f32x2 __attribute__((ext_vector_type(2)));
__device__ __forceinline__ f32x2 gelu_pk(f32x2 v) {
    const f32x2 av = __builtin_elementwise_abs(v), d = av * 0.2316418882f + 1.0f;
    f32x2 t; t.x = __builtin_amdgcn_rcpf(d.x); t.y = __builtin_amdgcn_rcpf(d.y);
    f32x2 q = t * 0.5307027145f + (-0.7265760135f); q = q * t + 0.7107068705f; q = q * t + (-0.142248368f); q = q * t + 0.127414796f; q = q * t;
    const f32x2 s = (v * v) * (-0.72134752044f);
    f32x2 e; e.x = __builtin_amdgcn_exp2f(s.x); e.y = __builtin_amdgcn_exp2f(s.y);
    const f32x2 m = v * (q * e), r = v - m;
    f32x2 o; o.x = v.x < 0.f ? m.x : r.x; o.y = v.y < 0.f ? m.y : r.y; return o;
}

constexpr float LOG2E = 1.4426950408889634f;
constexpr float QC2 = 0.125f * 1.4426950408889634f;
__device__ __forceinline__ float sigm(float x) { return __builtin_amdgcn_rcpf(1.0f + __builtin_amdgcn_exp2f(-x * LOG2E)); }
__device__ __forceinline__ float gelu_tanh(float x) { const float z = 1.5957691216057308f * (x + 0.044715f * x * x * x); return x * sigm(z); }
__device__ __forceinline__ u32x4 pack8(const f32x4 v0, const f32x4 v1) { u32x4 w; w.x = cvt_pk_bf16(v0[0], v0[1]); w.y = cvt_pk_bf16(v0[2], v0[3]); w.z = cvt_pk_bf16(v1[0], v1[1]); w.w = cvt_pk_bf16(v1[2], v1[3]); return w; }
__device__ __forceinline__ float bf_lo(unsigned w) { return __uint_as_float(w << 16); }
__device__ __forceinline__ float bf_hi(unsigned w) { return __uint_as_float(w & 0xffff0000u); }
#define EPI_LOOP_BEGIN \
    _Pragma("unroll") for (int ai = 0; ai < 2; ++ai) _Pragma("unroll") for (int m = 0; m < 4; ++m) { const int row = u.pm * BM + ai * HALF + wr * 64 + m * 16 + fr; \
    _Pragma("unroll") for (int bj = 0; bj < 2; ++bj) { const int ct = bj * HALF + wc * 32 + 8 * fq; f32x4 v0 = acc[ai][bj][m][0], v1 = acc[ai][bj][m][1];
#define EPI_LOOP_END } }
#define EPI_SIG(v0, v1) do { _Pragma("unroll") for (int e_ = 0; e_ < 4; ++e_) { v0[e_] = sigm(v0[e_]); v1[e_] = sigm(v1[e_]); } } while (0)

struct EpiInProj {
    static constexpr bool PERM = true, AFTER_DRAIN = false;
    bf16_t *Q, *AS, *GA; size_t qkv_stride, gate_stride;
    __device__ __forceinline__ void operator()(const f32x4 (&acc)[2][2][4][2], const Unit& u, int wr, int wc, int fr, int fq) const {
        const int pn = u.pn;
        if (pn < 6) {
            bf16_t* base = Q + (size_t)(pn >> 1) * qkv_stride; const float sc = pn < 2 ? QC2 : 1.0f; const int cb = (pn & 1) * 256;
            EPI_LOOP_BEGIN v0 = v0 * sc; v1 = v1 * sc; *(u32x4*)(base + (size_t)row * 512 + cb + ct) = pack8(v0, v1); EPI_LOOP_END
        } else if (pn < 8) {
            const int cb = (pn - 6) * 256;
            EPI_LOOP_BEGIN const int j = cb + ct; const int g = j >> 4;
                *(u32x4*)(AS + ((size_t)(g * 4096 + (row >> 4))) * 384 + (row & 15) * 16 + (j & 15)) = pack8(v0, v1); EPI_LOOP_END
        } else {
            bf16_t* base = GA + (size_t)((pn - 8) >> 2) * gate_stride; const int cb = ((pn - 8) & 3) * 256;
            EPI_LOOP_BEGIN EPI_SIG(v0, v1); *(u32x4*)(base + (size_t)row * 1024 + cb + ct) = pack8(v0, v1); EPI_LOOP_END
        }
    }
};
struct EpiSsmState {
    static constexpr bool PERM = true, AFTER_DRAIN = false;
    float* SLOC;
    __device__ __forceinline__ void operator()(const f32x4 (&acc)[2][2][4][2], const Unit& u, int wr, int wc, int fr, int fq) const {
        EPI_LOOP_BEGIN if (bj == 0) { float* d = SLOC + (size_t)row * 128 + ct; *(f32x4*)d = v0; *(f32x4*)(d + 4) = v1; } EPI_LOOP_END
    }
};
struct EpiSsmY {
    static constexpr bool PERM = true, AFTER_DRAIN = false;
    bf16_t* YB;
    __device__ __forceinline__ void operator()(const f32x4 (&acc)[2][2][4][2], const Unit& u, int wr, int wc, int fr, int fq) const {
        EPI_LOOP_BEGIN const int g = row >> 12, cr = row & 4095, tl = ct >> 4, c0 = ct & 15;
            _Pragma("unroll") for (int e = 0; e < 4; ++e) { v0[e] = gelu_tanh(v0[e]); v1[e] = gelu_tanh(v1[e]); }
            *(u32x4*)(YB + ((size_t)(cr * 16 + tl)) * 512 + g * 16 + c0) = pack8(v0, v1); EPI_LOOP_END
    }
};
#define EPI_ROW(ai, m) (u.pm * BM + (ai) * HALF + wr * 64 + (m) * 16 + fr)
#define EPI_CT(bj) ((bj) * HALF + wc * 32 + 8 * fq)
struct EpiGlu {
    static constexpr bool PERM = true, AFTER_DRAIN = false;
    const bf16_t* YB; bf16_t* O; const float* bias;
    __device__ __forceinline__ void operator()(const f32x4 (&acc)[2][2][4][2], const Unit& u, int wr, int wc, int fr, int fq) const {
        u32x4 y[2][4][2]; f32x4 bb[2][2];
        _Pragma("unroll") for (int bj = 0; bj < 2; ++bj) { const int col = u.pn * BM + EPI_CT(bj); bb[bj][0] = *(const f32x4*)(bias + col); bb[bj][1] = *(const f32x4*)(bias + col + 4); }
        _Pragma("unroll") for (int ai = 0; ai < 2; ++ai) _Pragma("unroll") for (int m = 0; m < 4; ++m) _Pragma("unroll") for (int bj = 0; bj < 2; ++bj)
            y[ai][m][bj] = *(const u32x4*)(YB + (size_t)EPI_ROW(ai, m) * 512 + u.pn * BM + EPI_CT(bj));
        _Pragma("unroll") for (int ai = 0; ai < 2; ++ai) _Pragma("unroll") for (int m = 0; m < 4; ++m) _Pragma("unroll") for (int bj = 0; bj < 2; ++bj) {
            f32x4 v0 = acc[ai][bj][m][0] + bb[bj][0], v1 = acc[ai][bj][m][1] + bb[bj][1]; const u32x4 yy = y[ai][m][bj]; EPI_SIG(v0, v1);
            v0[0] *= bf_lo(yy.x); v0[1] *= bf_hi(yy.x); v0[2] *= bf_lo(yy.y); v0[3] *= bf_hi(yy.y); v1[0] *= bf_lo(yy.z); v1[1] *= bf_hi(yy.z); v1[2] *= bf_lo(yy.w); v1[3] *= bf_hi(yy.w);
            *(u32x4*)(O + (size_t)EPI_ROW(ai, m) * 512 + u.pn * BM + EPI_CT(bj)) = pack8(v0, v1); }
    }
};
template <bool ADD> struct EpiGate {
    static constexpr bool PERM = true, AFTER_DRAIN = false;
    const bf16_t* G; bf16_t* O;
    __device__ __forceinline__ void operator()(const f32x4 (&acc)[2][2][4][2], const Unit& u, int wr, int wc, int fr, int fq) const {
        _Pragma("unroll") for (int ai = 0; ai < 2; ++ai) {
            u32x4 gt[4][2], oo[4][2];
            _Pragma("unroll") for (int m = 0; m < 4; ++m) _Pragma("unroll") for (int bj = 0; bj < 2; ++bj) { const size_t off = (size_t)EPI_ROW(ai, m) * 1024 + u.pn * BM + EPI_CT(bj);
                gt[m][bj] = *(const u32x4*)(G + off); if (ADD) oo[m][bj] = *(const u32x4*)(O + off); }
            _Pragma("unroll") for (int m = 0; m < 4; ++m) _Pragma("unroll") for (int bj = 0; bj < 2; ++bj) { const size_t off = (size_t)EPI_ROW(ai, m) * 1024 + u.pn * BM + EPI_CT(bj);
                f32x4 v0 = acc[ai][bj][m][0], v1 = acc[ai][bj][m][1]; const u32x4 g4 = gt[m][bj];
                v0[0] *= bf_lo(g4.x); v0[1] *= bf_hi(g4.x); v0[2] *= bf_lo(g4.y); v0[3] *= bf_hi(g4.y); v1[0] *= bf_lo(g4.z); v1[1] *= bf_hi(g4.z); v1[2] *= bf_lo(g4.w); v1[3] *= bf_hi(g4.w);
                if (ADD) { const u32x4 o = oo[m][bj];
                    v0[0] += bf_lo(o.x); v0[1] += bf_hi(o.x); v0[2] += bf_lo(o.y); v0[3] += bf_hi(o.y); v1[0] += bf_lo(o.z); v1[1] += bf_hi(o.z); v1[2] += bf_lo(o.w); v1[3] += bf_hi(o.w); }
                *(u32x4*)(O + off) = pack8(v0, v1); }
            asm volatile("" ::: "memory");
        }
    }
};
struct EpiResid {
    static constexpr bool PERM = true, AFTER_DRAIN = false;
    bf16_t* X;
    __device__ __forceinline__ void operator()(const f32x4 (&acc)[2][2][4][2], const Unit& u, int wr, int wc, int fr, int fq) const {
        u32x4 xo[2][4][2];
        _Pragma("unroll") for (int ai = 0; ai < 2; ++ai) _Pragma("unroll") for (int m = 0; m < 4; ++m) _Pragma("unroll") for (int bj = 0; bj < 2; ++bj)
            xo[ai][m][bj] = *(const u32x4*)(X + (size_t)EPI_ROW(ai, m) * 1024 + u.pn * BM + EPI_CT(bj));
        _Pragma("unroll") for (int ai = 0; ai < 2; ++ai) _Pragma("unroll") for (int m = 0; m < 4; ++m) _Pragma("unroll") for (int bj = 0; bj < 2; ++bj) {
            f32x4 v0 = acc[ai][bj][m][0], v1 = acc[ai][bj][m][1]; const u32x4 o = xo[ai][m][bj];
            v0[0] += bf_lo(o.x); v0[1] += bf_hi(o.x); v0[2] += bf_lo(o.y); v0[3] += bf_hi(o.y); v1[0] += bf_lo(o.z); v1[1] += bf_hi(o.z); v1[2] += bf_lo(o.w); v1[3] += bf_hi(o.w);
            *(u32x4*)(X + (size_t)EPI_ROW(ai, m) * 1024 + u.pn * BM + EPI_CT(bj)) = pack8(v0, v1); }
    }
};
struct EpiRelu2 {
    static constexpr bool PERM = true, AFTER_DRAIN = false;
    bf16_t* O;
    __device__ __forceinline__ void operator()(const f32x4 (&acc)[2][2][4][2], const Unit& u, int wr, int wc, int fr, int fq) const {
        EPI_LOOP_BEGIN _Pragma("unroll") for (int e = 0; e < 4; ++e) { const float a = fmaxf(v0[e], 0.f), b = fmaxf(v1[e], 0.f); v0[e] = a * a; v1[e] = b * b; }
            *(u32x4*)(O + (size_t)row * 4096 + u.pn * BM + ct) = pack8(v0, v1); EPI_LOOP_END
    }
};
struct SsmOrder {
    int G, c;
    __device__ __forceinline__ bool next(int i, Unit& u) const { const int L = i * G + c; if (L >= 512) return false; u.pm = L; u.pn = L >> 4; return true; }
    __device__ __forceinline__ void a_ready(const Unit&) const {}
    __device__ __forceinline__ void done(const Unit&) const {}
};

template <class Epi, class Sched, bool ALIGN_EPI = false, bool SP2 = false>
__device__ __forceinline__ void gemm_phase(PG8_LAS unsigned char* lds, const Gemm g, const Sched& S, const Epi& E) {
    int tid_ = threadIdx.x; asm volatile("" : "+v"(tid_));
    const int tid = tid_, wid = __builtin_amdgcn_readfirstlane(tid >> 6), lane = tid & 63, wr = wid >> 2, wc = wid & 3, fr = lane & 15, fq = lane >> 4;
    const int K = g.K, nt = K / BK;
    unsigned voffA[2], voffB[2];
#pragma unroll
    for (int i = 0; i < 2; ++i) { int R, C; stage_rc(tid * 16 + i * 8192, R, C); const int Rb = Epi::PERM ? ((R & ~31) + perm32(R & 31)) : R;
        voffA[i] = (unsigned)(R * K + C) * 2u; voffB[i] = (unsigned)(Rb * K + C) * 2u; }
    const size_t kstep = (size_t)(BK * 2);
    const size_t hstep = (size_t)HALF * K * 2;
    const size_t tstep = 2 * hstep;
    const unsigned ldsw = (unsigned)wid * 1024u;
    const int aoff = lds_byte(wr * 64 + fr, fq * 8), boff = lds_byte(wc * 32 + fr, fq * 8);
#define PG8_SA(b, h) (((b) * 2 + (h)) * HTB)
#define PG8_SB(b, h) ((4 + (b) * 2 + (h)) * HTB)
#define PG8_STAGE(bufoff, gbase, voff) do { _Pragma("unroll") for (int _i = 0; _i < 2; ++_i) \
        __builtin_amdgcn_global_load_lds((const unsigned*)((const char*)(gbase) + (voff)[_i]), (PG8_LAS unsigned*)(lds + (bufoff) + ldsw + _i * 8192), 16, 0, 0); } while (0)
#define PG8_LDA(dst, b, h) do { _Pragma("unroll") for (int m = 0; m < 4; ++m) _Pragma("unroll") for (int k = 0; k < 2; ++k) dst[m][k] = *(const PG8_LAS bf16x8*)(lds + PG8_SA(b, h) + aoff + m * 2048 + k * 1024); } while (0)
#define PG8_LDB(dst, b, h) do { _Pragma("unroll") for (int n = 0; n < 2; ++n) _Pragma("unroll") for (int k = 0; k < 2; ++k) dst[n][k] = *(const PG8_LAS bf16x8*)(lds + PG8_SB(b, h) + boff + n * 2048 + k * 1024); } while (0)
#define PG8_MMA(ai, bj, At, Bt) do { __builtin_amdgcn_s_setprio(1); _Pragma("unroll") for (int m = 0; m < 4; ++m) _Pragma("unroll") for (int n = 0; n < 2; ++n) _Pragma("unroll") for (int k = 0; k < 2; ++k) \
        acc[ai][bj][m][n] = __builtin_amdgcn_mfma_f32_16x16x32_bf16(Bt[n][k], At[m][k], acc[ai][bj][m][n], 0, 0, 0); __builtin_amdgcn_s_setprio(0); } while (0)
#define PG8_WAIT_V(n) asm volatile("s_waitcnt vmcnt(" #n ")" ::: "memory")
#define PG8_WAIT_L(n) asm volatile("s_waitcnt lgkmcnt(" #n ")" ::: "memory")
#define PG8_BAR __builtin_amdgcn_s_barrier()
#define PG8_SCHED __builtin_amdgcn_sched_barrier(0)
    Unit cur, nxt; int ui = 0;
    if (!S.next(0, cur)) return;
    f32x4 acc[2][2][4][2];
#pragma unroll
    for (int a = 0; a < 2; ++a)
#pragma unroll
        for (int b = 0; b < 2; ++b)
#pragma unroll
            for (int m = 0; m < 4; ++m)
#pragma unroll
                for (int n = 0; n < 2; ++n) acc[a][b][m][n] = (f32x4){0.f, 0.f, 0.f, 0.f};
    bf16x8 At[4][2], B0[2][2], B1[2][2];
    const char* cA = (const char*)g.A + (size_t)cur.pm * tstep; const char* cB = (const char*)g.Bt + (size_t)cur.pn * tstep;
    S.a_ready(cur);
    if constexpr (SP2) {
        PG8_STAGE(PG8_SB(0, 0), cB, voffB); PG8_STAGE(PG8_SB(0, 1), cB + hstep, voffB); PG8_STAGE(PG8_SA(0, 0), cA, voffA); PG8_STAGE(PG8_SA(0, 1), cA + hstep, voffA);
        if (wr == 1) PG8_BAR;
        PG8_WAIT_V(2); PG8_BAR;
        PG8_STAGE(PG8_SB(1, 0), cB + kstep, voffB); PG8_STAGE(PG8_SA(1, 0), cA + kstep, voffA); PG8_STAGE(PG8_SB(1, 1), cB + hstep + kstep, voffB);
        PG8_WAIT_V(6); PG8_BAR;
    } else {
        PG8_STAGE(PG8_SB(0, 0), cB, voffB); PG8_STAGE(PG8_SA(0, 0), cA, voffA); PG8_STAGE(PG8_SB(0, 1), cB + hstep, voffB); PG8_STAGE(PG8_SA(0, 1), cA + hstep, voffA);
        if (wr == 1) PG8_BAR;
        PG8_WAIT_V(4); PG8_BAR;
        PG8_STAGE(PG8_SB(1, 0), cB + kstep, voffB); PG8_STAGE(PG8_SA(1, 0), cA + kstep, voffA); PG8_STAGE(PG8_SB(1, 1), cB + hstep + kstep, voffB);
        PG8_WAIT_V(6); PG8_BAR;
    }
    for (;;) {
        const bool has_next = S.next(ui + 1, nxt);
        const char* nA = has_next ? (const char*)g.A + (size_t)nxt.pm * tstep : cA; const char* nB = has_next ? (const char*)g.Bt + (size_t)nxt.pn * tstep : cB;
        for (int t = 0; t < nt; t += 2) {
            const bool last = (t == nt - 2);
            const char* a1 = cA + (size_t)(t + 1) * kstep;
            const char* a2 = last ? nA : cA + (size_t)(t + 2) * kstep; const char* b2 = last ? nB : cB + (size_t)(t + 2) * kstep;
            const char* a3 = a2 + kstep; const char* b3 = b2 + kstep;
            if (last && has_next) S.a_ready(nxt);
            if constexpr (SP2) {
            PG8_LDB(B0, 0, 0); PG8_LDB(B1, 0, 1); PG8_SCHED; PG8_LDA(At, 0, 0); PG8_STAGE(PG8_SA(1, 1), a1 + hstep, voffA);
            PG8_WAIT_V(8); PG8_WAIT_L(0); PG8_BAR; PG8_MMA(0, 0, At, B0); PG8_MMA(0, 1, At, B1); PG8_BAR; PG8_SCHED;
            PG8_LDA(At, 0, 1); PG8_STAGE(PG8_SB(0, 0), b2, voffB); PG8_STAGE(PG8_SB(0, 1), b2 + hstep, voffB); PG8_STAGE(PG8_SA(0, 0), a2, voffA);
            PG8_WAIT_V(8); PG8_WAIT_L(0); PG8_BAR; PG8_MMA(1, 0, At, B0); PG8_MMA(1, 1, At, B1); PG8_BAR; PG8_SCHED;
            PG8_LDB(B0, 1, 0); PG8_LDB(B1, 1, 1); PG8_SCHED; PG8_LDA(At, 1, 0); PG8_STAGE(PG8_SA(0, 1), a2 + hstep, voffA);
            PG8_WAIT_V(8); PG8_WAIT_L(0); PG8_BAR; PG8_MMA(0, 0, At, B0); PG8_MMA(0, 1, At, B1); PG8_BAR; PG8_SCHED;
            PG8_LDA(At, 1, 1); PG8_STAGE(PG8_SB(1, 0), b3, voffB); PG8_STAGE(PG8_SB(1, 1), b3 + hstep, voffB); PG8_STAGE(PG8_SA(1, 0), a3, voffA);
            PG8_WAIT_V(8); PG8_WAIT_L(0); PG8_BAR; PG8_MMA(1, 0, At, B0); PG8_MMA(1, 1, At, B1); PG8_BAR; PG8_SCHED;
            } else {
            PG8_LDB(B0, 0, 0); PG8_SCHED; PG8_LDA(At, 0, 0); PG8_STAGE(PG8_SA(1, 1), a1 + hstep, voffA);
            PG8_WAIT_L(8); PG8_BAR; PG8_WAIT_L(0); PG8_MMA(0, 0, At, B0); PG8_BAR; PG8_SCHED;
            PG8_LDB(B1, 0, 1); PG8_STAGE(PG8_SB(0, 0), b2, voffB);
            PG8_BAR; PG8_WAIT_L(0); PG8_MMA(0, 1, At, B1); PG8_BAR;
            PG8_LDA(At, 0, 1); PG8_STAGE(PG8_SA(0, 0), a2, voffA);
            PG8_BAR; PG8_WAIT_L(0); PG8_MMA(1, 0, At, B0); PG8_BAR; PG8_SCHED;
            PG8_STAGE(PG8_SB(0, 1), b2 + hstep, voffB);
            PG8_WAIT_V(6); PG8_BAR; PG8_MMA(1, 1, At, B1); PG8_BAR;
            PG8_LDB(B0, 1, 0); PG8_SCHED; PG8_LDA(At, 1, 0); PG8_STAGE(PG8_SA(0, 1), a2 + hstep, voffA);
            PG8_WAIT_L(8); PG8_BAR; PG8_WAIT_L(0); PG8_MMA(0, 0, At, B0); PG8_BAR; PG8_SCHED;
            PG8_LDB(B1, 1, 1); PG8_STAGE(PG8_SB(1, 0), b3, voffB);
            PG8_BAR; PG8_WAIT_L(0); PG8_MMA(0, 1, At, B1); PG8_BAR;
            PG8_LDA(At, 1, 1); PG8_STAGE(PG8_SA(1, 0), a3, voffA);
            PG8_BAR; PG8_WAIT_L(0); PG8_MMA(1, 0, At, B0); PG8_BAR; PG8_SCHED;
            PG8_STAGE(PG8_SB(1, 1), b3 + hstep, voffB);
            PG8_WAIT_V(6); PG8_BAR; PG8_MMA(1, 1, At, B1); PG8_BAR;
            }
        }
        if constexpr (ALIGN_EPI) { if (wr == 0) PG8_BAR; }
        if constexpr (!Epi::AFTER_DRAIN) { E(acc, cur, wr, wc, fr, fq); S.done(cur); }
        if (!has_next) break;
#pragma unroll
        for (int a = 0; a < 2; ++a)
#pragma unroll
            for (int b = 0; b < 2; ++b)
#pragma unroll
                for (int m = 0; m < 4; ++m)
#pragma unroll
                    for (int n = 0; n < 2; ++n) acc[a][b][m][n] = (f32x4){0.f, 0.f, 0.f, 0.f};
        cur = nxt; cA = nA; cB = nB; ++ui;
        if constexpr (ALIGN_EPI) { if (wr == 1) PG8_BAR; }
    }
    PG8_WAIT_V(0);
    if constexpr (!ALIGN_EPI) { if (wr == 0) PG8_BAR; }
    PG8_BAR;
    if constexpr (Epi::AFTER_DRAIN) { E.fused(acc, cur, wr, wc, fr, fq, lds, wid, lane); S.done(cur); }
#undef PG8_SA
#undef PG8_SB
#undef PG8_STAGE
#undef PG8_LDA
#undef PG8_LDB
#undef PG8_MMA
#undef PG8_WAIT_V
#undef PG8_WAIT_L
#undef PG8_BAR
#undef PG8_SCHED
}
}
#include <hip/hip_bf16.h>
#include <cmath>
namespace attn_body {
using bf16=__hip_bfloat16;
using bf16x8=__attribute__((ext_vector_type(8)))short;
using s16x4=__attribute__((ext_vector_type(4)))short;
using f32x16=__attribute__((ext_vector_type(16)))float;
using u32x4=__attribute__((ext_vector_type(4)))unsigned;
constexpr int BATCH=16,NHEAD=8,SEQ=4096,D=64,DM=NHEAD*D;
constexpr int NW=8,QBLK=32,QB=QBLK*NW,KVBLK=64,NQB=SEQ/QB;
constexpr int ATTN_PITCH=DM, ATTN_UNIT_ROWS=QB;
__device__ __forceinline__ int crow(int r,int hi){return (r&3)+8*(r>>2)+4*hi;}
#define SBAR() __builtin_amdgcn_sched_barrier(0)
__device__ __forceinline__ void cmask(f32x16&p0,f32x16&p1,int jb,int qrel,int hi){
  const float NEG=-INFINITY; int kb=64*jb+4*hi;
  #pragma unroll
  for(int r=0;r<16;++r){int kv=kb+(r&3)+8*(r>>2); if(kv>qrel)p0[r]=NEG; if(kv+32>qrel)p1[r]=NEG;}
}

constexpr int NSLOT=3, SLOTB=8192;
constexpr int LDS_K=0, LDS_V=NSLOT*SLOTB, LDS_WS=2*NSLOT*SLOTB, LDS_OST=LDS_WS+NW*64*4, LDS_BIAS=LDS_OST+NW*4096, LDS_BYTES=LDS_BIAS+SEQ*4;
constexpr float C2=0.125f*1.4426950408889634f;
__device__ __forceinline__ void glds16(const void*gsrc,unsigned lds_dst){unsigned keep;
  asm volatile("s_mov_b32 %0, m0\n\ts_mov_b32 m0, %2\n\ts_nop 0\n\tglobal_load_lds_dwordx4 %1, off\n\ts_mov_b32 m0, %0":"=&s"(keep):"v"(gsrc),"s"(lds_dst):"memory");}
__device__ __forceinline__ float max3f(float a,float b,float c){float r;asm("v_max3_f32 %0, %1, %2, %3":"=v"(r):"v"(a),"v"(b),"v"(c));return r;}
__device__ __forceinline__ float max2f(float a,float b){float r;asm("v_max_f32_e32 %0, %1, %2":"=v"(r):"v"(a),"v"(b));return r;}
__device__ __forceinline__ float fadd_s(float a,float b){float r;asm("v_add_f32_e32 %0, %1, %2":"=v"(r):"v"(a),"v"(b));return r;}
__device__ __forceinline__ float fsub_s(float a,float b){float r;asm("v_sub_f32_e32 %0, %1, %2":"=v"(r):"v"(a),"v"(b));return r;}
typedef float f32x4_t __attribute__((ext_vector_type(4))); typedef float f32x2_t __attribute__((ext_vector_type(2))); typedef __bf16 bf16x2_t __attribute__((ext_vector_type(2)));
__device__ __forceinline__ unsigned cvtpk_s(float lo,float hi){f32x2_t v={lo,hi};bf16x2_t b=__builtin_convertvector(v,bf16x2_t);return __builtin_bit_cast(unsigned,b);}
#define WAIT_BAR(N) asm volatile("s_waitcnt vmcnt(" #N ") lgkmcnt(0)\n\ts_barrier":::"memory")

__device__ __forceinline__ void qkt(f32x16&p0,f32x16&p1,const char*Kslot,const bf16x8*qr,const f32x16&negm,int r32,int hi){
  const char*kb=Kslot+hi*1024+r32*16;
  #pragma unroll
  for(int d0=0;d0<4;++d0){
    const bf16x8 b0=*reinterpret_cast<const bf16x8*>(kb+d0*2048);
    const bf16x8 b1=*reinterpret_cast<const bf16x8*>(kb+d0*2048+512);
    if(d0==0){p0=__builtin_amdgcn_mfma_f32_32x32x16_bf16(b0,qr[0],negm,0,0,0);p1=__builtin_amdgcn_mfma_f32_32x32x16_bf16(b1,qr[0],negm,0,0,0);}
    else{p0=__builtin_amdgcn_mfma_f32_32x32x16_bf16(b0,qr[d0],p0,0,0,0);p1=__builtin_amdgcn_mfma_f32_32x32x16_bf16(b1,qr[d0],p1,0,0,0);}}
}
typedef __attribute__((address_space(3))) const char* lds_cptr;
typedef short v4i16_t __attribute__((ext_vector_type(4)));
__device__ __forceinline__ void kload8(bf16x8*kf,lds_cptr kp){
  kf[0]=*(const __attribute__((address_space(3))) bf16x8*)(kp);      kf[1]=*(const __attribute__((address_space(3))) bf16x8*)(kp+512);
  kf[2]=*(const __attribute__((address_space(3))) bf16x8*)(kp+2048); kf[3]=*(const __attribute__((address_space(3))) bf16x8*)(kp+2560);
  kf[4]=*(const __attribute__((address_space(3))) bf16x8*)(kp+4096); kf[5]=*(const __attribute__((address_space(3))) bf16x8*)(kp+4608);
  kf[6]=*(const __attribute__((address_space(3))) bf16x8*)(kp+6144); kf[7]=*(const __attribute__((address_space(3))) bf16x8*)(kp+6656);
}
__device__ __forceinline__ void kload2(bf16x8*kf,lds_cptr kp,int j){ kf[2*j]=*(const __attribute__((address_space(3))) bf16x8*)(kp+j*2048); kf[2*j+1]=*(const __attribute__((address_space(3))) bf16x8*)(kp+j*2048+512); }
__device__ __forceinline__ s16x4 vtr(lds_cptr p){ return __builtin_bit_cast(s16x4,__builtin_amdgcn_ds_read_tr16_b64_v4i16((__attribute__((address_space(3))) v4i16_t*)p)); }
__device__ __forceinline__ float rowmax(const f32x16&p0,const f32x16&p1){
  float a=max3f(p0[0],p0[1],p1[0]),b=max3f(p0[2],p0[3],p1[1]);a=max3f(a,p1[2],p1[3]);
  #pragma unroll
  for(int r=4;r<16;r+=4){a=max3f(a,p0[r],p0[r+1]);b=max3f(b,p0[r+2],p0[r+3]);a=max3f(a,p1[r],p1[r+1]);b=max3f(b,p1[r+2],p1[r+3]);}
  const float m=max2f(a,b);
  auto rr=__builtin_amdgcn_permlane32_swap(__float_as_uint(m),__float_as_uint(m),false,false);
  return max2f(__uint_as_float(rr[0]),__uint_as_float(rr[1]));
}
__device__ __forceinline__ void pv(f32x16*o,int vb,bf16x8 pa0,bf16x8 pa1,bf16x8 pa2,bf16x8 pa3){
  #pragma unroll
  for(int d0=0;d0<2;++d0){s16x4 lo[4],hi[4];
    #pragma unroll
    for(int ks=0;ks<4;++ks){
      asm volatile("ds_read_b64_tr_b16 %0,%1 offset:%c2":"=&v"(lo[ks]):"v"(vb),"i"(d0*4096+ks*1024):"memory");
      asm volatile("ds_read_b64_tr_b16 %0,%1 offset:%c2":"=&v"(hi[ks]):"v"(vb),"i"(d0*4096+ks*1024+512):"memory");}
    asm volatile("s_waitcnt lgkmcnt(0)":::"memory");SBAR();
    #define PK(k) (bf16x8){lo[k][0],lo[k][1],lo[k][2],lo[k][3],hi[k][0],hi[k][1],hi[k][2],hi[k][3]}
    o[d0]=__builtin_amdgcn_mfma_f32_32x32x16_bf16(pa0,PK(0),o[d0],0,0,0);
    o[d0]=__builtin_amdgcn_mfma_f32_32x32x16_bf16(pa1,PK(1),o[d0],0,0,0);
    o[d0]=__builtin_amdgcn_mfma_f32_32x32x16_bf16(pa2,PK(2),o[d0],0,0,0);
    o[d0]=__builtin_amdgcn_mfma_f32_32x32x16_bf16(pa3,PK(3),o[d0],0,0,0);
    #undef PK
  }
}

#ifndef ATTN_STORE16
#define ATTN_STORE16(p,v) (*(u32x4*)(p)=(v))
#endif
template<int THRL> __device__ __forceinline__ void attn_unit(int b,int h,int qb,const bf16*Q,const bf16*__restrict__ K,const bf16*__restrict__ V,bf16*O,const float*__restrict__ BIASG,char*shm){
  int tid_=threadIdx.x; asm volatile("":"+v"(tid_)); const int tid=tid_,lane=tid&63,r32=lane&31,hi=lane>>5; const int wid=__builtin_amdgcn_readfirstlane(tid>>6);
  const long rowbase=(long)b*SEQ; const int q0=qb*QB;
  const bf16*Qw=Q+(rowbase+q0+wid*QBLK)*DM+h*D;
  const bf16*Kh=K+rowbase*DM+h*D,*Vh=V+rowbase*DM+h*D;
  const lds_cptr shm3=(lds_cptr)shm;
  const unsigned lds0=(unsigned)(uintptr_t)shm;
  float*wsf=(float*)(shm+LDS_WS)+wid*64;
  const bf16*ksrc=Kh+(long)lane*DM+wid*8;
  const bf16*vsrc=Vh+(long)(16*(wid&3)+(lane>>2))*DM+(wid>>2)*32+(lane&3)*8;
  const unsigned kdst=lds0+LDS_K+wid*1024, vdst=lds0+LDS_V+wid*1024;
  #define DMA_K(t,slot) glds16(ksrc+(long)(t)*KVBLK*DM,(unsigned)__builtin_amdgcn_readfirstlane(kdst+(slot)))
  #define DMA_V(t,slot) glds16(vsrc+(long)(t)*KVBLK*DM,(unsigned)__builtin_amdgcn_readfirstlane(vdst+(slot)))
  const int vb0=(int)(lds0+LDS_V)+((lane>>4)&1)*32+(lane&3)*8+(4*hi+((lane&15)>>2))*64;
  const char*Kbase=shm+LDS_K; bf16x8 kf[8];
  const lds_cptr kp0=shm3+LDS_K+hi*1024+r32*16; const lds_cptr vp0=shm3+LDS_V+((lane>>4)&1)*32+(lane&3)*8+(4*hi+((lane&15)>>2))*64;
  const int NT=(q0+QB)/KVBLK;
  const __attribute__((address_space(3))) float*biasl=(const __attribute__((address_space(3))) float*)(shm3+LDS_BIAS)+4*hi;
  #define ADDB(P0,P1,t) do{ const __attribute__((address_space(3))) float*bp_=biasl+64*(t); \
    _Pragma("unroll") for(int j_=0;j_<4;++j_){ const f32x4_t b0_=*(const __attribute__((address_space(3))) f32x4_t*)(bp_+8*j_), b1_=*(const __attribute__((address_space(3))) f32x4_t*)(bp_+32+8*j_); \
      _Pragma("unroll") for(int e_=0;e_<4;++e_){ P0[4*j_+e_]+=b0_[e_]; P1[4*j_+e_]+=b1_[e_]; } } }while(0)
  DMA_K(0,0);DMA_V(0,0);DMA_K(1,SLOTB);
  bf16x8 qr[4];
  #pragma unroll
  for(int d0=0;d0<4;++d0)qr[d0]=*reinterpret_cast<const bf16x8*>(&Qw[(long)r32*DM+d0*16+hi*8]);
  float mhat=0.f,l_reg=0.f;f32x16 o[2];o[0]=f32x16{};o[1]=f32x16{};f32x16 negm=f32x16{};asm volatile("":"+v"(negm));
  const int qrel=wid*QBLK+r32;
  #define CMASK(P0,P1,t) do{int jb_=(t)-(NT-4); if(jb_>=0)cmask(P0,P1,jb_,qrel,hi);}while(0)
  bool resc=false;
  #define START(P0,P1) do{ const float rm=rowmax(P0,P1); resc=false; \
    { const float dl=rm; mhat=fadd_s(mhat,dl); \
      _Pragma("unroll") for(int r=0;r<16;++r){P0[r]=fsub_s(P0[r],dl);P1[r]=fsub_s(P1[r],dl);} \
      _Pragma("unroll") for(int r=0;r<16;++r)negm[r]=-mhat; asm volatile("":"+v"(negm)); } \
    _Pragma("unroll") for(int r=0;r<16;++r)P0[r]=__builtin_amdgcn_exp2f(P0[r]); }while(0)
  #define RESC() do{ if(resc){ asm volatile("s_waitcnt lgkmcnt(0)":::"memory"); \
      _Pragma("unroll") for(int d_=0;d_<2;++d_) _Pragma("unroll") for(int r=0;r<16;++r)o[d_][r]*=wsf[crow(r,hi)]; } }while(0)
  f32x16 pA0,pA1,pB0,pB1;
  int sl_prev=0,sl_cur=0,sl_next=SLOTB;
  #define ROT() do{sl_prev=sl_cur;sl_cur=sl_next;sl_next=(sl_next==(NSLOT-1)*SLOTB)?0:sl_next+SLOTB;}while(0)
  DMA_K(2,2*SLOTB);
  { const float*gb=BIASG+(long)(b*NHEAD+h)*SEQ; __attribute__((address_space(3))) float*bl=(__attribute__((address_space(3))) float*)(shm3+LDS_BIAS);
    for(int i=tid*4;i<q0+QB;i+=NW*64*4){ const f32x4_t v=*(const f32x4_t*)(gb+i); *(__attribute__((address_space(3))) f32x4_t*)(bl+i)=v; } }
  WAIT_BAR(3);
  qkt(pA0,pA1,Kbase,qr,negm,r32,hi);asm volatile("s_nop 15\n\ts_nop 7":"+v"(pA0),"+v"(pA1));ADDB(pA0,pA1,0);CMASK(pA0,pA1,0);
  START(pA0,pA1);
  _Pragma("unroll") for(int r=0;r<16;++r)pA1[r]=__builtin_amdgcn_exp2f(pA1[r]);
  WAIT_BAR(0);
  DMA_K(3,0);DMA_V(1,SLOTB);
  ROT();
  kload8(kf,kp0+sl_cur);
  WAIT_BAR(2);
  s16x4 vlo[8],vhi[8]; u32x4 pw0,pw1,pw2,pw3;
  #define PKW(P,B) cvtpk_s(P[B],P[B+1])
  #define PAF(k) __builtin_bit_cast(bf16x8,pw##k)
  #define VFR(i) (bf16x8){vlo[i][0],vlo[i][1],vlo[i][2],vlo[i][3],vhi[i][0],vhi[i][1],vhi[i][2],vhi[i][3]}
  #define PIN(x) asm volatile("":"+v"(x))
  #define MX3(a,b,c) __builtin_fmaxf(__builtin_fmaxf((a),(b)),(c))
  #define GAPA(MF,A0,A1,A2,A3,W0,W1,PW) do{ MF; sacc+=A0; sacc+=A1; sacc+=A2; sacc+=A3; PIN(sacc); W0; W1; PIN(PW); SBAR(); }while(0)
  #define EX(v) __builtin_amdgcn_exp2f(v)
  #define GAPB(MF,X,B) do{ MF; X[B]=EX(X[B]); X[B+1]=EX(X[B+1]); X[B+2]=EX(X[B+2]); X[B+3]=EX(X[B+3]); PIN(X); SBAR(); }while(0)
  #define VRD(i) do{ vlo[i]=vtr(vp_+(((i)>>2)*4096+((i)&3)*1024)); vhi[i]=vtr(vp_+(((i)>>2)*4096+((i)&3)*1024+512)); }while(0)
  #define KRD(G,j) do{ if(G){ kload2(kf,kp0+sl_next,j); SBAR(); } }while(0)
  #define LDB4(off) (*(const __attribute__((address_space(3))) f32x4_t*)(bp_+(off)))
  #define BL0(t) do{ const __attribute__((address_space(3))) float*bp_=biasl+64*(t); bA0=LDB4(0); bA1=LDB4(8); bA2=LDB4(16); bA3=LDB4(24); }while(0)
  #define BL1(t) do{ const __attribute__((address_space(3))) float*bp_=biasl+64*(t); bB0=LDB4(32); bB1=LDB4(40); bB2=LDB4(48); bB3=LDB4(56); }while(0)
  #define BADD(C0,C1) do{ _Pragma("unroll") for(int e_=0;e_<4;++e_){ C0[e_]+=bA0[e_]; C0[4+e_]+=bA1[e_]; C0[8+e_]+=bA2[e_]; C0[12+e_]+=bA3[e_]; C1[e_]+=bB0[e_]; C1[4+e_]+=bB1[e_]; C1[8+e_]+=bB2[e_]; C1[12+e_]+=bB3[e_]; } }while(0)
  #define STEP(C0,C1,P0,P1,t,GK,GV,GL) do{ SBAR(); f32x4_t bA0,bA1,bA2,bA3,bB0,bB1,bB2,bB3; \
    const lds_cptr vp_=vp0+sl_prev; \
    VRD(0); SBAR(); float sacc=(P0[0]+P0[1]); \
    GAPA(C0=__builtin_amdgcn_mfma_f32_32x32x16_bf16(kf[0],qr[0],negm,0,0,0), P0[2],P0[3],P0[4],P0[5],     pw0[0]=PKW(P0,0), pw0[1]=PKW(P0,2), pw0); \
    VRD(4); SBAR(); GAPA(C1=__builtin_amdgcn_mfma_f32_32x32x16_bf16(kf[1],qr[0],negm,0,0,0), P0[6],P0[7],P0[8],P0[9],     pw0[2]=PKW(P0,4), pw0[3]=PKW(P0,6), pw0); \
    VRD(1); SBAR(); GAPA(C0=__builtin_amdgcn_mfma_f32_32x32x16_bf16(kf[2],qr[1],C0,0,0,0),   P0[10],P0[11],P0[12],P0[13], pw1[0]=PKW(P0,8), pw1[1]=PKW(P0,10), pw1); \
    VRD(5); SBAR(); GAPA(C1=__builtin_amdgcn_mfma_f32_32x32x16_bf16(kf[3],qr[1],C1,0,0,0),   P0[14],P0[15],P1[0],P1[1],   pw1[2]=PKW(P0,12),pw1[3]=PKW(P0,14), pw1); \
    VRD(2); SBAR(); GAPA(C0=__builtin_amdgcn_mfma_f32_32x32x16_bf16(kf[4],qr[2],C0,0,0,0),   P1[2],P1[3],P1[4],P1[5],     pw2[0]=PKW(P1,0), pw2[1]=PKW(P1,2), pw2); \
    VRD(6); SBAR(); GAPA(C1=__builtin_amdgcn_mfma_f32_32x32x16_bf16(kf[5],qr[2],C1,0,0,0),   P1[6],P1[7],P1[8],P1[9],     pw2[2]=PKW(P1,4), pw2[3]=PKW(P1,6), pw2); \
    VRD(3); SBAR(); GAPA(C0=__builtin_amdgcn_mfma_f32_32x32x16_bf16(kf[6],qr[3],C0,0,0,0),   P1[10],P1[11],P1[12],P1[13], pw3[0]=PKW(P1,8), pw3[1]=PKW(P1,10), pw3); \
    BL0(t); SBAR(); \
    VRD(7); SBAR(); GAPA(C1=__builtin_amdgcn_mfma_f32_32x32x16_bf16(kf[7],qr[3],C1,0,0,0),   P1[14],P1[15],0.f,0.f,       pw3[2]=PKW(P1,12),pw3[3]=PKW(P1,14), pw3); \
    BL1(t); SBAR(); \
    l_reg+=sacc; \
    if(GK){DMA_K((t)+3,sl_cur);} if(GV){DMA_V((t)+1,sl_next);} \
    BADD(C0,C1); CMASK(C0,C1,t); \
    { float a=MX3(C0[0],C0[1],C1[0]),b=MX3(C0[2],C0[3],C1[1]); a=MX3(a,C1[2],C1[3]); \
      _Pragma("unroll") for(int r=4;r<16;r+=4){a=MX3(a,C0[r],C0[r+1]);b=MX3(b,C0[r+2],C0[r+3]);a=MX3(a,C1[r],C1[r+1]);b=MX3(b,C1[r+2],C1[r+3]);} \
      float rm=__builtin_fmaxf(a,b); { auto rr=__builtin_amdgcn_permlane32_swap(__float_as_uint(rm),__float_as_uint(rm),false,false); rm=__builtin_fmaxf(__uint_as_float(rr[0]),__uint_as_float(rr[1])); } \
      resc=false; \
      if(__builtin_expect(__any(rm>(float)THRL),0)){ const float dl=__builtin_fmaxf(rm,0.f); mhat+=dl; \
        _Pragma("unroll") for(int r=0;r<16;++r){C0[r]-=dl;C1[r]-=dl;} \
        _Pragma("unroll") for(int r=0;r<16;++r)negm[r]=-mhat; asm volatile("":"+v"(negm)); \
        const float f=__builtin_amdgcn_exp2f(-dl); l_reg*=f; if(hi==0)wsf[r32]=f; resc=true; } } \
    SBAR(); \
    GAPB(o[0]=__builtin_amdgcn_mfma_f32_32x32x16_bf16(PAF(0),VFR(0),o[0],0,0,0), C0,0); \
    GAPB(o[1]=__builtin_amdgcn_mfma_f32_32x32x16_bf16(PAF(0),VFR(4),o[1],0,0,0), C0,4); \
    KRD(GL,0); GAPB(o[0]=__builtin_amdgcn_mfma_f32_32x32x16_bf16(PAF(1),VFR(1),o[0],0,0,0), C0,8); \
    KRD(GL,1); GAPB(o[1]=__builtin_amdgcn_mfma_f32_32x32x16_bf16(PAF(1),VFR(5),o[1],0,0,0), C0,12); \
    KRD(GL,2); GAPB(o[0]=__builtin_amdgcn_mfma_f32_32x32x16_bf16(PAF(2),VFR(2),o[0],0,0,0), C1,0); \
    KRD(GL,3); GAPB(o[1]=__builtin_amdgcn_mfma_f32_32x32x16_bf16(PAF(2),VFR(6),o[1],0,0,0), C1,4); \
    GAPB(o[0]=__builtin_amdgcn_mfma_f32_32x32x16_bf16(PAF(3),VFR(3),o[0],0,0,0), C1,8); \
    GAPB(o[1]=__builtin_amdgcn_mfma_f32_32x32x16_bf16(PAF(3),VFR(7),o[1],0,0,0), C1,12); \
    }while(0)
  int t=1;
  #undef CMASK
  #define CMASK(P0,P1,t) do{}while(0)
  for(;t+5<NT;t+=2){
    STEP(pB0,pB1,pA0,pA1,t,true,true,true);     WAIT_BAR(2); RESC(); ROT();
    STEP(pA0,pA1,pB0,pB1,t+1,true,true,true);   WAIT_BAR(2); RESC(); ROT();
  }
  #undef CMASK
  #define CMASK(P0,P1,t) do{int jb_=(t)-(NT-4); if(jb_>=0)cmask(P0,P1,jb_,qrel,hi);}while(0)
  #define ENDW(tt) do{ if((tt)+3<NT){WAIT_BAR(2);} else if((tt)+2<NT){WAIT_BAR(1);} else {WAIT_BAR(0);} }while(0)
  for(;t+1<NT;t+=2){
    STEP(pB0,pB1,pA0,pA1,t,(t+3<NT),(t+1<NT),(t+1<NT));       ENDW(t);   RESC(); ROT();
    STEP(pA0,pA1,pB0,pB1,t+1,(t+4<NT),(t+2<NT),(t+2<NT));     ENDW(t+1); RESC(); ROT();
  }
  STEP(pB0,pB1,pA0,pA1,NT-1,false,false,false); RESC();
  { float sacc=pB0[0]+pB0[1]; _Pragma("unroll") for(int r=2;r<16;++r)sacc+=pB0[r]; _Pragma("unroll") for(int r=0;r<16;++r)sacc+=pB1[r]; l_reg+=sacc;
    pw0=(u32x4){PKW(pB0,0),PKW(pB0,2),PKW(pB0,4),PKW(pB0,6)};pw1=(u32x4){PKW(pB0,8),PKW(pB0,10),PKW(pB0,12),PKW(pB0,14)};pw2=(u32x4){PKW(pB1,0),PKW(pB1,2),PKW(pB1,4),PKW(pB1,6)};pw3=(u32x4){PKW(pB1,8),PKW(pB1,10),PKW(pB1,12),PKW(pB1,14)};
    SBAR(); pv(o,vb0+sl_cur,PAF(0),PAF(1),PAF(2),PAF(3)); }
  #undef PKW
  #undef PAF
  #undef VFR
  #undef PIN
  #undef MX3
  #undef GAPA
  #undef GAPB
  #undef EX
  #undef VRD
  #undef KRD
  #undef STEP
  #undef ENDW
  {auto rr=__builtin_amdgcn_permlane32_swap(__float_as_uint(l_reg),__float_as_uint(l_reg),false,false);l_reg=__uint_as_float(rr[0])+__uint_as_float(rr[1]);}
  if(hi==0)wsf[32+r32]=l_reg;asm volatile("s_waitcnt lgkmcnt(0)":::"memory");
  float rli[16];
  #pragma unroll
  for(int r=0;r<16;++r)rli[r]=__builtin_amdgcn_rcpf(wsf[32+crow(r,hi)]);
  bf16*Ow=O+(rowbase+q0+wid*QBLK)*DM+h*D;
  { bf16*stg=(bf16*)(shm+LDS_OST)+wid*2048;
    #pragma unroll
    for(int r=0;r<16;++r){const int orow=crow(r,hi);
      #pragma unroll
      for(int d0=0;d0<2;++d0)stg[orow*64+d0*32+r32]=__float2bfloat16(o[d0][r]*rli[r]);}
    asm volatile("s_waitcnt lgkmcnt(0)":::"memory");
    #pragma unroll
    for(int i=0;i<4;++i){const int row=i*8+(lane>>3),ch=lane&7; const u32x4 v=*(const u32x4*)(stg+row*64+ch*8); ATTN_STORE16(Ow+(long)row*DM+ch*8,v);} }
  asm volatile("s_waitcnt lgkmcnt(0)\n\ts_barrier":::"memory");
  #undef ADDB
  #undef LDB4
  #undef BL0
  #undef BL1
  #undef BADD
  #undef DMA_K
  #undef DMA_V
  #undef CMASK
  #undef START
  #undef RESC
  #undef ROT
}
constexpr int ATTN_LDS_BYTES=LDS_BYTES;
struct AttnTensors { const bf16* Q; const bf16* K; const bf16* V; bf16* O; const float* BIAS; };
struct AttnUnit { int bh; int qb; };
struct StaticOrder {
  int vcu, grid;
  __device__ __forceinline__ explicit StaticOrder(int grid_,int block):vcu((grid_%8==0)?(block%8)*(grid_/8)+block/8:block),grid(grid_){}
  __device__ __forceinline__ bool next(int i,AttnUnit&u)const{ const int I=vcu+(i>>1)*grid; if(I>=BATCH*NHEAD*(NQB/2))return false; const int j=I%(NQB/2); u.bh=I/(NQB/2); u.qb=(i&1)?(NQB-1-j):j; return true; }
  __device__ __forceinline__ void a_ready(const AttnUnit&)const{}
  __device__ __forceinline__ void done(const AttnUnit&)const{}
};
template<class Sched,int THRL=64> __device__ __forceinline__ void attn_phase(char*lds,const AttnTensors&T,const Sched&S){
  AttnUnit u;
  for(int i=0;S.next(i,u);++i){ S.a_ready(u); attn_unit<THRL>(u.bh/NHEAD,u.bh%NHEAD,u.qb,T.Q,T.K,T.V,T.O,T.BIAS,lds); S.done(u); }
}
#undef SBAR
#undef WAIT_BAR
}
namespace cg = cooperative_groups;
constexpr int NWAVES = 8;
constexpr int BATCH = 16, SEQ = 4096, DMOD = 1024, DEPTH = 4, NHEADS = 8, AW = 512, SW = 512, NGRP = 32, GCH = 16, NST = 64, FF = 4096, NIN = 4104;
constexpr int M = BATCH * SEQ;
constexpr int CL = 16;
constexpr int NCR = M / CL;
constexpr int ASK = 384;
constexpr float RMS_EPS = 1e-6f;

constexpr size_t MiB = 1u << 20;
constexpr size_t WS_CTL = 0, CTL_ZERO_BYTES = 65536, WS_BARW = 16384;
constexpr int MISC_OFF = 131072 + 320;
constexpr size_t WS_WIN = 1 * MiB, WS_WUP = 9 * MiB, WS_WDN = 17 * MiB, WS_WOUT = 25 * MiB, WS_WA = 27 * MiB, WS_WB = 28 * MiB, WS_WGLU = 29 * MiB;
constexpr size_t WS_WSB = 30 * MiB, WS_WSY = 54 * MiB, WS_LPOW = 78 * MiB, SSM_W_LAYER = 6 * MiB;
constexpr size_t WS_LOGF = 79 * MiB, WS_BIAS = 81 * MiB;
constexpr size_t WS_H = 84 * MiB;
constexpr size_t WS_Q = 212 * MiB, WS_K = 276 * MiB, WS_V = 340 * MiB;
constexpr size_t WS_AS = 404 * MiB, WS_SLOC = 500 * MiB;
constexpr size_t WS_GA = 564 * MiB, WS_GB = 692 * MiB;
constexpr size_t WS_HID = 212 * MiB;
constexpr size_t WS_YB = WS_SLOC, WS_YB2 = WS_Q;
constexpr size_t WS_XB = 820 * MiB, WS_END = 948 * MiB;

constexpr int LDS_BYTES = 147456;
#define LAS __attribute__((address_space(3)))
typedef unsigned short bf16;
typedef unsigned v4u __attribute__((ext_vector_type(4)));
typedef float f32x4 __attribute__((ext_vector_type(4)));

__device__ __forceinline__ unsigned f2bf(float f) { unsigned u = __builtin_bit_cast(unsigned, f); return (u + 0x7fffu + ((u >> 16) & 1u)) >> 16; }
__device__ __forceinline__ unsigned pk2(float lo, float hi) { return f2bf(lo) | (f2bf(hi) << 16); }
__device__ __forceinline__ float wave_sum(float v, int lane) {
#pragma unroll
    for (int o = 1; o < 64; o <<= 1) v += __int_as_float(__builtin_amdgcn_ds_bpermute((lane ^ o) << 2, __float_as_int(v)));
    return v;
}
__device__ __forceinline__ void transpose_item(const float* W, int ldw, int K, int nblk, bf16* WT, int dst_row0, int src_col0, LAS float* scr, int item, int lane) {
    const int kb = item / nblk, nb = item % nblk, k0 = 64 * kb, n0 = 32 * nb;
#pragma unroll 8
    for (int i = 0; i < 32; ++i) { const int kk = 2 * i + (lane >> 5); scr[kk * 33 + (lane & 31)] = W[(size_t)(k0 + kk) * ldw + src_col0 + n0 + (lane & 31)]; }
    asm volatile("s_waitcnt lgkmcnt(0)" ::: "memory");
    const int c = lane & 7;
#pragma unroll
    for (int j = 0; j < 4; ++j) { const int n = (lane >> 3) + 8 * j; const LAS float* s = scr + (8 * c) * 33 + n;
        v4u o; o.x = pk2(s[0 * 33], s[1 * 33]); o.y = pk2(s[2 * 33], s[3 * 33]); o.z = pk2(s[4 * 33], s[5 * 33]); o.w = pk2(s[6 * 33], s[7 * 33]);
        *(v4u*)(WT + (size_t)(dst_row0 + n0 + n) * K + k0 + 8 * c) = o; }
    asm volatile("s_waitcnt lgkmcnt(0)" ::: "memory");
}

struct Args { const float* in[21]; float* out; unsigned char* ws; };

__device__ __forceinline__ void ssm_tables(const Args& a, int l, int g, unsigned char* ws, LAS unsigned char* lds, int tid) {
    typedef float f2 __attribute__((ext_vector_type(2)));
    LAS f2* P = (LAS f2*)lds;
    LAS f2* Qv = P + 17 * 64;
    LAS f2* Bb = Qv + 64;
    LAS f2* Cc = Bb + 64 * 16;
    LAS float* Km = (LAS float*)(Cc + 16 * 64);
    const float* lam_re = a.in[4] + (size_t)(l * NGRP + g) * NST; const float* lam_im = a.in[5] + (size_t)(l * NGRP + g) * NST;
    const float logdt = a.in[6][l * NGRP + g];
    const float* b_re = a.in[7] + (size_t)(l * NGRP + g) * NST * GCH; const float* b_im = a.in[8] + (size_t)(l * NGRP + g) * NST * GCH;
    const float* c_re = a.in[9] + (size_t)(l * NGRP + g) * GCH * NST; const float* c_im = a.in[10] + (size_t)(l * NGRP + g) * GCH * NST;
    const float* dsk = a.in[11] + (size_t)l * SW + g * GCH;
    const double dt = exp((double)logdt);
    for (int it = tid; it < 17 * 64; it += NWAVES * 64) { const int j = it >> 6, p = it & 63;
        const double ar = (double)lam_re[p] * dt, ai = (double)lam_im[p] * dt; const double mg = exp(ar * j), an = ai * j;
        const double pr = mg * cos(an), pi = mg * sin(an); P[it] = (f2){(float)pr, (float)pi};
        if (j == 1) { const double lr = lam_re[p], li = lam_im[p], nr = pr - 1.0, ni = pi, den = lr * lr + li * li;
            Qv[p] = (f2){(float)((nr * lr + ni * li) / den), (float)((ni * lr - nr * li) / den)}; } }
    __syncthreads();
    for (int it = tid; it < 1024; it += NWAVES * 64) { const int p = it >> 4; const f2 q = Qv[p]; const float br = b_re[it], bi = b_im[it];
        Bb[it] = (f2){q.x * br - q.y * bi, q.x * bi + q.y * br}; Cc[it] = (f2){c_re[it], c_im[it]}; }
    __syncthreads();
    for (int e = tid; e < 4096; e += NWAVES * 64) { const int ck = e & 15, c = (e >> 4) & 15, j = e >> 8; float s = 0.f;
        for (int p = 0; p < 64; ++p) { const f2 cc = Cc[c * 64 + p], pp = P[j * 64 + p], bb = Bb[p * 16 + ck];
            const float xr = cc.x * pp.x - cc.y * pp.y, xi = cc.x * pp.y + cc.y * pp.x; s += xr * bb.x - xi * bb.y; }
        Km[e] = s; }
    __syncthreads();
    bf16* WSB = (bf16*)(ws + WS_WSB + (size_t)l * SSM_W_LAYER) + (size_t)g * 256 * ASK; bf16* WSY = (bf16*)(ws + WS_WSY + (size_t)l * SSM_W_LAYER) + (size_t)g * 256 * ASK;
    for (int q = tid; q < 256 * 48; q += NWAVES * 64) { const int n = q / 48, k0 = (q % 48) * 8; float vy[8], vb[8];
        const int tl = n >> 4, c = n & 15;
        if (k0 < 256) { const int tk = k0 >> 4, ck0 = k0 & 15;
#pragma unroll
            for (int e = 0; e < 8; ++e) { float v = 0.f; if (tk <= tl) { v = Km[((tl - tk) * 16 + c) * 16 + ck0 + e]; if (tk == tl && ck0 + e == c) v += dsk[c]; } vy[e] = v; }
            if (n < 128) { const int p = n & 63; const f2 pw = P[(15 - tk) * 64 + p];
#pragma unroll
                for (int e = 0; e < 8; ++e) { const f2 bb = Bb[p * 16 + ck0 + e]; vb[e] = (n < 64) ? (pw.x * bb.x - pw.y * bb.y) : (pw.x * bb.y + pw.y * bb.x); } }
            else {
#pragma unroll
                for (int e = 0; e < 8; ++e) vb[e] = 0.f; }
        } else { const int p0 = (k0 - 256) & 63; const bool im = k0 >= 320;
#pragma unroll
            for (int e = 0; e < 8; ++e) { const f2 L = P[(tl + 1) * 64 + p0 + e], cc = Cc[c * 64 + p0 + e]; vy[e] = im ? -(cc.x * L.y + cc.y * L.x) : (cc.x * L.x - cc.y * L.y); vb[e] = 0.f; } }
        v4u oy, ob; oy.x = pk2(vy[0], vy[1]); oy.y = pk2(vy[2], vy[3]); oy.z = pk2(vy[4], vy[5]); oy.w = pk2(vy[6], vy[7]);
        ob.x = pk2(vb[0], vb[1]); ob.y = pk2(vb[2], vb[3]); ob.z = pk2(vb[4], vb[5]); ob.w = pk2(vb[6], vb[7]);
        *(v4u*)(WSY + (size_t)n * ASK + k0) = oy; *(v4u*)(WSB + (size_t)n * ASK + k0) = ob; }
    if (tid < 64) ((f2*)(ws + WS_LPOW))[(l * NGRP + g) * 64 + tid] = P[16 * 64 + tid];
    __syncthreads();
}

__device__ __forceinline__ float bperm(int lanesel, float v) { return __int_as_float(__builtin_amdgcn_ds_bpermute(lanesel << 2, __float_as_int(v))); }
template <bool FORGET, int R>
__device__ __forceinline__ void norm_rows(const float* X, const bf16* XBr, bf16* XBw, const float* gvec, bf16* H, const float* win  , const float* bfg, float* LOGF, int gw, int NGW, int lane) {
    f32x4 gv[4];
#pragma unroll
    for (int j = 0; j < 4; ++j) gv[j] = *((const f32x4*)gvec + lane + 64 * j);
    f32x4 wf[4][4][2];
    if (FORGET) {
#pragma unroll
        for (int j = 0; j < 4; ++j)
#pragma unroll
            for (int e = 0; e < 4; ++e) { const int k = 256 * j + 4 * lane + e; const float* wp = win + (size_t)k * NIN + 1536;
                wf[j][e][0] = *(const f32x4*)wp * gv[j][e]; wf[j][e][1] = *(const f32x4*)(wp + 4) * gv[j][e]; }
    }
    const int hsel = 4 * (lane & 1) + 2 * ((lane >> 1) & 1) + ((lane >> 2) & 1);
    const float bfv = FORGET ? bfg[hsel] : 0.f;
    for (int m0 = gw; m0 < M; m0 += NGW * R) {
        f32x4 v[R][4]; float s[R];
#pragma unroll
        for (int r = 0; r < R; ++r) { const int m = m0 + r * NGW; const size_t mr = (size_t)(m < M ? m : m0);
            if (X) { const f32x4* xr = (const f32x4*)(X + mr * DMOD) + lane; unsigned long long* xw = (unsigned long long*)(XBw + mr * DMOD) + lane;
#pragma unroll
                for (int j = 0; j < 4; ++j) { v[r][j] = xr[64 * j]; const unsigned lo = pk2(v[r][j].x, v[r][j].y), hi = pk2(v[r][j].z, v[r][j].w); xw[64 * j] = (unsigned long long)lo | ((unsigned long long)hi << 32);
                    v[r][j] = (f32x4){__uint_as_float(lo << 16), __uint_as_float(lo & 0xffff0000u), __uint_as_float(hi << 16), __uint_as_float(hi & 0xffff0000u)}; } }
            else { const unsigned long long* xr = (const unsigned long long*)(XBr + mr * DMOD) + lane;
#pragma unroll
                for (int j = 0; j < 4; ++j) { const unsigned long long w = xr[64 * j]; const unsigned lo = (unsigned)w, hi = (unsigned)(w >> 32);
                    v[r][j] = (f32x4){__uint_as_float(lo << 16), __uint_as_float(lo & 0xffff0000u), __uint_as_float(hi << 16), __uint_as_float(hi & 0xffff0000u)}; } } }
#pragma unroll
        for (int r = 0; r < R; ++r) { float t = 0.f;
#pragma unroll
            for (int j = 0; j < 4; ++j) t += (v[r][j].x * v[r][j].x + v[r][j].y * v[r][j].y) + (v[r][j].z * v[r][j].z + v[r][j].w * v[r][j].w);
            s[r] = t; }
#pragma unroll
        for (int o = 1; o < 64; o <<= 1)
#pragma unroll
            for (int r = 0; r < R; ++r) s[r] += bperm(lane ^ o, s[r]);
#pragma unroll
        for (int r = 0; r < R; ++r) { const int m = m0 + r * NGW; if (m >= M) break;
            const float rstd = 1.0f / sqrtf(s[r] * (1.f / DMOD) + RMS_EPS);
            unsigned long long* o8 = (unsigned long long*)(H + (size_t)m * DMOD) + lane;
#pragma unroll
            for (int j = 0; j < 4; ++j) { const f32x4 h = v[r][j] * rstd * gv[j]; o8[64 * j] = (unsigned long long)pk2(h.x, h.y) | ((unsigned long long)pk2(h.z, h.w) << 32); }
            if (FORGET) {
                f32x4 a0 = {0.f, 0.f, 0.f, 0.f}, a1 = {0.f, 0.f, 0.f, 0.f};
#pragma unroll
                for (int j = 0; j < 4; ++j)
#pragma unroll
                    for (int e = 0; e < 4; ++e) { a0 += wf[j][e][0] * v[r][j][e]; a1 += wf[j][e][1] * v[r][j][e]; }
                const bool b0 = lane & 1, b1 = lane & 2, b2 = lane & 4; float t4[4], t2[2];
#pragma unroll
                for (int i = 0; i < 4; ++i) { const float snd = b0 ? a0[i] : a1[i], kp = b0 ? a1[i] : a0[i]; t4[i] = kp + bperm(lane ^ 1, snd); }
#pragma unroll
                for (int i = 0; i < 2; ++i) { const float snd = b1 ? t4[i] : t4[2 + i], kp = b1 ? t4[2 + i] : t4[i]; t2[i] = kp + bperm(lane ^ 2, snd); }
                float w = (b2 ? t2[1] : t2[0]) + bperm(lane ^ 4, b2 ? t2[0] : t2[1]);
                w += bperm(lane ^ 8, w); w += bperm(lane ^ 16, w); w += bperm(lane ^ 32, w);
                if (lane < 8) { const float z = w * rstd + bfv;
                    const float ls = fminf(z, 0.f) - 0.6931471805599453f * __builtin_amdgcn_logf(1.0f + __builtin_amdgcn_exp2f(-fabsf(z) * 1.4426950408889634f));
                    LOGF[(size_t)m * 8 + hsel] = ls; }
            }
        }
    }
}
template <int R>
__device__ __forceinline__ void norm_rows_final(const bf16* XBr, float* OUT, const float* gvec, int gw, int NGW, int lane) {
    f32x4 gv[4];
#pragma unroll
    for (int j = 0; j < 4; ++j) gv[j] = *((const f32x4*)gvec + lane + 64 * j);
    for (int m0 = gw; m0 < M; m0 += NGW * R) {
        f32x4 v[R][4]; float s[R];
#pragma unroll
        for (int r = 0; r < R; ++r) { const int m = m0 + r * NGW; const unsigned long long* xr = (const unsigned long long*)(XBr + (size_t)(m < M ? m : m0) * DMOD) + lane;
#pragma unroll
            for (int j = 0; j < 4; ++j) { const unsigned long long w = xr[64 * j]; const unsigned lo = (unsigned)w, hi = (unsigned)(w >> 32);
                v[r][j] = (f32x4){__uint_as_float(lo << 16), __uint_as_float(lo & 0xffff0000u), __uint_as_float(hi << 16), __uint_as_float(hi & 0xffff0000u)}; } }
#pragma unroll
        for (int r = 0; r < R; ++r) { float t = 0.f;
#pragma unroll
            for (int j = 0; j < 4; ++j) t += (v[r][j].x * v[r][j].x + v[r][j].y * v[r][j].y) + (v[r][j].z * v[r][j].z + v[r][j].w * v[r][j].w);
            s[r] = t; }
#pragma unroll
        for (int o = 1; o < 64; o <<= 1)
#pragma unroll
            for (int r = 0; r < R; ++r) s[r] += bperm(lane ^ o, s[r]);
#pragma unroll
        for (int r = 0; r < R; ++r) { const int m = m0 + r * NGW; if (m >= M) break;
            const float rstd = 1.0f / sqrtf(s[r] * (1.f / DMOD) + RMS_EPS); f32x4* xw = (f32x4*)(OUT + (size_t)m * DMOD) + lane;
#pragma unroll
            for (int j = 0; j < 4; ++j) xw[64 * j] = v[r][j] * rstd * gv[j]; }
    }
}

#define XB_TMO      128
#define XB_XCNT(j)  (256  + 64 * (j))
#define XB_XSUB(j)  (1280 + 64 * (j))
#define XB_XGEN(j)  (2304 + 64 * (j))
#define XB_TOP      3328
#define XB_TOPGEN   3392
#define XCD_BAR_WORDS 3456
#define XB_SPIN_CAP (1u << 18)

__device__ __forceinline__ unsigned xb_ld(unsigned* p)              { return __hip_atomic_load(p, __ATOMIC_RELAXED, __HIP_MEMORY_SCOPE_AGENT); }
__device__ __forceinline__ unsigned xb_add(unsigned* p, unsigned v) { return __hip_atomic_fetch_add(p, v, __ATOMIC_RELAXED, __HIP_MEMORY_SCOPE_AGENT); }
__device__ __forceinline__ unsigned xb_xcc_id() { return (unsigned)__builtin_amdgcn_s_getreg((3 << 11) | 20) & 0xFu; }
#define XB_SPIN(cond, bar) do { unsigned _sp = 0; while (cond) { __builtin_amdgcn_s_sleep(1); \
    if ((++_sp & 255u) == 0u) { if (xb_ld(&(bar)[XB_TMO])) break; if (_sp > XB_SPIN_CAP) { atomicAdd(&(bar)[XB_TMO], 1u); break; } } } } while (0)

struct XcdBarrier {
    unsigned* bar; unsigned x;
    volatile LAS unsigned* st;
};

__device__ __forceinline__ XcdBarrier xcd_barrier_post(unsigned* bar, volatile LAS unsigned* st) {
    XcdBarrier b; b.bar = bar; b.x = xb_xcc_id(); b.st = st;
    if (threadIdx.x == 0) (void)xb_add(&bar[XB_XCNT(b.x)], 1u);
    return b;
}
__device__ __forceinline__ void xcd_barrier_complete(unsigned* bar, unsigned x, unsigned& nloc, unsigned& nx) {
    const unsigned G = gridDim.x * gridDim.y * gridDim.z;
    unsigned sum, cnt, mine, sp = 0u;
    for (;;) {
        sum = 0u; cnt = 0u; mine = 0u;
#pragma unroll
        for (unsigned j = 0; j < 16; ++j) { const unsigned c = xb_ld(&bar[XB_XCNT(j)]); sum += c; cnt += (c > 0u) ? 1u : 0u; mine = (j == x) ? c : mine; }
        if (sum == G) break;
        __builtin_amdgcn_s_sleep(1);
        if ((++sp & 255u) == 0u) { if (xb_ld(&bar[XB_TMO])) break; if (sp > XB_SPIN_CAP) { atomicAdd(&bar[XB_TMO], 1u); break; } }
    }
    nloc = mine > 0u ? mine : 1u; nx = cnt > 0u ? cnt : 1u;
}

__device__ __forceinline__ void xcd_barrier(const XcdBarrier& b) {
    asm volatile("s_waitcnt vmcnt(0)" ::: "memory");
    __syncthreads();
    if (threadIdx.x == 0) {
        unsigned* bar = b.bar;
        __builtin_amdgcn_s_waitcnt(0);
        unsigned nloc = b.st[0], nx = b.st[1];
        if (nloc == 0u) { xcd_barrier_complete(bar, b.x, nloc, nx); b.st[0] = nloc; b.st[1] = nx; }
        const unsigned old = xb_add(&bar[XB_XSUB(b.x)], 1u);
        const unsigned gen = old / nloc;
        if (old + 1u == (gen + 1u) * nloc) {
            __builtin_amdgcn_fence(__ATOMIC_RELEASE, "agent");
            asm volatile("s_waitcnt vmcnt(0)" ::: "memory");
            const unsigned og = xb_add(&bar[XB_TOP], 1u);
            const unsigned tg = og / nx;
            if (og + 1u == (tg + 1u) * nx) xb_add(&bar[XB_TOPGEN], 1u);
            else XB_SPIN(xb_ld(&bar[XB_TOPGEN]) == tg, bar);
            __builtin_amdgcn_fence(__ATOMIC_ACQUIRE, "agent");
            xb_add(&bar[XB_XGEN(b.x)], 1u);
            asm volatile("s_waitcnt vmcnt(0)" ::: "memory");
        } else {
            XB_SPIN(xb_ld(&bar[XB_XGEN(b.x)]) == gen, bar);
            __builtin_amdgcn_fence(__ATOMIC_ACQUIRE, "agent");
            asm volatile("s_waitcnt vmcnt(0)" ::: "memory");
        }
    }
    __syncthreads();
}
#ifndef PHMASK
#define PHMASK 0xFFFF
#endif
#ifndef SMALLK_ALIGN
#define SMALLK_ALIGN true
#endif
#ifndef BIGK_ALIGN
#define BIGK_ALIGN true
#endif
#ifndef DUPMASK
#define DUPMASK 0
#endif
__global__ void __launch_bounds__(NWAVES * 64, 2) fwd_megakernel(Args args) {
    extern __shared__ __attribute__((aligned(16))) unsigned char lds[];
    cg::grid_group grid = cg::this_grid();
    {
        volatile LAS unsigned* misc = (volatile LAS unsigned*)((LAS unsigned char*)lds + MISC_OFF);
        if (threadIdx.x < 32) misc[threadIdx.x] = 0u;
        __syncthreads();
    }
    XcdBarrier xbar = xcd_barrier_post((unsigned*)(args.ws + WS_CTL + WS_BARW), (volatile LAS unsigned*)((LAS unsigned char*)lds + MISC_OFF) + 8);
    if (args.ws == nullptr) grid.sync();
    LAS unsigned char* L = (LAS unsigned char*)lds;
    const int G = gridDim.x, bx = blockIdx.x, NGW = G * NWAVES;
#define TID_OPAQUE() int tid_ = threadIdx.x; asm volatile("" : "+v"(tid_)); const int tid = tid_, lane = tid & 63, wave = __builtin_amdgcn_readfirstlane(tid >> 6), gw = bx * NWAVES + wave; (void)tid; (void)lane; (void)gw
    float* out = args.out;
#define GASP __attribute__((address_space(1)))
#define WS_OPAQUE() GASP unsigned char* ws = (GASP unsigned char*)args.ws; asm volatile("" : "+s"(ws))
#define WSP(T, off) ((T*)(GASP T*)(ws + (off)))
#define GRID_SYNC1() xcd_barrier(xbar)
#ifdef DUPSYNC
#define GRID_SYNC() do { GRID_SYNC1(); GRID_SYNC1(); } while (0)
#else
#define GRID_SYNC() GRID_SYNC1()
#endif
    { TID_OPAQUE(); WS_OPAQUE(); for (int it = bx; it < DEPTH * NGRP; it += G) ssm_tables(args, it >> 5, it & 31, (unsigned char*)ws, L, tid); }
    for (int l_ = 0; l_ < DEPTH; ++l_) {
        int l = l_; asm volatile("" : "+s"(l));
#if (PHMASK >> 0) & 1
        for (int rep_ = 0; rep_ < (int)((DUPMASK >> 0) & 1) + 1; ++rep_) {
        {
            TID_OPAQUE(); WS_OPAQUE(); bf16* Win_t = WSP(bf16, WS_WIN); bf16* Wup_t = WSP(bf16, WS_WUP); bf16* Wdn_t = WSP(bf16, WS_WDN); bf16* Wout_t = WSP(bf16, WS_WOUT);
            bf16* Wa_t = WSP(bf16, WS_WA); bf16* Wb_t = WSP(bf16, WS_WB); bf16* Wglu_t = WSP(bf16, WS_WGLU); bf16* H = WSP(bf16, WS_H); float* LOGF = WSP(float, WS_LOGF);
            LAS float* scr = (LAS float*)(L + wave * 16384);
            const float* w_in = args.in[2] + (size_t)l * DMOD * NIN; const float* w_glu = args.in[12] + (size_t)l * SW * SW;
            const float* w_a = args.in[14] + (size_t)l * AW * DMOD; const float* w_b = args.in[15] + (size_t)l * SW * DMOD; const float* w_out = args.in[16] + (size_t)l * DMOD * DMOD;
            const float* w_up = args.in[18] + (size_t)l * DMOD * FF; const float* w_dn = args.in[19] + (size_t)l * FF * DMOD;
            constexpr int I_IN = 16 * 128, I_GLU = 8 * 16, I_A = 8 * 32, I_B = 8 * 32, I_OUT = 16 * 32, I_UP = 16 * 128, I_DN = 64 * 32;
            constexpr int NITEMS = I_IN + I_GLU + I_A + I_B + I_OUT + I_UP + I_DN;
            for (int it = gw; it < NITEMS; it += NGW) {
                int r = it;
                if (r < I_IN) { const int nb = r % 128; const int sc0 = (nb >= 48) ? 8 : 0;
                    transpose_item(w_in, NIN, DMOD, 128, Win_t, 0, sc0, scr, r, lane); continue; } r -= I_IN;
                if (r < I_GLU) { transpose_item(w_glu, SW, SW, 16, Wglu_t, 0, 0, scr, r, lane); continue; } r -= I_GLU;
                if (r < I_A) { transpose_item(w_a, DMOD, AW, 32, Wa_t, 0, 0, scr, r, lane); continue; } r -= I_A;
                if (r < I_B) { transpose_item(w_b, DMOD, SW, 32, Wb_t, 0, 0, scr, r, lane); continue; } r -= I_B;
                if (r < I_OUT) { transpose_item(w_out, DMOD, DMOD, 32, Wout_t, 0, 0, scr, r, lane); continue; } r -= I_OUT;
                if (r < I_UP) { transpose_item(w_up, FF, DMOD, 128, Wup_t, 0, 0, scr, r, lane); continue; } r -= I_UP;
                transpose_item(w_dn, DMOD, FF, 32, Wdn_t, 0, 0, scr, r, lane);
            }
            norm_rows<true, 2>(l == 0 ? args.in[0] : nullptr, WSP(bf16, WS_XB), WSP(bf16, WS_XB), args.in[1] + (size_t)l * DMOD, H, w_in, args.in[3] + (size_t)l * NHEADS, LOGF, gw, NGW, lane);
        }
        }
#endif
        GRID_SYNC();
#if (PHMASK >> 1) & 1
        for (int rep_ = 0; rep_ < (int)((DUPMASK >> 1) & 1) + 1; ++rep_) {
        {
            WS_OPAQUE(); bf16* H = WSP(bf16, WS_H); bf16* Win_t = WSP(bf16, WS_WIN); bf16* Qb = WSP(bf16, WS_Q); bf16* AS = WSP(bf16, WS_AS); bf16* GA = WSP(bf16, WS_GA);
            static_assert(WS_V - WS_K == WS_K - WS_Q, "Q|K|V equally spaced");
            pg8::Gemm g{H, Win_t, M, 4096, DMOD}; pg8::StaticOrder S; S.init(M, 4096, G, bx);
            pg8::EpiInProj E{Qb, AS, GA, (size_t)(WS_K - WS_Q) / 2, (size_t)(WS_GB - WS_GA) / 2};
            pg8::gemm_phase<pg8::EpiInProj, pg8::StaticOrder, BIGK_ALIGN, true>(L, g, S, E);
        }
        }
#endif
        GRID_SYNC();
#if (PHMASK >> 2) & 1
        for (int rep_ = 0; rep_ < (int)((DUPMASK >> 2) & 1) + 1; ++rep_) {
        {
            WS_OPAQUE(); bf16* AS = WSP(bf16, WS_AS); bf16* WSB_t = WSP(bf16, WS_WSB + (size_t)l * SSM_W_LAYER); float* SLOC = WSP(float, WS_SLOC);
            pg8::Gemm g{AS, WSB_t, NGRP * NCR, NGRP * 256, ASK}; pg8::SsmOrder S{G, bx};
            pg8::EpiSsmState E{SLOC};
            pg8::gemm_phase<pg8::EpiSsmState, pg8::SsmOrder, SMALLK_ALIGN, true>(L, g, S, E);
        }
        }
#endif
#if (PHMASK >> 3) & 1
        for (int rep_ = 0; rep_ < (int)((DUPMASK >> 3) & 1) + 1; ++rep_) {
        {
            typedef float f2 __attribute__((ext_vector_type(2)));
            TID_OPAQUE(); WS_OPAQUE(); bf16* AS = WSP(bf16, WS_AS); float* SLOC = WSP(float, WS_SLOC); float* LOGF = WSP(float, WS_LOGF); float* BIAS = WSP(float, WS_BIAS);
            if ((wave & 1) == 0) {
                for (int i = 0; i * G + bx < NGRP * BATCH; ++i) { if (wave != ((2 * i) & 7)) continue; const int it = i * G + bx; const int g = it >> 4, b = it & 15;
                    const f2 l16 = WSP(const f2, WS_LPOW)[(l * NGRP + g) * 64 + lane];
                    const float* sl = SLOC + ((size_t)(g * NCR + b * 256)) * 128 + lane; bf16* as = AS + ((size_t)(g * NCR + b * 256)) * ASK + 256 + lane;
                    float sr = 0.f, si = 0.f;
#pragma unroll 64
                    for (int ch = 0; ch < 256; ++ch) { as[(size_t)ch * ASK] = (bf16)f2bf(sr); as[(size_t)ch * ASK + 64] = (bf16)f2bf(si);
                        const float ar = sl[(size_t)ch * 128], ai = sl[(size_t)ch * 128 + 64];
                        const float nr = l16.x * sr - l16.y * si + ar, ni = l16.x * si + l16.y * sr + ai; sr = nr; si = ni; } }
            } else if ((gw & 3) == 1) {
                for (int sq = gw >> 2; sq < BATCH * NHEADS; sq += NGW >> 2) { const int b = sq >> 3, h = sq & 7;
                    const float* lf = LOGF + ((size_t)b * SEQ + lane * 64) * 8 + h; float tot = 0.f;
#pragma unroll
                    for (int i = 0; i < 64; ++i) tot += lf[i * 8];
                    float incl = tot;
#pragma unroll
                    for (int o = 1; o < 64; o <<= 1) { const float t = __int_as_float(__builtin_amdgcn_ds_bpermute((lane - o) << 2, __float_as_int(incl))); if (lane >= o) incl += t; }
                    float run = incl - tot; float* bo = BIAS + (size_t)sq * SEQ + lane * 64;
#pragma unroll
                    for (int i = 0; i < 64; ++i) { run += lf[i * 8]; bo[i] = -run * 1.4426950408889634f; } }
            }
        }
        }
#endif
        GRID_SYNC();
#if (PHMASK >> 4) & 1
        for (int rep_ = 0; rep_ < (int)((DUPMASK >> 4) & 1) + 1; ++rep_) {
        {
            WS_OPAQUE(); bf16* AS = WSP(bf16, WS_AS); bf16* WSY_t = WSP(bf16, WS_WSY + (size_t)l * SSM_W_LAYER); bf16* YB = WSP(bf16, WS_YB);
            pg8::Gemm g{AS, WSY_t, NGRP * NCR, NGRP * 256, ASK}; pg8::SsmOrder S{G, bx};
            pg8::EpiSsmY E{YB};
            pg8::gemm_phase<pg8::EpiSsmY, pg8::SsmOrder, SMALLK_ALIGN, true>(L, g, S, E);
        }
        {
            WS_OPAQUE(); bf16* Qb = WSP(bf16, WS_Q); bf16* Kb = WSP(bf16, WS_K); bf16* Vb = WSP(bf16, WS_V); float* BIAS = WSP(float, WS_BIAS);
            const attn_body::AttnTensors AT{(const attn_body::bf16*)Qb, (const attn_body::bf16*)Kb, (const attn_body::bf16*)Vb, (attn_body::bf16*)WSP(bf16, WS_H), BIAS};
            const attn_body::StaticOrder S(G, bx);
#ifndef NO_ATTN
            attn_body::attn_phase<attn_body::StaticOrder>((char*)lds, AT, S);
        }
#endif
        }
#endif
        GRID_SYNC();
#if (PHMASK >> 5) & 1
        for (int rep_ = 0; rep_ < (int)((DUPMASK >> 5) & 1) + 1; ++rep_) {
        {
            WS_OPAQUE(); bf16* YB = WSP(bf16, WS_YB); bf16* YB2 = WSP(bf16, WS_YB2); bf16* Wglu_t = WSP(bf16, WS_WGLU);
            pg8::Gemm g{YB, Wglu_t, M, SW, SW}; pg8::StaticOrder S; S.init(M, SW, G, bx);
            pg8::EpiGlu E{YB, YB2, args.in[13] + (size_t)l * SW};
            pg8::gemm_phase<pg8::EpiGlu, pg8::StaticOrder, SMALLK_ALIGN, true>(L, g, S, E);
        }
        }
#endif
#if (PHMASK >> 6) & 1
        for (int rep_ = 0; rep_ < (int)((DUPMASK >> 6) & 1) + 1; ++rep_) {
        {
            WS_OPAQUE(); bf16* Qb = WSP(bf16, WS_H)  ; bf16* Wa_t = WSP(bf16, WS_WA); bf16* GA = WSP(bf16, WS_GA); bf16* MIXED = WSP(bf16, WS_K)  ;
            pg8::Gemm g{Qb, Wa_t, M, DMOD, AW}; pg8::StaticOrder S; S.init(M, DMOD, G, bx);
            pg8::EpiGate<false> E{GA, MIXED};
            pg8::gemm_phase<pg8::EpiGate<false>, pg8::StaticOrder, SMALLK_ALIGN, true>(L, g, S, E);
        }
        }
#endif
        GRID_SYNC();
#if (PHMASK >> 7) & 1
        for (int rep_ = 0; rep_ < (int)((DUPMASK >> 7) & 1) + 1; ++rep_) {
        {
            WS_OPAQUE(); bf16* YB2 = WSP(bf16, WS_YB2); bf16* Wb_t = WSP(bf16, WS_WB); bf16* GB = WSP(bf16, WS_GB); bf16* MIXED = WSP(bf16, WS_K);
            pg8::Gemm g{YB2, Wb_t, M, DMOD, SW}; pg8::StaticOrder S; S.init(M, DMOD, G, bx);
            pg8::EpiGate<true> E{GB, rep_ ? WSP(bf16, WS_H) : MIXED};
            pg8::gemm_phase<pg8::EpiGate<true>, pg8::StaticOrder, SMALLK_ALIGN, true>(L, g, S, E);
        }
        }
#endif
        GRID_SYNC();
#if (PHMASK >> 8) & 1
        for (int rep_ = 0; rep_ < (int)((DUPMASK >> 8) & 1) + 1; ++rep_) {
        {
            WS_OPAQUE(); bf16* MIXED = WSP(bf16, WS_K); bf16* Wout_t = WSP(bf16, WS_WOUT);
            pg8::Gemm g{MIXED, Wout_t, M, DMOD, DMOD}; pg8::StaticOrder S; S.init(M, DMOD, G, bx);
            pg8::EpiResid E{rep_ ? WSP(bf16, WS_H) : WSP(bf16, WS_XB)};
            pg8::gemm_phase<pg8::EpiResid, pg8::StaticOrder, BIGK_ALIGN, true>(L, g, S, E);
        }
        }
#endif
        GRID_SYNC();
#if (PHMASK >> 9) & 1
        for (int rep_ = 0; rep_ < (int)((DUPMASK >> 9) & 1) + 1; ++rep_) {
        { TID_OPAQUE(); WS_OPAQUE(); norm_rows<false, 4>(nullptr, WSP(bf16, WS_XB), nullptr, args.in[17] + (size_t)l * DMOD, WSP(bf16, WS_H), nullptr, nullptr, nullptr, gw, NGW, lane); }
        }
#endif
        GRID_SYNC();
#if (PHMASK >> 10) & 1
        for (int rep_ = 0; rep_ < (int)((DUPMASK >> 10) & 1) + 1; ++rep_) {
        {
            WS_OPAQUE(); bf16* H = WSP(bf16, WS_H); bf16* Wup_t = WSP(bf16, WS_WUP); bf16* HID = WSP(bf16, WS_HID);
            pg8::Gemm g{H, Wup_t, M, FF, DMOD}; pg8::StaticOrder S; S.init(M, FF, G, bx);
            pg8::EpiRelu2 E{HID};
            pg8::gemm_phase<pg8::EpiRelu2, pg8::StaticOrder, BIGK_ALIGN, true>(L, g, S, E);
        }
        }
#endif
        GRID_SYNC();
#if (PHMASK >> 11) & 1
        for (int rep_ = 0; rep_ < (int)((DUPMASK >> 11) & 1) + 1; ++rep_) {
        {
            WS_OPAQUE(); bf16* HID = WSP(bf16, WS_HID); bf16* Wdn_t = WSP(bf16, WS_WDN);
            pg8::Gemm g{HID, Wdn_t, M, DMOD, FF}; pg8::StaticOrder S; S.init(M, DMOD, G, bx);
            pg8::EpiResid E{rep_ ? WSP(bf16, WS_H) : WSP(bf16, WS_XB)};
            pg8::gemm_phase<pg8::EpiResid, pg8::StaticOrder, BIGK_ALIGN, true>(L, g, S, E);
        }
        }
#endif
        GRID_SYNC();
    }
    { TID_OPAQUE(); WS_OPAQUE(); norm_rows_final<4>(WSP(bf16, WS_XB), out, args.in[20], gw, NGW, lane); }
}

extern "C" void kernel_launch(void* const* d_in, const int* in_sizes, int n_in, void* d_out, int out_size, void* d_ws, size_t ws_size, hipStream_t stream) {
    static int grid = 0;
    if (grid == 0) {
        if (n_in != 21 || in_sizes[0] != M * DMOD || out_size != M * DMOD || ws_size < WS_END) {
            fprintf(stderr, "kernel_launch: unexpected shapes: n_in %d in0 %d out %d ws %zu (need %zu)\n", n_in, n_in > 0 ? in_sizes[0] : -1, out_size, ws_size, (size_t)WS_END); grid = -1; return; }
        int dev = 0, cus = 0, per_cu = 0;
        hipGetDevice(&dev); hipDeviceGetAttribute(&cus, hipDeviceAttributeMultiprocessorCount, dev);
        if (hipFuncSetAttribute((const void*)fwd_megakernel, hipFuncAttributeMaxDynamicSharedMemorySize, LDS_BYTES) != hipSuccess) { fprintf(stderr, "kernel_launch: hipFuncSetAttribute failed\n"); grid = -1; return; }
        if (hipOccupancyMaxActiveBlocksPerMultiprocessor(&per_cu, (const void*)fwd_megakernel, NWAVES * 64, LDS_BYTES) != hipSuccess || per_cu < 1) per_cu = 1;
        (void)hipGetLastError();
        grid = cus * per_cu;
    }
    if (grid < 0) return;
    if (hipMemsetAsync((char*)d_ws + WS_CTL, 0, CTL_ZERO_BYTES, stream) != hipSuccess) { fprintf(stderr, "kernel_launch: hipMemsetAsync failed\n"); return; }
    Args a{};
    for (int i = 0; i < 21; ++i) a.in[i] = (const float*)d_in[i];
    a.out = (float*)d_out; a.ws = (unsigned char*)d_ws;
    void* kargs[] = {&a};
    hipError_t e = hipLaunchCooperativeKernel((const void*)fwd_megakernel, dim3(grid), dim3(NWAVES * 64), kargs, LDS_BYTES, stream);
    if (e != hipSuccess) fprintf(stderr, "cooperative launch failed: %s (grid %d)\n", hipGetErrorString(e), grid);
}
```

```cpp
#include <hip/hip_runtime.h>
#include <hip/hip_cooperative_groups.h>
#include <cstdio>
#include <cstdint>
namespace pg8 {
#define PG8_LAS __attribute__((address_space(3)))
typedef unsigned short bf16_t;
typedef short bf16x8 __attribute__((ext_vector_type(8)));
typedef float f32x4 __attribute__((ext_vector_type(4)));
typedef unsigned u32x4 __attribute__((ext_vector_type(4)));
constexpr int BM = 256, BK = 64, HALF = 128, HTB = HALF * BK * 2  , STAGE_BYTES = 8 * HTB, NXCD = 8, WGM = 8;

__host__ __device__ __forceinline__ int lds_byte(int r, int c) { const int st = (r >> 4) * 2 + (c >> 5), rr = r & 15, cc = c & 31, ob = rr * 64 + cc * 2; return st * 1024 + (ob ^ (((ob >> 9) & 1) << 5)); }
__host__ __device__ __forceinline__ void stage_rc(int b, int& R, int& C) { const int st = b / 1024, sb = b % 1024, swz = sb ^ (((sb >> 9) & 1) << 5); R = (st >> 1) * 16 + swz / 64; C = (st & 1) * 32 + (swz % 64) / 2; }
__host__ __device__ __forceinline__ int perm32(int rho) { const int n = rho >> 4, i = rho & 15; return 8 * (i >> 2) + 4 * n + (i & 3); }

struct Unit { int pm, pn; };
struct Gemm { const bf16_t* A; const bf16_t* Bt; int M, N, K; };

struct StaticOrder {
    int nM, nN, nwg, G, c;
    __host__ __device__ void init(int M, int N, int G_, int c_) { nM = M / BM; nN = N / BM; nwg = nM * nN; G = G_; c = c_; }
    __host__ __device__ bool next(int i, Unit& u) const {
        const long L = (long)i * G + c; if (L >= nwg) return false;
        int wgid = (int)L; { const int q = nwg / NXCD, r = nwg % NXCD, xcd = wgid % NXCD, off = wgid / NXCD; wgid = (xcd < r ? xcd * (q + 1) : r * (q + 1) + (xcd - r) * q) + off; }
        const int nig = WGM * nN, gid = wgid / nig, fm = gid * WGM, gsz = (nM - fm) < WGM ? (nM - fm) : WGM;
        u.pm = fm + ((wgid % nig) % gsz); u.pn = (wgid % nig) / gsz; return true;
    }
    __device__ __forceinline__ void a_ready(const Unit&) const {}
    __device__ __forceinline__ void done(const Unit&) const {}
};

typedef float f32x2c_t __attribute__((ext_vector_type(2))); typedef __bf16 bf16x2c_t __attribute__((ext_vector_type(2)));
__device__ __forceinline__ unsigned cvt_pk_bf16(float lo, float hi) { f32x2c_t v = {lo, hi}; bf16x2c_t b = __builtin_convertvector(v, bf16x2c_t); return __builtin_bit_cast(unsigned, b); }
typedef float f32x2 __attribute__((ext_vector_type(2)));
__device__ __forceinline__ f32x2 gelu_pk(f32x2 v) {
    const f32x2 av = __builtin_elementwise_abs(v), d = av * 0.2316418882f + 1.0f;
    f32x2 t; t.x = __builtin_amdgcn_rcpf(d.x); t.y = __builtin_amdgcn_rcpf(d.y);
    f32x2 q = t * 0.5307027145f + (-0.7265760135f); q = q * t + 0.7107068705f; q = q * t + (-0.142248368f); q = q * t + 0.127414796f; q = q * t;
    const f32x2 s = (v * v) * (-0.72134752044f);
    f32x2 e; e.x = __builtin_amdgcn_exp2f(s.x); e.y = __builtin_amdgcn_exp2f(s.y);
    const f32x2 m = v * (q * e), r = v - m;
    f32x2 o; o.x = v.x < 0.f ? m.x : r.x; o.y = v.y < 0.f ? m.y : r.y; return o;
}

constexpr float LOG2E = 1.4426950408889634f;
constexpr float QC2 = 0.125f * 1.4426950408889634f;
__device__ __forceinline__ float sigm(float x) { return __builtin_amdgcn_rcpf(1.0f + __builtin_amdgcn_exp2f(-x * LOG2E)); }
__device__ __forceinline__ float gelu_tanh(float x) { const float z = 1.5957691216057308f * (x + 0.044715f * x * x * x); return x * sigm(z); }
__device__ __forceinline__ u32x4 pack8(const f32x4 v0, const f32x4 v1) { u32x4 w; w.x = cvt_pk_bf16(v0[0], v0[1]); w.y = cvt_pk_bf16(v0[2], v0[3]); w.z = cvt_pk_bf16(v1[0], v1[1]); w.w = cvt_pk_bf16(v1[2], v1[3]); return w; }
__device__ __forceinline__ float bf_lo(unsigned w) { return __uint_as_float(w << 16); }
__device__ __forceinline__ float bf_hi(unsigned w) { return __uint_as_float(w & 0xffff0000u); }
#define EPI_LOOP_BEGIN \
    _Pragma("unroll") for (int ai = 0; ai < 2; ++ai) _Pragma("unroll") for (int m = 0; m < 4; ++m) { const int row = u.pm * BM + ai * HALF + wr * 64 + m * 16 + fr; \
    _Pragma("unroll") for (int bj = 0; bj < 2; ++bj) { const int ct = bj * HALF + wc * 32 + 8 * fq; f32x4 v0 = acc[ai][bj][m][0], v1 = acc[ai][bj][m][1];
#define EPI_LOOP_END } }
#define EPI_SIG(v0, v1) do { _Pragma("unroll") for (int e_ = 0; e_ < 4; ++e_) { v0[e_] = sigm(v0[e_]); v1[e_] = sigm(v1[e_]); } } while (0)

struct EpiInProj {
    static constexpr bool PERM = true, AFTER_DRAIN = false;
    bf16_t *Q, *AS, *GA; size_t qkv_stride, gate_stride;
    __device__ __forceinline__ void operator()(const f32x4 (&acc)[2][2][4][2], const Unit& u, int wr, int wc, int fr, int fq) const {
        const int pn = u.pn;
        if (pn < 6) {
            bf16_t* base = Q + (size_t)(pn >> 1) * qkv_stride; const float sc = pn < 2 ? QC2 : 1.0f; const int cb = (pn & 1) * 256;
            EPI_LOOP_BEGIN v0 = v0 * sc; v1 = v1 * sc; *(u32x4*)(base + (size_t)row * 512 + cb + ct) = pack8(v0, v1); EPI_LOOP_END
        } else if (pn < 8) {
            const int cb = (pn - 6) * 256;
            EPI_LOOP_BEGIN const int j = cb + ct; const int g = j >> 4;
                *(u32x4*)(AS + ((size_t)(g * 4096 + (row >> 4))) * 384 + (row & 15) * 16 + (j & 15)) = pack8(v0, v1); EPI_LOOP_END
        } else {
            bf16_t* base = GA + (size_t)((pn - 8) >> 2) * gate_stride; const int cb = ((pn - 8) & 3) * 256;
            EPI_LOOP_BEGIN EPI_SIG(v0, v1); *(u32x4*)(base + (size_t)row * 1024 + cb + ct) = pack8(v0, v1); EPI_LOOP_END
        }
    }
};
struct EpiSsmState {
    static constexpr bool PERM = true, AFTER_DRAIN = false;
    float* SLOC;
    __device__ __forceinline__ void operator()(const f32x4 (&acc)[2][2][4][2], const Unit& u, int wr, int wc, int fr, int fq) const {
        EPI_LOOP_BEGIN if (bj == 0) { float* d = SLOC + (size_t)row * 128 + ct; *(f32x4*)d = v0; *(f32x4*)(d + 4) = v1; } EPI_LOOP_END
    }
};
struct EpiSsmY {
    static constexpr bool PERM = true, AFTER_DRAIN = false;
    bf16_t* YB;
    __device__ __forceinline__ void operator()(const f32x4 (&acc)[2][2][4][2], const Unit& u, int wr, int wc, int fr, int fq) const {
        EPI_LOOP_BEGIN const int g = row >> 12, cr = row & 4095, tl = ct >> 4, c0 = ct & 15;
            _Pragma("unroll") for (int e = 0; e < 4; ++e) { v0[e] = gelu_tanh(v0[e]); v1[e] = gelu_tanh(v1[e]); }
            *(u32x4*)(YB + ((size_t)(cr * 16 + tl)) * 512 + g * 16 + c0) = pack8(v0, v1); EPI_LOOP_END
    }
};
#define EPI_ROW(ai, m) (u.pm * BM + (ai) * HALF + wr * 64 + (m) * 16 + fr)
#define EPI_CT(bj) ((bj) * HALF + wc * 32 + 8 * fq)
struct EpiGlu {
    static constexpr bool PERM = true, AFTER_DRAIN = false;
    const bf16_t* YB; bf16_t* O; const float* bias;
    __device__ __forceinline__ void operator()(const f32x4 (&acc)[2][2][4][2], const Unit& u, int wr, int wc, int fr, int fq) const {
        u32x4 y[2][4][2]; f32x4 bb[2][2];
        _Pragma("unroll") for (int bj = 0; bj < 2; ++bj) { const int col = u.pn * BM + EPI_CT(bj); bb[bj][0] = *(const f32x4*)(bias + col); bb[bj][1] = *(const f32x4*)(bias + col + 4); }
        _Pragma("unroll") for (int ai = 0; ai < 2; ++ai) _Pragma("unroll") for (int m = 0; m < 4; ++m) _Pragma("unroll") for (int bj = 0; bj < 2; ++bj)
            y[ai][m][bj] = *(const u32x4*)(YB + (size_t)EPI_ROW(ai, m) * 512 + u.pn * BM + EPI_CT(bj));
        _Pragma("unroll") for (int ai = 0; ai < 2; ++ai) _Pragma("unroll") for (int m = 0; m < 4; ++m) _Pragma("unroll") for (int bj = 0; bj < 2; ++bj) {
            f32x4 v0 = acc[ai][bj][m][0] + bb[bj][0], v1 = acc[ai][bj][m][1] + bb[bj][1]; const u32x4 yy = y[ai][m][bj]; EPI_SIG(v0, v1);
            v0[0] *= bf_lo(yy.x); v0[1] *= bf_hi(yy.x); v0[2] *= bf_lo(yy.y); v0[3] *= bf_hi(yy.y); v1[0] *= bf_lo(yy.z); v1[1] *= bf_hi(yy.z); v1[2] *= bf_lo(yy.w); v1[3] *= bf_hi(yy.w);
            *(u32x4*)(O + (size_t)EPI_ROW(ai, m) * 512 + u.pn * BM + EPI_CT(bj)) = pack8(v0, v1); }
    }
};
template <bool ADD> struct EpiGate {
    static constexpr bool PERM = true, AFTER_DRAIN = false;
    const bf16_t* G; bf16_t* O;
    __device__ __forceinline__ void operator()(const f32x4 (&acc)[2][2][4][2], const Unit& u, int wr, int wc, int fr, int fq) const {
        _Pragma("unroll") for (int ai = 0; ai < 2; ++ai) {
            u32x4 gt[4][2], oo[4][2];
            _Pragma("unroll") for (int m = 0; m < 4; ++m) _Pragma("unroll") for (int bj = 0; bj < 2; ++bj) { const size_t off = (size_t)EPI_ROW(ai, m) * 1024 + u.pn * BM + EPI_CT(bj);
                gt[m][bj] = *(const u32x4*)(G + off); if (ADD) oo[m][bj] = *(const u32x4*)(O + off); }
            _Pragma("unroll") for (int m = 0; m < 4; ++m) _Pragma("unroll") for (int bj = 0; bj < 2; ++bj) { const size_t off = (size_t)EPI_ROW(ai, m) * 1024 + u.pn * BM + EPI_CT(bj);
                f32x4 v0 = acc[ai][bj][m][0], v1 = acc[ai][bj][m][1]; const u32x4 g4 = gt[m][bj];
                v0[0] *= bf_lo(g4.x); v0[1] *= bf_hi(g4.x); v0[2] *= bf_lo(g4.y); v0[3] *= bf_hi(g4.y); v1[0] *= bf_lo(g4.z); v1[1] *= bf_hi(g4.z); v1[2] *= bf_lo(g4.w); v1[3] *= bf_hi(g4.w);
                if (ADD) { const u32x4 o = oo[m][bj];
                    v0[0] += bf_lo(o.x); v0[1] += bf_hi(o.x); v0[2] += bf_lo(o.y); v0[3] += bf_hi(o.y); v1[0] += bf_lo(o.z); v1[1] += bf_hi(o.z); v1[2] += bf_lo(o.w); v1[3] += bf_hi(o.w); }
                *(u32x4*)(O + off) = pack8(v0, v1); }
            asm volatile("" ::: "memory");
        }
    }
};
struct EpiResid {
    static constexpr bool PERM = true, AFTER_DRAIN = false;
    bf16_t* X;
    __device__ __forceinline__ void operator()(const f32x4 (&acc)[2][2][4][2], const Unit& u, int wr, int wc, int fr, int fq) const {
        u32x4 xo[2][4][2];
        _Pragma("unroll") for (int ai = 0; ai < 2; ++ai) _Pragma("unroll") for (int m = 0; m < 4; ++m) _Pragma("unroll") for (int bj = 0; bj < 2; ++bj)
            xo[ai][m][bj] = *(const u32x4*)(X + (size_t)EPI_ROW(ai, m) * 1024 + u.pn * BM + EPI_CT(bj));
        _Pragma("unroll") for (int ai = 0; ai < 2; ++ai) _Pragma("unroll") for (int m = 0; m < 4; ++m) _Pragma("unroll") for (int bj = 0; bj < 2; ++bj) {
            f32x4 v0 = acc[ai][bj][m][0], v1 = acc[ai][bj][m][1]; const u32x4 o = xo[ai][m][bj];
            v0[0] += bf_lo(o.x); v0[1] += bf_hi(o.x); v0[2] += bf_lo(o.y); v0[3] += bf_hi(o.y); v1[0] += bf_lo(o.z); v1[1] += bf_hi(o.z); v1[2] += bf_lo(o.w); v1[3] += bf_hi(o.w);
            *(u32x4*)(X + (size_t)EPI_ROW(ai, m) * 1024 + u.pn * BM + EPI_CT(bj)) = pack8(v0, v1); }
    }
};
struct EpiRelu2 {
    static constexpr bool PERM = true, AFTER_DRAIN = false;
    bf16_t* O;
    __device__ __forceinline__ void operator()(const f32x4 (&acc)[2][2][4][2], const Unit& u, int wr, int wc, int fr, int fq) const {
        EPI_LOOP_BEGIN _Pragma("unroll") for (int e = 0; e < 4; ++e) { const float a = fmaxf(v0[e], 0.f), b = fmaxf(v1[e], 0.f); v0[e] = a * a; v1[e] = b * b; }
            *(u32x4*)(O + (size_t)row * 4096 + u.pn * BM + ct) = pack8(v0, v1); EPI_LOOP_END
    }
};
struct SsmOrder {
    int G, c;
    __device__ __forceinline__ bool next(int i, Unit& u) const { const int L = i * G + c; if (L >= 512) return false; u.pm = L; u.pn = L >> 4; return true; }
    __device__ __forceinline__ void a_ready(const Unit&) const {}
    __device__ __forceinline__ void done(const Unit&) const {}
};

template <class Epi, class Sched, bool ALIGN_EPI = false, bool SP2 = false>
__device__ __forceinline__ void gemm_phase(PG8_LAS unsigned char* lds, const Gemm g, const Sched& S, const Epi& E) {
    int tid_ = threadIdx.x; asm volatile("" : "+v"(tid_));
    const int tid = tid_, wid = __builtin_amdgcn_readfirstlane(tid >> 6), lane = tid & 63, wr = wid >> 2, wc = wid & 3, fr = lane & 15, fq = lane >> 4;
    const int K = g.K, nt = K / BK;
    unsigned voffA[2], voffB[2];
#pragma unroll
    for (int i = 0; i < 2; ++i) { int R, C; stage_rc(tid * 16 + i * 8192, R, C); const int Rb = Epi::PERM ? ((R & ~31) + perm32(R & 31)) : R;
        voffA[i] = (unsigned)(R * K + C) * 2u; voffB[i] = (unsigned)(Rb * K + C) * 2u; }
    const size_t kstep = (size_t)(BK * 2);
    const size_t hstep = (size_t)HALF * K * 2;
    const size_t tstep = 2 * hstep;
    const unsigned ldsw = (unsigned)wid * 1024u;
    const int aoff = lds_byte(wr * 64 + fr, fq * 8), boff = lds_byte(wc * 32 + fr, fq * 8);
#define PG8_SA(b, h) (((b) * 2 + (h)) * HTB)
#define PG8_SB(b, h) ((4 + (b) * 2 + (h)) * HTB)
#define PG8_STAGE(bufoff, gbase, voff) do { _Pragma("unroll") for (int _i = 0; _i < 2; ++_i) \
        __builtin_amdgcn_global_load_lds((const unsigned*)((const char*)(gbase) + (voff)[_i]), (PG8_LAS unsigned*)(lds + (bufoff) + ldsw + _i * 8192), 16, 0, 0); } while (0)
#define PG8_LDA(dst, b, h) do { _Pragma("unroll") for (int m = 0; m < 4; ++m) _Pragma("unroll") for (int k = 0; k < 2; ++k) dst[m][k] = *(const PG8_LAS bf16x8*)(lds + PG8_SA(b, h) + aoff + m * 2048 + k * 1024); } while (0)
#define PG8_LDB(dst, b, h) do { _Pragma("unroll") for (int n = 0; n < 2; ++n) _Pragma("unroll") for (int k = 0; k < 2; ++k) dst[n][k] = *(const PG8_LAS bf16x8*)(lds + PG8_SB(b, h) + boff + n * 2048 + k * 1024); } while (0)
#define PG8_MMA(ai, bj, At, Bt) do { __builtin_amdgcn_s_setprio(1); _Pragma("unroll") for (int m = 0; m < 4; ++m) _Pragma("unroll") for (int n = 0; n < 2; ++n) _Pragma("unroll") for (int k = 0; k < 2; ++k) \
        acc[ai][bj][m][n] = __builtin_amdgcn_mfma_f32_16x16x32_bf16(Bt[n][k], At[m][k], acc[ai][bj][m][n], 0, 0, 0); __builtin_amdgcn_s_setprio(0); } while (0)
#define PG8_WAIT_V(n) asm volatile("s_waitcnt vmcnt(" #n ")" ::: "memory")
#define PG8_WAIT_L(n) asm volatile("s_waitcnt lgkmcnt(" #n ")" ::: "memory")
#define PG8_BAR __builtin_amdgcn_s_barrier()
#define PG8_SCHED __builtin_amdgcn_sched_barrier(0)
    Unit cur, nxt; int ui = 0;
    if (!S.next(0, cur)) return;
    f32x4 acc[2][2][4][2];
#pragma unroll
    for (int a = 0; a < 2; ++a)
#pragma unroll
        for (int b = 0; b < 2; ++b)
#pragma unroll
            for (int m = 0; m < 4; ++m)
#pragma unroll
                for (int n = 0; n < 2; ++n) acc[a][b][m][n] = (f32x4){0.f, 0.f, 0.f, 0.f};
    bf16x8 At[4][2], B0[2][2], B1[2][2];
    const char* cA = (const char*)g.A + (size_t)cur.pm * tstep; const char* cB = (const char*)g.Bt + (size_t)cur.pn * tstep;
    S.a_ready(cur);
    if constexpr (SP2) {
        PG8_STAGE(PG8_SB(0, 0), cB, voffB); PG8_STAGE(PG8_SB(0, 1), cB + hstep, voffB); PG8_STAGE(PG8_SA(0, 0), cA, voffA); PG8_STAGE(PG8_SA(0, 1), cA + hstep, voffA);
        if (wr == 1) PG8_BAR;
        PG8_WAIT_V(2); PG8_BAR;
        PG8_STAGE(PG8_SB(1, 0), cB + kstep, voffB); PG8_STAGE(PG8_SA(1, 0), cA + kstep, voffA); PG8_STAGE(PG8_SB(1, 1), cB + hstep + kstep, voffB);
        PG8_WAIT_V(6); PG8_BAR;
    } else {
        PG8_STAGE(PG8_SB(0, 0), cB, voffB); PG8_STAGE(PG8_SA(0, 0), cA, voffA); PG8_STAGE(PG8_SB(0, 1), cB + hstep, voffB); PG8_STAGE(PG8_SA(0, 1), cA + hstep, voffA);
        if (wr == 1) PG8_BAR;
        PG8_WAIT_V(4); PG8_BAR;
        PG8_STAGE(PG8_SB(1, 0), cB + kstep, voffB); PG8_STAGE(PG8_SA(1, 0), cA + kstep, voffA); PG8_STAGE(PG8_SB(1, 1), cB + hstep + kstep, voffB);
        PG8_WAIT_V(6); PG8_BAR;
    }
    for (;;) {
        const bool has_next = S.next(ui + 1, nxt);
        const char* nA = has_next ? (const char*)g.A + (size_t)nxt.pm * tstep : cA; const char* nB = has_next ? (const char*)g.Bt + (size_t)nxt.pn * tstep : cB;
        for (int t = 0; t < nt; t += 2) {
            const bool last = (t == nt - 2);
            const char* a1 = cA + (size_t)(t + 1) * kstep;
            const char* a2 = last ? nA : cA + (size_t)(t + 2) * kstep; const char* b2 = last ? nB : cB + (size_t)(t + 2) * kstep;
            const char* a3 = a2 + kstep; const char* b3 = b2 + kstep;
            if (last && has_next) S.a_ready(nxt);
            if constexpr (SP2) {
            PG8_LDB(B0, 0, 0); PG8_LDB(B1, 0, 1); PG8_SCHED; PG8_LDA(At, 0, 0); PG8_STAGE(PG8_SA(1, 1), a1 + hstep, voffA);
            PG8_WAIT_V(8); PG8_WAIT_L(0); PG8_BAR; PG8_MMA(0, 0, At, B0); PG8_MMA(0, 1, At, B1); PG8_BAR; PG8_SCHED;
            PG8_LDA(At, 0, 1); PG8_STAGE(PG8_SB(0, 0), b2, voffB); PG8_STAGE(PG8_SB(0, 1), b2 + hstep, voffB); PG8_STAGE(PG8_SA(0, 0), a2, voffA);
            PG8_WAIT_V(8); PG8_WAIT_L(0); PG8_BAR; PG8_MMA(1, 0, At, B0); PG8_MMA(1, 1, At, B1); PG8_BAR; PG8_SCHED;
            PG8_LDB(B0, 1, 0); PG8_LDB(B1, 1, 1); PG8_SCHED; PG8_LDA(At, 1, 0); PG8_STAGE(PG8_SA(0, 1), a2 + hstep, voffA);
            PG8_WAIT_V(8); PG8_WAIT_L(0); PG8_BAR; PG8_MMA(0, 0, At, B0); PG8_MMA(0, 1, At, B1); PG8_BAR; PG8_SCHED;
            PG8_LDA(At, 1, 1); PG8_STAGE(PG8_SB(1, 0), b3, voffB); PG8_STAGE(PG8_SB(1, 1), b3 + hstep, voffB); PG8_STAGE(PG8_SA(1, 0), a3, voffA);
            PG8_WAIT_V(8); PG8_WAIT_L(0); PG8_BAR; PG8_MMA(1, 0, At, B0); PG8_MMA(1, 1, At, B1); PG8_BAR; PG8_SCHED;
            } else {
            PG8_LDB(B0, 0, 0); PG8_SCHED; PG8_LDA(At, 0, 0); PG8_STAGE(PG8_SA(1, 1), a1 + hstep, voffA);
            PG8_WAIT_L(8); PG8_BAR; PG8_WAIT_L(0); PG8_MMA(0, 0, At, B0); PG8_BAR; PG8_SCHED;
            PG8_LDB(B1, 0, 1); PG8_STAGE(PG8_SB(0, 0), b2, voffB);
            PG8_BAR; PG8_WAIT_L(0); PG8_MMA(0, 1, At, B1); PG8_BAR;
            PG8_LDA(At, 0, 1); PG8_STAGE(PG8_SA(0, 0), a2, voffA);
            PG8_BAR; PG8_WAIT_L(0); PG8_MMA(1, 0, At, B0); PG8_BAR; PG8_SCHED;
            PG8_STAGE(PG8_SB(0, 1), b2 + hstep, voffB);
            PG8_WAIT_V(6); PG8_BAR; PG8_MMA(1, 1, At, B1); PG8_BAR;
            PG8_LDB(B0, 1, 0); PG8_SCHED; PG8_LDA(At, 1, 0); PG8_STAGE(PG8_SA(0, 1), a2 + hstep, voffA);
            PG8_WAIT_L(8); PG8_BAR; PG8_WAIT_L(0); PG8_MMA(0, 0, At, B0); PG8_BAR; PG8_SCHED;
            PG8_LDB(B1, 1, 1); PG8_STAGE(PG8_SB(1, 0), b3, voffB);
            PG8_BAR; PG8_WAIT_L(0); PG8_MMA(0, 1, At, B1); PG8_BAR;
            PG8_LDA(At, 1, 1); PG8_STAGE(PG8_SA(1, 0), a3, voffA);
            PG8_BAR; PG8_WAIT_L(0); PG8_MMA(1, 0, At, B0); PG8_BAR; PG8_SCHED;
            PG8_STAGE(PG8_SB(1, 1), b3 + hstep, voffB);
            PG8_WAIT_V(6); PG8_BAR; PG8_MMA(1, 1, At, B1); PG8_BAR;
            }
        }
        if constexpr (ALIGN_EPI) { if (wr == 0) PG8_BAR; }
        if constexpr (!Epi::AFTER_DRAIN) { E(acc, cur, wr, wc, fr, fq); S.done(cur); }
        if (!has_next) break;
#pragma unroll
        for (int a = 0; a < 2; ++a)
#pragma unroll
            for (int b = 0; b < 2; ++b)
#pragma unroll
                for (int m = 0; m < 4; ++m)
#pragma unroll
                    for (int n = 0; n < 2; ++n) acc[a][b][m][n] = (f32x4){0.f, 0.f, 0.f, 0.f};
        cur = nxt; cA = nA; cB = nB; ++ui;
        if constexpr (ALIGN_EPI) { if (wr == 1) PG8_BAR; }
    }
    PG8_WAIT_V(0);
    if constexpr (!ALIGN_EPI) { if (wr == 0) PG8_BAR; }
    PG8_BAR;
    if constexpr (Epi::AFTER_DRAIN) { E.fused(acc, cur, wr, wc, fr, fq, lds, wid, lane); S.done(cur); }
#undef PG8_SA
#undef PG8_SB
#undef PG8_STAGE
#undef PG8_LDA
#undef PG8_LDB
#undef PG8_MMA
#undef PG8_WAIT_V
#undef PG8_WAIT_L
#undef PG8_BAR
#undef PG8_SCHED
}
}
#include <hip/hip_bf16.h>
#include <cmath>
namespace attn_body {
using bf16=__hip_bfloat16;
using bf16x8=__attribute__((ext_vector_type(8)))short;
using s16x4=__attribute__((ext_vector_type(4)))short;
using f32x16=__attribute__((ext_vector_type(16)))float;
using u32x4=__attribute__((ext_vector_type(4)))unsigned;
constexpr int BATCH=16,NHEAD=8,SEQ=4096,D=64,DM=NHEAD*D;
constexpr int NW=8,QBLK=32,QB=QBLK*NW,KVBLK=64,NQB=SEQ/QB;
constexpr int ATTN_PITCH=DM, ATTN_UNIT_ROWS=QB;
__device__ __forceinline__ int crow(int r,int hi){return (r&3)+8*(r>>2)+4*hi;}
#define SBAR() __builtin_amdgcn_sched_barrier(0)
__device__ __forceinline__ void cmask(f32x16&p0,f32x16&p1,int jb,int qrel,int hi){
  const float NEG=-INFINITY; int kb=64*jb+4*hi;
  #pragma unroll
  for(int r=0;r<16;++r){int kv=kb+(r&3)+8*(r>>2); if(kv>qrel)p0[r]=NEG; if(kv+32>qrel)p1[r]=NEG;}
}

constexpr int NSLOT=3, SLOTB=8192;
constexpr int LDS_K=0, LDS_V=NSLOT*SLOTB, LDS_WS=2*NSLOT*SLOTB, LDS_OST=LDS_WS+NW*64*4, LDS_BIAS=LDS_OST+NW*4096, LDS_BYTES=LDS_BIAS+SEQ*4;
constexpr float C2=0.125f*1.4426950408889634f;
__device__ __forceinline__ void glds16(const void*gsrc,unsigned lds_dst){unsigned keep;
  asm volatile("s_mov_b32 %0, m0\n\ts_mov_b32 m0, %2\n\ts_nop 0\n\tglobal_load_lds_dwordx4 %1, off\n\ts_mov_b32 m0, %0":"=&s"(keep):"v"(gsrc),"s"(lds_dst):"memory");}
__device__ __forceinline__ float max3f(float a,float b,float c){float r;asm("v_max3_f32 %0, %1, %2, %3":"=v"(r):"v"(a),"v"(b),"v"(c));return r;}
__device__ __forceinline__ float max2f(float a,float b){float r;asm("v_max_f32_e32 %0, %1, %2":"=v"(r):"v"(a),"v"(b));return r;}
__device__ __forceinline__ float fadd_s(float a,float b){float r;asm("v_add_f32_e32 %0, %1, %2":"=v"(r):"v"(a),"v"(b));return r;}
__device__ __forceinline__ float fsub_s(float a,float b){float r;asm("v_sub_f32_e32 %0, %1, %2":"=v"(r):"v"(a),"v"(b));return r;}
typedef float f32x4_t __attribute__((ext_vector_type(4))); typedef float f32x2_t __attribute__((ext_vector_type(2))); typedef __bf16 bf16x2_t __attribute__((ext_vector_type(2)));
__device__ __forceinline__ unsigned cvtpk_s(float lo,float hi){f32x2_t v={lo,hi};bf16x2_t b=__builtin_convertvector(v,bf16x2_t);return __builtin_bit_cast(unsigned,b);}
#define WAIT_BAR(N) asm volatile("s_waitcnt vmcnt(" #N ") lgkmcnt(0)\n\ts_barrier":::"memory")

__device__ __forceinline__ void qkt(f32x16&p0,f32x16&p1,const char*Kslot,const bf16x8*qr,const f32x16&negm,int r32,int hi){
  const char*kb=Kslot+hi*1024+r32*16;
  #pragma unroll
  for(int d0=0;d0<4;++d0){
    const bf16x8 b0=*reinterpret_cast<const bf16x8*>(kb+d0*2048);
    const bf16x8 b1=*reinterpret_cast<const bf16x8*>(kb+d0*2048+512);
    if(d0==0){p0=__builtin_amdgcn_mfma_f32_32x32x16_bf16(b0,qr[0],negm,0,0,0);p1=__builtin_amdgcn_mfma_f32_32x32x16_bf16(b1,qr[0],negm,0,0,0);}
    else{p0=__builtin_amdgcn_mfma_f32_32x32x16_bf16(b0,qr[d0],p0,0,0,0);p1=__builtin_amdgcn_mfma_f32_32x32x16_bf16(b1,qr[d0],p1,0,0,0);}}
}
typedef __attribute__((address_space(3))) const char* lds_cptr;
typedef short v4i16_t __attribute__((ext_vector_type(4)));
__device__ __forceinline__ void kload8(bf16x8*kf,lds_cptr kp){
  kf[0]=*(const __attribute__((address_space(3))) bf16x8*)(kp);      kf[1]=*(const __attribute__((address_space(3))) bf16x8*)(kp+512);
  kf[2]=*(const __attribute__((address_space(3))) bf16x8*)(kp+2048); kf[3]=*(const __attribute__((address_space(3))) bf16x8*)(kp+2560);
  kf[4]=*(const __attribute__((address_space(3))) bf16x8*)(kp+4096); kf[5]=*(const __attribute__((address_space(3))) bf16x8*)(kp+4608);
  kf[6]=*(const __attribute__((address_space(3))) bf16x8*)(kp+6144); kf[7]=*(const __attribute__((address_space(3))) bf16x8*)(kp+6656);
}
__device__ __forceinline__ void kload2(bf16x8*kf,lds_cptr kp,int j){ kf[2*j]=*(const __attribute__((address_space(3))) bf16x8*)(kp+j*2048); kf[2*j+1]=*(const __attribute__((address_space(3))) bf16x8*)(kp+j*2048+512); }
__device__ __forceinline__ s16x4 vtr(lds_cptr p){ return __builtin_bit_cast(s16x4,__builtin_amdgcn_ds_read_tr16_b64_v4i16((__attribute__((address_space(3))) v4i16_t*)p)); }
__device__ __forceinline__ float rowmax(const f32x16&p0,const f32x16&p1){
  float a=max3f(p0[0],p0[1],p1[0]),b=max3f(p0[2],p0[3],p1[1]);a=max3f(a,p1[2],p1[3]);
  #pragma unroll
  for(int r=4;r<16;r+=4){a=max3f(a,p0[r],p0[r+1]);b=max3f(b,p0[r+2],p0[r+3]);a=max3f(a,p1[r],p1[r+1]);b=max3f(b,p1[r+2],p1[r+3]);}
  const float m=max2f(a,b);
  auto rr=__builtin_amdgcn_permlane32_swap(__float_as_uint(m),__float_as_uint(m),false,false);
  return max2f(__uint_as_float(rr[0]),__uint_as_float(rr[1]));
}
__device__ __forceinline__ void pv(f32x16*o,int vb,bf16x8 pa0,bf16x8 pa1,bf16x8 pa2,bf16x8 pa3){
  #pragma unroll
  for(int d0=0;d0<2;++d0){s16x4 lo[4],hi[4];
    #pragma unroll
    for(int ks=0;ks<4;++ks){
      asm volatile("ds_read_b64_tr_b16 %0,%1 offset:%c2":"=&v"(lo[ks]):"v"(vb),"i"(d0*4096+ks*1024):"memory");
      asm volatile("ds_read_b64_tr_b16 %0,%1 offset:%c2":"=&v"(hi[ks]):"v"(vb),"i"(d0*4096+ks*1024+512):"memory");}
    asm volatile("s_waitcnt lgkmcnt(0)":::"memory");SBAR();
    #define PK(k) (bf16x8){lo[k][0],lo[k][1],lo[k][2],lo[k][3],hi[k][0],hi[k][1],hi[k][2],hi[k][3]}
    o[d0]=__builtin_amdgcn_mfma_f32_32x32x16_bf16(pa0,PK(0),o[d0],0,0,0);
    o[d0]=__builtin_amdgcn_mfma_f32_32x32x16_bf16(pa1,PK(1),o[d0],0,0,0);
    o[d0]=__builtin_amdgcn_mfma_f32_32x32x16_bf16(pa2,PK(2),o[d0],0,0,0);
    o[d0]=__builtin_amdgcn_mfma_f32_32x32x16_bf16(pa3,PK(3),o[d0],0,0,0);
    #undef PK
  }
}

#ifndef ATTN_STORE16
#define ATTN_STORE16(p,v) (*(u32x4*)(p)=(v))
#endif
template<int THRL> __device__ __forceinline__ void attn_unit(int b,int h,int qb,const bf16*Q,const bf16*__restrict__ K,const bf16*__restrict__ V,bf16*O,const float*__restrict__ BIASG,char*shm){
  int tid_=threadIdx.x; asm volatile("":"+v"(tid_)); const int tid=tid_,lane=tid&63,r32=lane&31,hi=lane>>5; const int wid=__builtin_amdgcn_readfirstlane(tid>>6);
  const long rowbase=(long)b*SEQ; const int q0=qb*QB;
  const bf16*Qw=Q+(rowbase+q0+wid*QBLK)*DM+h*D;
  const bf16*Kh=K+rowbase*DM+h*D,*Vh=V+rowbase*DM+h*D;
  const lds_cptr shm3=(lds_cptr)shm;
  const unsigned lds0=(unsigned)(uintptr_t)shm;
  float*wsf=(float*)(shm+LDS_WS)+wid*64;
  const bf16*ksrc=Kh+(long)lane*DM+wid*8;
  const bf16*vsrc=Vh+(long)(16*(wid&3)+(lane>>2))*DM+(wid>>2)*32+(lane&3)*8;
  const unsigned kdst=lds0+LDS_K+wid*1024, vdst=lds0+LDS_V+wid*1024;
  #define DMA_K(t,slot) glds16(ksrc+(long)(t)*KVBLK*DM,(unsigned)__builtin_amdgcn_readfirstlane(kdst+(slot)))
  #define DMA_V(t,slot) glds16(vsrc+(long)(t)*KVBLK*DM,(unsigned)__builtin_amdgcn_readfirstlane(vdst+(slot)))
  const int vb0=(int)(lds0+LDS_V)+((lane>>4)&1)*32+(lane&3)*8+(4*hi+((lane&15)>>2))*64;
  const char*Kbase=shm+LDS_K; bf16x8 kf[8];
  const lds_cptr kp0=shm3+LDS_K+hi*1024+r32*16; const lds_cptr vp0=shm3+LDS_V+((lane>>4)&1)*32+(lane&3)*8+(4*hi+((lane&15)>>2))*64;
  const int NT=(q0+QB)/KVBLK;
  const __attribute__((address_space(3))) float*biasl=(const __attribute__((address_space(3))) float*)(shm3+LDS_BIAS)+4*hi;
  #define ADDB(P0,P1,t) do{ const __attribute__((address_space(3))) float*bp_=biasl+64*(t); \
    _Pragma("unroll") for(int j_=0;j_<4;++j_){ const f32x4_t b0_=*(const __attribute__((address_space(3))) f32x4_t*)(bp_+8*j_), b1_=*(const __attribute__((address_space(3))) f32x4_t*)(bp_+32+8*j_); \
      _Pragma("unroll") for(int e_=0;e_<4;++e_){ P0[4*j_+e_]+=b0_[e_]; P1[4*j_+e_]+=b1_[e_]; } } }while(0)
  DMA_K(0,0);DMA_V(0,0);DMA_K(1,SLOTB);
  bf16x8 qr[4];
  #pragma unroll
  for(int d0=0;d0<4;++d0)qr[d0]=*reinterpret_cast<const bf16x8*>(&Qw[(long)r32*DM+d0*16+hi*8]);
  float mhat=0.f,l_reg=0.f;f32x16 o[2];o[0]=f32x16{};o[1]=f32x16{};f32x16 negm=f32x16{};asm volatile("":"+v"(negm));
  const int qrel=wid*QBLK+r32;
  #define CMASK(P0,P1,t) do{int jb_=(t)-(NT-4); if(jb_>=0)cmask(P0,P1,jb_,qrel,hi);}while(0)
  bool resc=false;
  #define START(P0,P1) do{ const float rm=rowmax(P0,P1); resc=false; \
    { const float dl=rm; mhat=fadd_s(mhat,dl); \
      _Pragma("unroll") for(int r=0;r<16;++r){P0[r]=fsub_s(P0[r],dl);P1[r]=fsub_s(P1[r],dl);} \
      _Pragma("unroll") for(int r=0;r<16;++r)negm[r]=-mhat; asm volatile("":"+v"(negm)); } \
    _Pragma("unroll") for(int r=0;r<16;++r)P0[r]=__builtin_amdgcn_exp2f(P0[r]); }while(0)
  #define RESC() do{ if(resc){ asm volatile("s_waitcnt lgkmcnt(0)":::"memory"); \
      _Pragma("unroll") for(int d_=0;d_<2;++d_) _Pragma("unroll") for(int r=0;r<16;++r)o[d_][r]*=wsf[crow(r,hi)]; } }while(0)
  f32x16 pA0,pA1,pB0,pB1;
  int sl_prev=0,sl_cur=0,sl_next=SLOTB;
  #define ROT() do{sl_prev=sl_cur;sl_cur=sl_next;sl_next=(sl_next==(NSLOT-1)*SLOTB)?0:sl_next+SLOTB;}while(0)
  DMA_K(2,2*SLOTB);
  { const float*gb=BIASG+(long)(b*NHEAD+h)*SEQ; __attribute__((address_space(3))) float*bl=(__attribute__((address_space(3))) float*)(shm3+LDS_BIAS);
    for(int i=tid*4;i<q0+QB;i+=NW*64*4){ const f32x4_t v=*(const f32x4_t*)(gb+i); *(__attribute__((address_space(3))) f32x4_t*)(bl+i)=v; } }
  WAIT_BAR(3);
  qkt(pA0,pA1,Kbase,qr,negm,r32,hi);asm volatile("s_nop 15\n\ts_nop 7":"+v"(pA0),"+v"(pA1));ADDB(pA0,pA1,0);CMASK(pA0,pA1,0);
  START(pA0,pA1);
  _Pragma("unroll") for(int r=0;r<16;++r)pA1[r]=__builtin_amdgcn_exp2f(pA1[r]);
  WAIT_BAR(0);
  DMA_K(3,0);DMA_V(1,SLOTB);
  ROT();
  kload8(kf,kp0+sl_cur);
  WAIT_BAR(2);
  s16x4 vlo[8],vhi[8]; u32x4 pw0,pw1,pw2,pw3;
  #define PKW(P,B) cvtpk_s(P[B],P[B+1])
  #define PAF(k) __builtin_bit_cast(bf16x8,pw##k)
  #define VFR(i) (bf16x8){vlo[i][0],vlo[i][1],vlo[i][2],vlo[i][3],vhi[i][0],vhi[i][1],vhi[i][2],vhi[i][3]}
  #define PIN(x) asm volatile("":"+v"(x))
  #define MX3(a,b,c) __builtin_fmaxf(__builtin_fmaxf((a),(b)),(c))
  #define GAPA(MF,A0,A1,A2,A3,W0,W1,PW) do{ MF; sacc+=A0; sacc+=A1; sacc+=A2; sacc+=A3; PIN(sacc); W0; W1; PIN(PW); SBAR(); }while(0)
  #define EX(v) __builtin_amdgcn_exp2f(v)
  #define GAPB(MF,X,B) do{ MF; X[B]=EX(X[B]); X[B+1]=EX(X[B+1]); X[B+2]=EX(X[B+2]); X[B+3]=EX(X[B+3]); PIN(X); SBAR(); }while(0)
  #define VRD(i) do{ vlo[i]=vtr(vp_+(((i)>>2)*4096+((i)&3)*1024)); vhi[i]=vtr(vp_+(((i)>>2)*4096+((i)&3)*1024+512)); }while(0)
  #define KRD(G,j) do{ if(G){ kload2(kf,kp0+sl_next,j); SBAR(); } }while(0)
  #define LDB4(off) (*(const __attribute__((address_space(3))) f32x4_t*)(bp_+(off)))
  #define BL0(t) do{ const __attribute__((address_space(3))) float*bp_=biasl+64*(t); bA0=LDB4(0); bA1=LDB4(8); bA2=LDB4(16); bA3=LDB4(24); }while(0)
  #define BL1(t) do{ const __attribute__((address_space(3))) float*bp_=biasl+64*(t); bB0=LDB4(32); bB1=LDB4(40); bB2=LDB4(48); bB3=LDB4(56); }while(0)
  #define BADD(C0,C1) do{ _Pragma("unroll") for(int e_=0;e_<4;++e_){ C0[e_]+=bA0[e_]; C0[4+e_]+=bA1[e_]; C0[8+e_]+=bA2[e_]; C0[12+e_]+=bA3[e_]; C1[e_]+=bB0[e_]; C1[4+e_]+=bB1[e_]; C1[8+e_]+=bB2[e_]; C1[12+e_]+=bB3[e_]; } }while(0)
  #define STEP(C0,C1,P0,P1,t,GK,GV,GL) do{ SBAR(); f32x4_t bA0,bA1,bA2,bA3,bB0,bB1,bB2,bB3; \
    const lds_cptr vp_=vp0+sl_prev; \
    VRD(0); SBAR(); float sacc=(P0[0]+P0[1]); \
    GAPA(C0=__builtin_amdgcn_mfma_f32_32x32x16_bf16(kf[0],qr[0],negm,0,0,0), P0[2],P0[3],P0[4],P0[5],     pw0[0]=PKW(P0,0), pw0[1]=PKW(P0,2), pw0); \
    VRD(4); SBAR(); GAPA(C1=__builtin_amdgcn_mfma_f32_32x32x16_bf16(kf[1],qr[0],negm,0,0,0), P0[6],P0[7],P0[8],P0[9],     pw0[2]=PKW(P0,4), pw0[3]=PKW(P0,6), pw0); \
    VRD(1); SBAR(); GAPA(C0=__builtin_amdgcn_mfma_f32_32x32x16_bf16(kf[2],qr[1],C0,0,0,0),   P0[10],P0[11],P0[12],P0[13], pw1[0]=PKW(P0,8), pw1[1]=PKW(P0,10), pw1); \
    VRD(5); SBAR(); GAPA(C1=__builtin_amdgcn_mfma_f32_32x32x16_bf16(kf[3],qr[1],C1,0,0,0),   P0[14],P0[15],P1[0],P1[1],   pw1[2]=PKW(P0,12),pw1[3]=PKW(P0,14), pw1); \
    VRD(2); SBAR(); GAPA(C0=__builtin_amdgcn_mfma_f32_32x32x16_bf16(kf[4],qr[2],C0,0,0,0),   P1[2],P1[3],P1[4],P1[5],     pw2[0]=PKW(P1,0), pw2[1]=PKW(P1,2), pw2); \
    VRD(6); SBAR(); GAPA(C1=__builtin_amdgcn_mfma_f32_32x32x16_bf16(kf[5],qr[2],C1,0,0,0),   P1[6],P1[7],P1[8],P1[9],     pw2[2]=PKW(P1,4), pw2[3]=PKW(P1,6), pw2); \
    VRD(3); SBAR(); GAPA(C0=__builtin_amdgcn_mfma_f32_32x32x16_bf16(kf[6],qr[3],C0,0,0,0),   P1[10],P1[11],P1[12],P1[13], pw3[0]=PKW(P1,8), pw3[1]=PKW(P1,10), pw3); \
    BL0(t); SBAR(); \
    VRD(7); SBAR(); GAPA(C1=__builtin_amdgcn_mfma_f32_32x32x16_bf16(kf[7],qr[3],C1,0,0,0),   P1[14],P1[15],0.f,0.f,       pw3[2]=PKW(P1,12),pw3[3]=PKW(P1,14), pw3); \
    BL1(t); SBAR(); \
    l_reg+=sacc; \
    if(GK){DMA_K((t)+3,sl_cur);} if(GV){DMA_V((t)+1,sl_next);} \
    BADD(C0,C1); CMASK(C0,C1,t); \
    { float a=MX3(C0[0],C0[1],C1[0]),b=MX3(C0[2],C0[3],C1[1]); a=MX3(a,C1[2],C1[3]); \
      _Pragma("unroll") for(int r=4;r<16;r+=4){a=MX3(a,C0[r],C0[r+1]);b=MX3(b,C0[r+2],C0[r+3]);a=MX3(a,C1[r],C1[r+1]);b=MX3(b,C1[r+2],C1[r+3]);} \
      float rm=__builtin_fmaxf(a,b); { auto rr=__builtin_amdgcn_permlane32_swap(__float_as_uint(rm),__float_as_uint(rm),false,false); rm=__builtin_fmaxf(__uint_as_float(rr[0]),__uint_as_float(rr[1])); } \
      resc=false; \
      if(__builtin_expect(__any(rm>(float)THRL),0)){ const float dl=__builtin_fmaxf(rm,0.f); mhat+=dl; \
        _Pragma("unroll") for(int r=0;r<16;++r){C0[r]-=dl;C1[r]-=dl;} \
        _Pragma("unroll") for(int r=0;r<16;++r)negm[r]=-mhat; asm volatile("":"+v"(negm)); \
        const float f=__builtin_amdgcn_exp2f(-dl); l_reg*=f; if(hi==0)wsf[r32]=f; resc=true; } } \
    SBAR(); \
    GAPB(o[0]=__builtin_amdgcn_mfma_f32_32x32x16_bf16(PAF(0),VFR(0),o[0],0,0,0), C0,0); \
    GAPB(o[1]=__builtin_amdgcn_mfma_f32_32x32x16_bf16(PAF(0),VFR(4),o[1],0,0,0), C0,4); \
    KRD(GL,0); GAPB(o[0]=__builtin_amdgcn_mfma_f32_32x32x16_bf16(PAF(1),VFR(1),o[0],0,0,0), C0,8); \
    KRD(GL,1); GAPB(o[1]=__builtin_amdgcn_mfma_f32_32x32x16_bf16(PAF(1),VFR(5),o[1],0,0,0), C0,12); \
    KRD(GL,2); GAPB(o[0]=__builtin_amdgcn_mfma_f32_32x32x16_bf16(PAF(2),VFR(2),o[0],0,0,0), C1,0); \
    KRD(GL,3); GAPB(o[1]=__builtin_amdgcn_mfma_f32_32x32x16_bf16(PAF(2),VFR(6),o[1],0,0,0), C1,4); \
    GAPB(o[0]=__builtin_amdgcn_mfma_f32_32x32x16_bf16(PAF(3),VFR(3),o[0],0,0,0), C1,8); \
    GAPB(o[1]=__builtin_amdgcn_mfma_f32_32x32x16_bf16(PAF(3),VFR(7),o[1],0,0,0), C1,12); \
    }while(0)
  int t=1;
  #undef CMASK
  #define CMASK(P0,P1,t) do{}while(0)
  for(;t+5<NT;t+=2){
    STEP(pB0,pB1,pA0,pA1,t,true,true,true);     WAIT_BAR(2); RESC(); ROT();
    STEP(pA0,pA1,pB0,pB1,t+1,true,true,true);   WAIT_BAR(2); RESC(); ROT();
  }
  #undef CMASK
  #define CMASK(P0,P1,t) do{int jb_=(t)-(NT-4); if(jb_>=0)cmask(P0,P1,jb_,qrel,hi);}while(0)
  #define ENDW(tt) do{ if((tt)+3<NT){WAIT_BAR(2);} else if((tt)+2<NT){WAIT_BAR(1);} else {WAIT_BAR(0);} }while(0)
  for(;t+1<NT;t+=2){
    STEP(pB0,pB1,pA0,pA1,t,(t+3<NT),(t+1<NT),(t+1<NT));       ENDW(t);   RESC(); ROT();
    STEP(pA0,pA1,pB0,pB1,t+1,(t+4<NT),(t+2<NT),(t+2<NT));     ENDW(t+1); RESC(); ROT();
  }
  STEP(pB0,pB1,pA0,pA1,NT-1,false,false,false); RESC();
  { float sacc=pB0[0]+pB0[1]; _Pragma("unroll") for(int r=2;r<16;++r)sacc+=pB0[r]; _Pragma("unroll") for(int r=0;r<16;++r)sacc+=pB1[r]; l_reg+=sacc;
    pw0=(u32x4){PKW(pB0,0),PKW(pB0,2),PKW(pB0,4),PKW(pB0,6)};pw1=(u32x4){PKW(pB0,8),PKW(pB0,10),PKW(pB0,12),PKW(pB0,14)};pw2=(u32x4){PKW(pB1,0),PKW(pB1,2),PKW(pB1,4),PKW(pB1,6)};pw3=(u32x4){PKW(pB1,8),PKW(pB1,10),PKW(pB1,12),PKW(pB1,14)};
    SBAR(); pv(o,vb0+sl_cur,PAF(0),PAF(1),PAF(2),PAF(3)); }
  #undef PKW
  #undef PAF
  #undef VFR
  #undef PIN
  #undef MX3
  #undef GAPA
  #undef GAPB
  #undef EX
  #undef VRD
  #undef KRD
  #undef STEP
  #undef ENDW
  {auto rr=__builtin_amdgcn_permlane32_swap(__float_as_uint(l_reg),__float_as_uint(l_reg),false,false);l_reg=__uint_as_float(rr[0])+__uint_as_float(rr[1]);}
  if(hi==0)wsf[32+r32]=l_reg;asm volatile("s_waitcnt lgkmcnt(0)":::"memory");
  float rli[16];
  #pragma unroll
  for(int r=0;r<16;++r)rli[r]=__builtin_amdgcn_rcpf(wsf[32+crow(r,hi)]);
  bf16*Ow=O+(rowbase+q0+wid*QBLK)*DM+h*D;
  { bf16*stg=(bf16*)(shm+LDS_OST)+wid*2048;
    #pragma unroll
    for(int r=0;r<16;++r){const int orow=crow(r,hi);
      #pragma unroll
      for(int d0=0;d0<2;++d0)stg[orow*64+d0*32+r32]=__float2bfloat16(o[d0][r]*rli[r]);}
    asm volatile("s_waitcnt lgkmcnt(0)":::"memory");
    #pragma unroll
    for(int i=0;i<4;++i){const int row=i*8+(lane>>3),ch=lane&7; const u32x4 v=*(const u32x4*)(stg+row*64+ch*8); ATTN_STORE16(Ow+(long)row*DM+ch*8,v);} }
  asm volatile("s_waitcnt lgkmcnt(0)\n\ts_barrier":::"memory");
  #undef ADDB
  #undef LDB4
  #undef BL0
  #undef BL1
  #undef BADD
  #undef DMA_K
  #undef DMA_V
  #undef CMASK
  #undef START
  #undef RESC
  #undef ROT
}
constexpr int ATTN_LDS_BYTES=LDS_BYTES;
struct AttnTensors { const bf16* Q; const bf16* K; const bf16* V; bf16* O; const float* BIAS; };
struct AttnUnit { int bh; int qb; };
struct StaticOrder {
  int vcu, grid;
  __device__ __forceinline__ explicit StaticOrder(int grid_,int block):vcu((grid_%8==0)?(block%8)*(grid_/8)+block/8:block),grid(grid_){}
  __device__ __forceinline__ bool next(int i,AttnUnit&u)const{ const int I=vcu+(i>>1)*grid; if(I>=BATCH*NHEAD*(NQB/2))return false; const int j=I%(NQB/2); u.bh=I/(NQB/2); u.qb=(i&1)?(NQB-1-j):j; return true; }
  __device__ __forceinline__ void a_ready(const AttnUnit&)const{}
  __device__ __forceinline__ void done(const AttnUnit&)const{}
};
template<class Sched,int THRL=64> __device__ __forceinline__ void attn_phase(char*lds,const AttnTensors&T,const Sched&S){
  AttnUnit u;
  for(int i=0;S.next(i,u);++i){ S.a_ready(u); attn_unit<THRL>(u.bh/NHEAD,u.bh%NHEAD,u.qb,T.Q,T.K,T.V,T.O,T.BIAS,lds); S.done(u); }
}
#undef SBAR
#undef WAIT_BAR
}
namespace cg = cooperative_groups;
constexpr int NWAVES = 8;
constexpr int BATCH = 16, SEQ = 4096, DMOD = 1024, DEPTH = 4, NHEADS = 8, AW = 512, SW = 512, NGRP = 32, GCH = 16, NST = 64, FF = 4096, NIN = 4104;
constexpr int M = BATCH * SEQ;
constexpr int CL = 16;
constexpr int NCR = M / CL;
constexpr int ASK = 384;
constexpr float RMS_EPS = 1e-6f;

constexpr size_t MiB = 1u << 20;
constexpr size_t WS_CTL = 0, CTL_ZERO_BYTES = 65536, WS_BARW = 16384;
constexpr int MISC_OFF = 131072 + 320;
constexpr size_t WS_WIN = 1 * MiB, WS_WUP = 9 * MiB, WS_WDN = 17 * MiB, WS_WOUT = 25 * MiB, WS_WA = 27 * MiB, WS_WB = 28 * MiB, WS_WGLU = 29 * MiB;
constexpr size_t WS_WSB = 30 * MiB, WS_WSY = 54 * MiB, WS_LPOW = 78 * MiB, SSM_W_LAYER = 6 * MiB;
constexpr size_t WS_LOGF = 79 * MiB, WS_BIAS = 81 * MiB;
constexpr size_t WS_H = 84 * MiB;
constexpr size_t WS_Q = 212 * MiB, WS_K = 276 * MiB, WS_V = 340 * MiB;
constexpr size_t WS_AS = 404 * MiB, WS_SLOC = 500 * MiB;
constexpr size_t WS_GA = 564 * MiB, WS_GB = 692 * MiB;
constexpr size_t WS_HID = 212 * MiB;
constexpr size_t WS_YB = WS_SLOC, WS_YB2 = WS_Q;
constexpr size_t WS_XB = 820 * MiB, WS_END = 948 * MiB;

constexpr int LDS_BYTES = 147456;
#define LAS __attribute__((address_space(3)))
typedef unsigned short bf16;
typedef unsigned v4u __attribute__((ext_vector_type(4)));
typedef float f32x4 __attribute__((ext_vector_type(4)));

__device__ __forceinline__ unsigned f2bf(float f) { unsigned u = __builtin_bit_cast(unsigned, f); return (u + 0x7fffu + ((u >> 16) & 1u)) >> 16; }
__device__ __forceinline__ unsigned pk2(float lo, float hi) { return f2bf(lo) | (f2bf(hi) << 16); }
__device__ __forceinline__ float wave_sum(float v, int lane) {
#pragma unroll
    for (int o = 1; o < 64; o <<= 1) v += __int_as_float(__builtin_amdgcn_ds_bpermute((lane ^ o) << 2, __float_as_int(v)));
    return v;
}
__device__ __forceinline__ void transpose_item(const float* W, int ldw, int K, int nblk, bf16* WT, int dst_row0, int src_col0, LAS float* scr, int item, int lane) {
    const int kb = item / nblk, nb = item % nblk, k0 = 64 * kb, n0 = 32 * nb;
#pragma unroll 8
    for (int i = 0; i < 32; ++i) { const int kk = 2 * i + (lane >> 5); scr[kk * 33 + (lane & 31)] = W[(size_t)(k0 + kk) * ldw + src_col0 + n0 + (lane & 31)]; }
    asm volatile("s_waitcnt lgkmcnt(0)" ::: "memory");
    const int c = lane & 7;
#pragma unroll
    for (int j = 0; j < 4; ++j) { const int n = (lane >> 3) + 8 * j; const LAS float* s = scr + (8 * c) * 33 + n;
        v4u o; o.x = pk2(s[0 * 33], s[1 * 33]); o.y = pk2(s[2 * 33], s[3 * 33]); o.z = pk2(s[4 * 33], s[5 * 33]); o.w = pk2(s[6 * 33], s[7 * 33]);
        *(v4u*)(WT + (size_t)(dst_row0 + n0 + n) * K + k0 + 8 * c) = o; }
    asm volatile("s_waitcnt lgkmcnt(0)" ::: "memory");
}

struct Args { const float* in[21]; float* out; unsigned char* ws; };

__device__ __forceinline__ void ssm_tables(const Args& a, int l, int g, unsigned char* ws, LAS unsigned char* lds, int tid) {
    typedef float f2 __attribute__((ext_vector_type(2)));
    LAS f2* P = (LAS f2*)lds;
    LAS f2* Qv = P + 17 * 64;
    LAS f2* Bb = Qv + 64;
    LAS f2* Cc = Bb + 64 * 16;
    LAS float* Km = (LAS float*)(Cc + 16 * 64);
    const float* lam_re = a.in[4] + (size_t)(l * NGRP + g) * NST; const float* lam_im = a.in[5] + (size_t)(l * NGRP + g) * NST;
    const float logdt = a.in[6][l * NGRP + g];
    const float* b_re = a.in[7] + (size_t)(l * NGRP + g) * NST * GCH; const float* b_im = a.in[8] + (size_t)(l * NGRP + g) * NST * GCH;
    const float* c_re = a.in[9] + (size_t)(l * NGRP + g) * GCH * NST; const float* c_im = a.in[10] + (size_t)(l * NGRP + g) * GCH * NST;
    const float* dsk = a.in[11] + (size_t)l * SW + g * GCH;
    const double dt = exp((double)logdt);
    for (int it = tid; it < 17 * 64; it += NWAVES * 64) { const int j = it >> 6, p = it & 63;
        const double ar = (double)lam_re[p] * dt, ai = (double)lam_im[p] * dt; const double mg = exp(ar * j), an = ai * j;
        const double pr = mg * cos(an), pi = mg * sin(an); P[it] = (f2){(float)pr, (float)pi};
        if (j == 1) { const double lr = lam_re[p], li = lam_im[p], nr = pr - 1.0, ni = pi, den = lr * lr + li * li;
            Qv[p] = (f2){(float)((nr * lr + ni * li) / den), (float)((ni * lr - nr * li) / den)}; } }
    __syncthreads();
    for (int it = tid; it < 1024; it += NWAVES * 64) { const int p = it >> 4; const f2 q = Qv[p]; const float br = b_re[it], bi = b_im[it];
        Bb[it] = (f2){q.x * br - q.y * bi, q.x * bi + q.y * br}; Cc[it] = (f2){c_re[it], c_im[it]}; }
    __syncthreads();
    for (int e = tid; e < 4096; e += NWAVES * 64) { const int ck = e & 15, c = (e >> 4) & 15, j = e >> 8; float s = 0.f;
        for (int p = 0; p < 64; ++p) { const f2 cc = Cc[c * 64 + p], pp = P[j * 64 + p], bb = Bb[p * 16 + ck];
            const float xr = cc.x * pp.x - cc.y * pp.y, xi = cc.x * pp.y + cc.y * pp.x; s += xr * bb.x - xi * bb.y; }
        Km[e] = s; }
    __syncthreads();
    bf16* WSB = (bf16*)(ws + WS_WSB + (size_t)l * SSM_W_LAYER) + (size_t)g * 256 * ASK; bf16* WSY = (bf16*)(ws + WS_WSY + (size_t)l * SSM_W_LAYER) + (size_t)g * 256 * ASK;
    for (int q = tid; q < 256 * 48; q += NWAVES * 64) { const int n = q / 48, k0 = (q % 48) * 8; float vy[8], vb[8];
        const int tl = n >> 4, c = n & 15;
        if (k0 < 256) { const int tk = k0 >> 4, ck0 = k0 & 15;
#pragma unroll
            for (int e = 0; e < 8; ++e) { float v = 0.f; if (tk <= tl) { v = Km[((tl - tk) * 16 + c) * 16 + ck0 + e]; if (tk == tl && ck0 + e == c) v += dsk[c]; } vy[e] = v; }
            if (n < 128) { const int p = n & 63; const f2 pw = P[(15 - tk) * 64 + p];
#pragma unroll
                for (int e = 0; e < 8; ++e) { const f2 bb = Bb[p * 16 + ck0 + e]; vb[e] = (n < 64) ? (pw.x * bb.x - pw.y * bb.y) : (pw.x * bb.y + pw.y * bb.x); } }
            else {
#pragma unroll
                for (int e = 0; e < 8; ++e) vb[e] = 0.f; }
        } else { const int p0 = (k0 - 256) & 63; const bool im = k0 >= 320;
#pragma unroll
            for (int e = 0; e < 8; ++e) { const f2 L = P[(tl + 1) * 64 + p0 + e], cc = Cc[c * 64 + p0 + e]; vy[e] = im ? -(cc.x * L.y + cc.y * L.x) : (cc.x * L.x - cc.y * L.y); vb[e] = 0.f; } }
        v4u oy, ob; oy.x = pk2(vy[0], vy[1]); oy.y = pk2(vy[2], vy[3]); oy.z = pk2(vy[4], vy[5]); oy.w = pk2(vy[6], vy[7]);
        ob.x = pk2(vb[0], vb[1]); ob.y = pk2(vb[2], vb[3]); ob.z = pk2(vb[4], vb[5]); ob.w = pk2(vb[6], vb[7]);
        *(v4u*)(WSY + (size_t)n * ASK + k0) = oy; *(v4u*)(WSB + (size_t)n * ASK + k0) = ob; }
    if (tid < 64) ((f2*)(ws + WS_LPOW))[(l * NGRP + g) * 64 + tid] = P[16 * 64 + tid];
    __syncthreads();
}

__device__ __forceinline__ float bperm(int lanesel, float v) { return __int_as_float(__builtin_amdgcn_ds_bpermute(lanesel << 2, __float_as_int(v))); }
template <bool FORGET, int R, bool F32IN>
__device__ __forceinline__ void norm_rows(const float* X, const bf16* XBr, bf16* XBw, const float* gvec, bf16* H, const float* win  , const float* bfg, float* LOGF, int gw, int NGW, int lane) {
    f32x4 gv[4];
#pragma unroll
    for (int j = 0; j < 4; ++j) gv[j] = *((const f32x4*)gvec + lane + 64 * j);
    f32x4 wf[4][4][2];
    if (FORGET) {
#pragma unroll
        for (int j = 0; j < 4; ++j)
#pragma unroll
            for (int e = 0; e < 4; ++e) { const int k = 256 * j + 4 * lane + e; const float* wp = win + (size_t)k * NIN + 1536;
                wf[j][e][0] = *(const f32x4*)wp * gv[j][e]; wf[j][e][1] = *(const f32x4*)(wp + 4) * gv[j][e]; }
    }
    const int hsel = 4 * (lane & 1) + 2 * ((lane >> 1) & 1) + ((lane >> 2) & 1);
    const float bfv = FORGET ? bfg[hsel] : 0.f;
    const bool b0 = lane & 1, b1 = lane & 2, b2 = lane & 4;
    for (int m0 = gw; m0 < M; m0 += NGW * R) {
        f32x4 v[R][4]; float s[R]; size_t mr[R]; bool ok[R];
#pragma unroll
        for (int r = 0; r < R; ++r) { const int m = m0 + r * NGW; ok[r] = m < M; mr[r] = (size_t)(ok[r] ? m : m0); }
        if constexpr (F32IN) {
#pragma unroll
            for (int r = 0; r < R; ++r) { const f32x4* xr = (const f32x4*)(X + mr[r] * DMOD) + lane;
#pragma unroll
                for (int j = 0; j < 4; ++j) v[r][j] = xr[64 * j]; }
#pragma unroll
            for (int r = 0; r < R; ++r) { unsigned long long* xw = (unsigned long long*)(XBw + mr[r] * DMOD) + lane;
#pragma unroll
                for (int j = 0; j < 4; ++j) { const unsigned lo = pk2(v[r][j].x, v[r][j].y), hi = pk2(v[r][j].z, v[r][j].w); if (ok[r]) xw[64 * j] = (unsigned long long)lo | ((unsigned long long)hi << 32);
                    v[r][j] = (f32x4){__uint_as_float(lo << 16), __uint_as_float(lo & 0xffff0000u), __uint_as_float(hi << 16), __uint_as_float(hi & 0xffff0000u)}; } }
        } else {
            unsigned long long w8[R][4];
#pragma unroll
            for (int r = 0; r < R; ++r) { const unsigned long long* xr = (const unsigned long long*)(XBr + mr[r] * DMOD) + lane;
#pragma unroll
                for (int j = 0; j < 4; ++j) w8[r][j] = xr[64 * j]; }
#pragma unroll
            for (int r = 0; r < R; ++r)
#pragma unroll
                for (int j = 0; j < 4; ++j) { const unsigned lo = (unsigned)w8[r][j], hi = (unsigned)(w8[r][j] >> 32);
                    v[r][j] = (f32x4){__uint_as_float(lo << 16), __uint_as_float(lo & 0xffff0000u), __uint_as_float(hi << 16), __uint_as_float(hi & 0xffff0000u)}; }
        }
#pragma unroll
        for (int r = 0; r < R; ++r) { float t = 0.f;
#pragma unroll
            for (int j = 0; j < 4; ++j) t += (v[r][j].x * v[r][j].x + v[r][j].y * v[r][j].y) + (v[r][j].z * v[r][j].z + v[r][j].w * v[r][j].w);
            s[r] = t; }
        f32x4 a0[R], a1[R];
        if (FORGET) {
#pragma unroll
            for (int r = 0; r < R; ++r) { a0[r] = (f32x4){0.f, 0.f, 0.f, 0.f}; a1[r] = (f32x4){0.f, 0.f, 0.f, 0.f};
#pragma unroll
                for (int j = 0; j < 4; ++j)
#pragma unroll
                    for (int e = 0; e < 4; ++e) { a0[r] += wf[j][e][0] * v[r][j][e]; a1[r] += wf[j][e][1] * v[r][j][e]; } }
        }
#pragma unroll
        for (int o = 1; o < 64; o <<= 1)
#pragma unroll
            for (int r = 0; r < R; ++r) s[r] += bperm(lane ^ o, s[r]);
        float rstd[R];
#pragma unroll
        for (int r = 0; r < R; ++r) { rstd[r] = 1.0f / sqrtf(s[r] * (1.f / DMOD) + RMS_EPS);
            unsigned long long* o8 = (unsigned long long*)(H + mr[r] * DMOD) + lane;
#pragma unroll
            for (int j = 0; j < 4; ++j) { const f32x4 h = v[r][j] * rstd[r] * gv[j]; if (ok[r]) o8[64 * j] = (unsigned long long)pk2(h.x, h.y) | ((unsigned long long)pk2(h.z, h.w) << 32); } }
        if (FORGET) {
            float t4[R][4], t2[R][2], w[R];
#pragma unroll
            for (int i = 0; i < 4; ++i)
#pragma unroll
                for (int r = 0; r < R; ++r) { const float snd = b0 ? a0[r][i] : a1[r][i], kp = b0 ? a1[r][i] : a0[r][i]; t4[r][i] = kp + bperm(lane ^ 1, snd); }
#pragma unroll
            for (int i = 0; i < 2; ++i)
#pragma unroll
                for (int r = 0; r < R; ++r) { const float snd = b1 ? t4[r][i] : t4[r][2 + i], kp = b1 ? t4[r][2 + i] : t4[r][i]; t2[r][i] = kp + bperm(lane ^ 2, snd); }
#pragma unroll
            for (int r = 0; r < R; ++r) w[r] = (b2 ? t2[r][1] : t2[r][0]) + bperm(lane ^ 4, b2 ? t2[r][0] : t2[r][1]);
#pragma unroll
            for (int o = 8; o < 64; o <<= 1)
#pragma unroll
                for (int r = 0; r < R; ++r) w[r] += bperm(lane ^ o, w[r]);
#pragma unroll
            for (int r = 0; r < R; ++r) if (lane < 8 && ok[r]) { const float z = w[r] * rstd[r] + bfv;
                const float ls = fminf(z, 0.f) - 0.6931471805599453f * __builtin_amdgcn_logf(1.0f + __builtin_amdgcn_exp2f(-fabsf(z) * 1.4426950408889634f));
                LOGF[mr[r] * 8 + hsel] = ls; }
        }
    }
}
template <int R>
__device__ __forceinline__ void norm_rows_final(const bf16* XBr, float* OUT, const float* gvec, int gw, int NGW, int lane) {
    f32x4 gv[4];
#pragma unroll
    for (int j = 0; j < 4; ++j) gv[j] = *((const f32x4*)gvec + lane + 64 * j);
    for (int m0 = gw; m0 < M; m0 += NGW * R) {
        f32x4 v[R][4]; float s[R];
#pragma unroll
        for (int r = 0; r < R; ++r) { const int m = m0 + r * NGW; const unsigned long long* xr = (const unsigned long long*)(XBr + (size_t)(m < M ? m : m0) * DMOD) + lane;
#pragma unroll
            for (int j = 0; j < 4; ++j) { const unsigned long long w = xr[64 * j]; const unsigned lo = (unsigned)w, hi = (unsigned)(w >> 32);
                v[r][j] = (f32x4){__uint_as_float(lo << 16), __uint_as_float(lo & 0xffff0000u), __uint_as_float(hi << 16), __uint_as_float(hi & 0xffff0000u)}; } }
#pragma unroll
        for (int r = 0; r < R; ++r) { float t = 0.f;
#pragma unroll
            for (int j = 0; j < 4; ++j) t += (v[r][j].x * v[r][j].x + v[r][j].y * v[r][j].y) + (v[r][j].z * v[r][j].z + v[r][j].w * v[r][j].w);
            s[r] = t; }
#pragma unroll
        for (int o = 1; o < 64; o <<= 1)
#pragma unroll
            for (int r = 0; r < R; ++r) s[r] += bperm(lane ^ o, s[r]);
#pragma unroll
        for (int r = 0; r < R; ++r) { const int m = m0 + r * NGW; if (m >= M) break;
            const float rstd = 1.0f / sqrtf(s[r] * (1.f / DMOD) + RMS_EPS); f32x4* xw = (f32x4*)(OUT + (size_t)m * DMOD) + lane;
#pragma unroll
            for (int j = 0; j < 4; ++j) xw[64 * j] = v[r][j] * rstd * gv[j]; }
    }
}

#define XB_TMO      128
#define XB_XCNT(j)  (256  + 64 * (j))
#define XB_XSUB(j)  (1280 + 64 * (j))
#define XB_XGEN(j)  (2304 + 64 * (j))
#define XB_TOP      3328
#define XB_TOPGEN   3392
#define XCD_BAR_WORDS 3456
#define XB_SPIN_CAP (1u << 18)

__device__ __forceinline__ unsigned xb_ld(unsigned* p)              { return __hip_atomic_load(p, __ATOMIC_RELAXED, __HIP_MEMORY_SCOPE_AGENT); }
__device__ __forceinline__ unsigned xb_add(unsigned* p, unsigned v) { return __hip_atomic_fetch_add(p, v, __ATOMIC_RELAXED, __HIP_MEMORY_SCOPE_AGENT); }
__device__ __forceinline__ unsigned xb_xcc_id() { return (unsigned)__builtin_amdgcn_s_getreg((3 << 11) | 20) & 0xFu; }
#define XB_SPIN(cond, bar) do { unsigned _sp = 0; while (cond) { __builtin_amdgcn_s_sleep(1); \
    if ((++_sp & 255u) == 0u) { if (xb_ld(&(bar)[XB_TMO])) break; if (_sp > XB_SPIN_CAP) { atomicAdd(&(bar)[XB_TMO], 1u); break; } } } } while (0)

struct XcdBarrier {
    unsigned* bar; unsigned x;
    volatile LAS unsigned* st;
};

__device__ __forceinline__ XcdBarrier xcd_barrier_post(unsigned* bar, volatile LAS unsigned* st) {
    XcdBarrier b; b.bar = bar; b.x = xb_xcc_id(); b.st = st;
    if (threadIdx.x == 0) (void)xb_add(&bar[XB_XCNT(b.x)], 1u);
    return b;
}
__device__ __forceinline__ void xcd_barrier_complete(unsigned* bar, unsigned x, unsigned& nloc, unsigned& nx) {
    const unsigned G = gridDim.x * gridDim.y * gridDim.z;
    unsigned sum, cnt, mine, sp = 0u;
    for (;;) {
        sum = 0u; cnt = 0u; mine = 0u;
#pragma unroll
        for (unsigned j = 0; j < 16; ++j) { const unsigned c = xb_ld(&bar[XB_XCNT(j)]); sum += c; cnt += (c > 0u) ? 1u : 0u; mine = (j == x) ? c : mine; }
        if (sum == G) break;
        __builtin_amdgcn_s_sleep(1);
        if ((++sp & 255u) == 0u) { if (xb_ld(&bar[XB_TMO])) break; if (sp > XB_SPIN_CAP) { atomicAdd(&bar[XB_TMO], 1u); break; } }
    }
    nloc = mine > 0u ? mine : 1u; nx = cnt > 0u ? cnt : 1u;
}

__device__ __forceinline__ void xcd_barrier(const XcdBarrier& b) {
    asm volatile("s_waitcnt vmcnt(0)" ::: "memory");
    __syncthreads();
    if (threadIdx.x == 0) {
        unsigned* bar = b.bar;
        __builtin_amdgcn_s_waitcnt(0);
        unsigned nloc = b.st[0], nx = b.st[1];
        if (nloc == 0u) { xcd_barrier_complete(bar, b.x, nloc, nx); b.st[0] = nloc; b.st[1] = nx; }
        const unsigned old = xb_add(&bar[XB_XSUB(b.x)], 1u);
        const unsigned gen = old / nloc;
        if (old + 1u == (gen + 1u) * nloc) {
            __builtin_amdgcn_fence(__ATOMIC_RELEASE, "agent");
            asm volatile("s_waitcnt vmcnt(0)" ::: "memory");
            const unsigned og = xb_add(&bar[XB_TOP], 1u);
            const unsigned tg = og / nx;
            if (og + 1u == (tg + 1u) * nx) xb_add(&bar[XB_TOPGEN], 1u);
            else XB_SPIN(xb_ld(&bar[XB_TOPGEN]) == tg, bar);
            __builtin_amdgcn_fence(__ATOMIC_ACQUIRE, "agent");
            xb_add(&bar[XB_XGEN(b.x)], 1u);
            asm volatile("s_waitcnt vmcnt(0)" ::: "memory");
        } else {
            XB_SPIN(xb_ld(&bar[XB_XGEN(b.x)]) == gen, bar);
            __builtin_amdgcn_fence(__ATOMIC_ACQUIRE, "agent");
            asm volatile("s_waitcnt vmcnt(0)" ::: "memory");
        }
    }
    __syncthreads();
}
#ifndef PHMASK
#define PHMASK 0xFFFF
#endif
#ifndef SMALLK_ALIGN
#define SMALLK_ALIGN true
#endif
#ifndef BIGK_ALIGN
#define BIGK_ALIGN true
#endif
#ifndef DUPMASK
#define DUPMASK 0
#endif
__global__ void __launch_bounds__(NWAVES * 64, 2) fwd_megakernel(Args args) {
    extern __shared__ __attribute__((aligned(16))) unsigned char lds[];
    cg::grid_group grid = cg::this_grid();
    {
        volatile LAS unsigned* misc = (volatile LAS unsigned*)((LAS unsigned char*)lds + MISC_OFF);
        if (threadIdx.x < 32) misc[threadIdx.x] = 0u;
        __syncthreads();
    }
    XcdBarrier xbar = xcd_barrier_post((unsigned*)(args.ws + WS_CTL + WS_BARW), (volatile LAS unsigned*)((LAS unsigned char*)lds + MISC_OFF) + 8);
    if (args.ws == nullptr) grid.sync();
    LAS unsigned char* L = (LAS unsigned char*)lds;
    const int G = gridDim.x, bx = blockIdx.x, NGW = G * NWAVES;
#define TID_OPAQUE() int tid_ = threadIdx.x; asm volatile("" : "+v"(tid_)); const int tid = tid_, lane = tid & 63, wave = __builtin_amdgcn_readfirstlane(tid >> 6), gw = bx * NWAVES + wave; (void)tid; (void)lane; (void)gw
    float* out = args.out;
#define GASP __attribute__((address_space(1)))
#define WS_OPAQUE() GASP unsigned char* ws = (GASP unsigned char*)args.ws; asm volatile("" : "+s"(ws))
#define WSP(T, off) ((T*)(GASP T*)(ws + (off)))
#define GRID_SYNC1() xcd_barrier(xbar)
#ifdef DUPSYNC
#define GRID_SYNC() do { GRID_SYNC1(); GRID_SYNC1(); } while (0)
#else
#define GRID_SYNC() GRID_SYNC1()
#endif
    { TID_OPAQUE(); WS_OPAQUE(); for (int it = bx; it < DEPTH * NGRP; it += G) ssm_tables(args, it >> 5, it & 31, (unsigned char*)ws, L, tid); }
    for (int l_ = 0; l_ < DEPTH; ++l_) {
        int l = l_; asm volatile("" : "+s"(l));
#if (PHMASK >> 0) & 1
        for (int rep_ = 0; rep_ < (int)((DUPMASK >> 0) & 1) + 1; ++rep_) {
        {
            TID_OPAQUE(); WS_OPAQUE(); bf16* Win_t = WSP(bf16, WS_WIN); bf16* Wup_t = WSP(bf16, WS_WUP); bf16* Wdn_t = WSP(bf16, WS_WDN); bf16* Wout_t = WSP(bf16, WS_WOUT);
            bf16* Wa_t = WSP(bf16, WS_WA); bf16* Wb_t = WSP(bf16, WS_WB); bf16* Wglu_t = WSP(bf16, WS_WGLU); bf16* H = WSP(bf16, WS_H); float* LOGF = WSP(float, WS_LOGF);
            LAS float* scr = (LAS float*)(L + wave * 16384);
            const float* w_in = args.in[2] + (size_t)l * DMOD * NIN; const float* w_glu = args.in[12] + (size_t)l * SW * SW;
            const float* w_a = args.in[14] + (size_t)l * AW * DMOD; const float* w_b = args.in[15] + (size_t)l * SW * DMOD; const float* w_out = args.in[16] + (size_t)l * DMOD * DMOD;
            const float* w_up = args.in[18] + (size_t)l * DMOD * FF; const float* w_dn = args.in[19] + (size_t)l * FF * DMOD;
            constexpr int I_IN = 16 * 128, I_GLU = 8 * 16, I_A = 8 * 32, I_B = 8 * 32, I_OUT = 16 * 32, I_UP = 16 * 128, I_DN = 64 * 32;
            constexpr int NITEMS = I_IN + I_GLU + I_A + I_B + I_OUT + I_UP + I_DN;
            for (int it = gw; it < NITEMS; it += NGW) {
                int r = it;
                if (r < I_IN) { const int nb = r % 128; const int sc0 = (nb >= 48) ? 8 : 0;
                    transpose_item(w_in, NIN, DMOD, 128, Win_t, 0, sc0, scr, r, lane); continue; } r -= I_IN;
                if (r < I_GLU) { transpose_item(w_glu, SW, SW, 16, Wglu_t, 0, 0, scr, r, lane); continue; } r -= I_GLU;
                if (r < I_A) { transpose_item(w_a, DMOD, AW, 32, Wa_t, 0, 0, scr, r, lane); continue; } r -= I_A;
                if (r < I_B) { transpose_item(w_b, DMOD, SW, 32, Wb_t, 0, 0, scr, r, lane); continue; } r -= I_B;
                if (r < I_OUT) { transpose_item(w_out, DMOD, DMOD, 32, Wout_t, 0, 0, scr, r, lane); continue; } r -= I_OUT;
                if (r < I_UP) { transpose_item(w_up, FF, DMOD, 128, Wup_t, 0, 0, scr, r, lane); continue; } r -= I_UP;
                transpose_item(w_dn, DMOD, FF, 32, Wdn_t, 0, 0, scr, r, lane);
            }
            if (l == 0) norm_rows<true, 2, true>(args.in[0], nullptr, WSP(bf16, WS_XB), args.in[1] + (size_t)l * DMOD, H, w_in, args.in[3] + (size_t)l * NHEADS, LOGF, gw, NGW, lane);
            else norm_rows<true, 2, false>(nullptr, WSP(bf16, WS_XB), nullptr, args.in[1] + (size_t)l * DMOD, H, w_in, args.in[3] + (size_t)l * NHEADS, LOGF, gw, NGW, lane);
        }
        }
#endif
        GRID_SYNC();
#if (PHMASK >> 1) & 1
        for (int rep_ = 0; rep_ < (int)((DUPMASK >> 1) & 1) + 1; ++rep_) {
        {
            WS_OPAQUE(); bf16* H = WSP(bf16, WS_H); bf16* Win_t = WSP(bf16, WS_WIN); bf16* Qb = WSP(bf16, WS_Q); bf16* AS = WSP(bf16, WS_AS); bf16* GA = WSP(bf16, WS_GA);
            static_assert(WS_V - WS_K == WS_K - WS_Q, "Q|K|V equally spaced");
            pg8::Gemm g{H, Win_t, M, 4096, DMOD}; pg8::StaticOrder S; S.init(M, 4096, G, bx);
            pg8::EpiInProj E{Qb, AS, GA, (size_t)(WS_K - WS_Q) / 2, (size_t)(WS_GB - WS_GA) / 2};
            pg8::gemm_phase<pg8::EpiInProj, pg8::StaticOrder, BIGK_ALIGN, true>(L, g, S, E);
        }
        }
#endif
        GRID_SYNC();
#if (PHMASK >> 2) & 1
        for (int rep_ = 0; rep_ < (int)((DUPMASK >> 2) & 1) + 1; ++rep_) {
        {
            WS_OPAQUE(); bf16* AS = WSP(bf16, WS_AS); bf16* WSB_t = WSP(bf16, WS_WSB + (size_t)l * SSM_W_LAYER); float* SLOC = WSP(float, WS_SLOC);
            pg8::Gemm g{AS, WSB_t, NGRP * NCR, NGRP * 256, ASK}; pg8::SsmOrder S{G, bx};
            pg8::EpiSsmState E{SLOC};
            pg8::gemm_phase<pg8::EpiSsmState, pg8::SsmOrder, SMALLK_ALIGN, true>(L, g, S, E);
        }
        }
#endif
#if (PHMASK >> 3) & 1
        for (int rep_ = 0; rep_ < (int)((DUPMASK >> 3) & 1) + 1; ++rep_) {
        {
            typedef float f2 __attribute__((ext_vector_type(2)));
            TID_OPAQUE(); WS_OPAQUE(); bf16* AS = WSP(bf16, WS_AS); float* SLOC = WSP(float, WS_SLOC); float* LOGF = WSP(float, WS_LOGF); float* BIAS = WSP(float, WS_BIAS);
            if ((wave & 1) == 0) {
                for (int i = 0; i * G + bx < NGRP * BATCH; ++i) { if (wave != ((2 * i) & 7)) continue; const int it = i * G + bx; const int g = it >> 4, b = it & 15;
                    const f2 l16 = WSP(const f2, WS_LPOW)[(l * NGRP + g) * 64 + lane];
                    const float* sl = SLOC + ((size_t)(g * NCR + b * 256)) * 128 + lane; bf16* as = AS + ((size_t)(g * NCR + b * 256)) * ASK + 256 + lane;
                    float sr = 0.f, si = 0.f;
#pragma unroll 64
                    for (int ch = 0; ch < 256; ++ch) { as[(size_t)ch * ASK] = (bf16)f2bf(sr); as[(size_t)ch * ASK + 64] = (bf16)f2bf(si);
                        const float ar = sl[(size_t)ch * 128], ai = sl[(size_t)ch * 128 + 64];
                        const float nr = l16.x * sr - l16.y * si + ar, ni = l16.x * si + l16.y * sr + ai; sr = nr; si = ni; } }
            } else if ((gw & 3) == 1) {
                for (int sq = gw >> 2; sq < BATCH * NHEADS; sq += NGW >> 2) { const int b = sq >> 3, h = sq & 7;
                    const float* lf = LOGF + ((size_t)b * SEQ + lane * 64) * 8 + h; float tot = 0.f;
#pragma unroll
                    for (int i = 0; i < 64; ++i) tot += lf[i * 8];
                    float incl = tot;
#pragma unroll
                    for (int o = 1; o < 64; o <<= 1) { const float t = __int_as_float(__builtin_amdgcn_ds_bpermute((lane - o) << 2, __float_as_int(incl))); if (lane >= o) incl += t; }
                    float run = incl - tot; float* bo = BIAS + (size_t)sq * SEQ + lane * 64;
#pragma unroll
                    for (int i = 0; i < 64; ++i) { run += lf[i * 8]; bo[i] = -run * 1.4426950408889634f; } }
            }
        }
        }
#endif
        GRID_SYNC();
#if (PHMASK >> 4) & 1
        for (int rep_ = 0; rep_ < (int)((DUPMASK >> 4) & 1) + 1; ++rep_) {
        {
            WS_OPAQUE(); bf16* AS = WSP(bf16, WS_AS); bf16* WSY_t = WSP(bf16, WS_WSY + (size_t)l * SSM_W_LAYER); bf16* YB = WSP(bf16, WS_YB);
            pg8::Gemm g{AS, WSY_t, NGRP * NCR, NGRP * 256, ASK}; pg8::SsmOrder S{G, bx};
            pg8::EpiSsmY E{YB};
            pg8::gemm_phase<pg8::EpiSsmY, pg8::SsmOrder, SMALLK_ALIGN, true>(L, g, S, E);
        }
        {
            WS_OPAQUE(); bf16* Qb = WSP(bf16, WS_Q); bf16* Kb = WSP(bf16, WS_K); bf16* Vb = WSP(bf16, WS_V); float* BIAS = WSP(float, WS_BIAS);
            const attn_body::AttnTensors AT{(const attn_body::bf16*)Qb, (const attn_body::bf16*)Kb, (const attn_body::bf16*)Vb, (attn_body::bf16*)WSP(bf16, WS_H), BIAS};
            const attn_body::StaticOrder S(G, bx);
#ifndef NO_ATTN
            attn_body::attn_phase<attn_body::StaticOrder>((char*)lds, AT, S);
        }
#endif
        }
#endif
        GRID_SYNC();
#if (PHMASK >> 5) & 1
        for (int rep_ = 0; rep_ < (int)((DUPMASK >> 5) & 1) + 1; ++rep_) {
        {
            WS_OPAQUE(); bf16* YB = WSP(bf16, WS_YB); bf16* YB2 = WSP(bf16, WS_YB2); bf16* Wglu_t = WSP(bf16, WS_WGLU);
            pg8::Gemm g{YB, Wglu_t, M, SW, SW}; pg8::StaticOrder S; S.init(M, SW, G, bx);
            pg8::EpiGlu E{YB, YB2, args.in[13] + (size_t)l * SW};
            pg8::gemm_phase<pg8::EpiGlu, pg8::StaticOrder, SMALLK_ALIGN, true>(L, g, S, E);
        }
        }
#endif
#if (PHMASK >> 6) & 1
        for (int rep_ = 0; rep_ < (int)((DUPMASK >> 6) & 1) + 1; ++rep_) {
        {
            WS_OPAQUE(); bf16* Qb = WSP(bf16, WS_H)  ; bf16* Wa_t = WSP(bf16, WS_WA); bf16* GA = WSP(bf16, WS_GA); bf16* MIXED = WSP(bf16, WS_K)  ;
            pg8::Gemm g{Qb, Wa_t, M, DMOD, AW}; pg8::StaticOrder S; S.init(M, DMOD, G, bx);
            pg8::EpiGate<false> E{GA, MIXED};
            pg8::gemm_phase<pg8::EpiGate<false>, pg8::StaticOrder, SMALLK_ALIGN, true>(L, g, S, E);
        }
        }
#endif
        GRID_SYNC();
#if (PHMASK >> 7) & 1
        for (int rep_ = 0; rep_ < (int)((DUPMASK >> 7) & 1) + 1; ++rep_) {
        {
            WS_OPAQUE(); bf16* YB2 = WSP(bf16, WS_YB2); bf16* Wb_t = WSP(bf16, WS_WB); bf16* GB = WSP(bf16, WS_GB); bf16* MIXED = WSP(bf16, WS_K);
            pg8::Gemm g{YB2, Wb_t, M, DMOD, SW}; pg8::StaticOrder S; S.init(M, DMOD, G, bx);
            pg8::EpiGate<true> E{GB, rep_ ? WSP(bf16, WS_H) : MIXED};
            pg8::gemm_phase<pg8::EpiGate<true>, pg8::StaticOrder, SMALLK_ALIGN, true>(L, g, S, E);
        }
        }
#endif
        GRID_SYNC();
#if (PHMASK >> 8) & 1
        for (int rep_ = 0; rep_ < (int)((DUPMASK >> 8) & 1) + 1; ++rep_) {
        {
            WS_OPAQUE(); bf16* MIXED = WSP(bf16, WS_K); bf16* Wout_t = WSP(bf16, WS_WOUT);
            pg8::Gemm g{MIXED, Wout_t, M, DMOD, DMOD}; pg8::StaticOrder S; S.init(M, DMOD, G, bx);
            pg8::EpiResid E{rep_ ? WSP(bf16, WS_H) : WSP(bf16, WS_XB)};
            pg8::gemm_phase<pg8::EpiResid, pg8::StaticOrder, BIGK_ALIGN, true>(L, g, S, E);
        }
        }
#endif
        GRID_SYNC();
#if (PHMASK >> 9) & 1
        for (int rep_ = 0; rep_ < (int)((DUPMASK >> 9) & 1) + 1; ++rep_) {
        { TID_OPAQUE(); WS_OPAQUE(); norm_rows<false, 4, false>(nullptr, WSP(bf16, WS_XB), nullptr, args.in[17] + (size_t)l * DMOD, WSP(bf16, WS_H), nullptr, nullptr, nullptr, gw, NGW, lane); }
        }
#endif
        GRID_SYNC();
#if (PHMASK >> 10) & 1
        for (int rep_ = 0; rep_ < (int)((DUPMASK >> 10) & 1) + 1; ++rep_) {
        {
            WS_OPAQUE(); bf16* H = WSP(bf16, WS_H); bf16* Wup_t = WSP(bf16, WS_WUP); bf16* HID = WSP(bf16, WS_HID);
            pg8::Gemm g{H, Wup_t, M, FF, DMOD}; pg8::StaticOrder S; S.init(M, FF, G, bx);
            pg8::EpiRelu2 E{HID};
            pg8::gemm_phase<pg8::EpiRelu2, pg8::StaticOrder, BIGK_ALIGN, true>(L, g, S, E);
        }
        }
#endif
        GRID_SYNC();
#if (PHMASK >> 11) & 1
        for (int rep_ = 0; rep_ < (int)((DUPMASK >> 11) & 1) + 1; ++rep_) {
        {
            WS_OPAQUE(); bf16* HID = WSP(bf16, WS_HID); bf16* Wdn_t = WSP(bf16, WS_WDN);
            pg8::Gemm g{HID, Wdn_t, M, DMOD, FF}; pg8::StaticOrder S; S.init(M, DMOD, G, bx);
            pg8::EpiResid E{rep_ ? WSP(bf16, WS_H) : WSP(bf16, WS_XB)};
            pg8::gemm_phase<pg8::EpiResid, pg8::StaticOrder, BIGK_ALIGN, true>(L, g, S, E);
        }
        }
#endif
        GRID_SYNC();
    }
    { TID_OPAQUE(); WS_OPAQUE(); norm_rows_final<4>(WSP(bf16, WS_XB), out, args.in[20], gw, NGW, lane); }
}

extern "C" void kernel_launch(void* const* d_in, const int* in_sizes, int n_in, void* d_out, int out_size, void* d_ws, size_t ws_size, hipStream_t stream) {
    static int grid = 0;
    if (grid == 0) {
        if (n_in != 21 || in_sizes[0] != M * DMOD || out_size != M * DMOD || ws_size < WS_END) {
            fprintf(stderr, "kernel_launch: unexpected shapes: n_in %d in0 %d out %d ws %zu (need %zu)\n", n_in, n_in > 0 ? in_sizes[0] : -1, out_size, ws_size, (size_t)WS_END); grid = -1; return; }
        int dev = 0, cus = 0, per_cu = 0;
        hipGetDevice(&dev); hipDeviceGetAttribute(&cus, hipDeviceAttributeMultiprocessorCount, dev);
        if (hipFuncSetAttribute((const void*)fwd_megakernel, hipFuncAttributeMaxDynamicSharedMemorySize, LDS_BYTES) != hipSuccess) { fprintf(stderr, "kernel_launch: hipFuncSetAttribute failed\n"); grid = -1; return; }
        if (hipOccupancyMaxActiveBlocksPerMultiprocessor(&per_cu, (const void*)fwd_megakernel, NWAVES * 64, LDS_BYTES) != hipSuccess || per_cu < 1) per_cu = 1;
        (void)hipGetLastError();
        grid = cus * per_cu;
    }
    if (grid < 0) return;
    if (hipMemsetAsync((char*)d_ws + WS_CTL, 0, CTL_ZERO_BYTES, stream) != hipSuccess) { fprintf(stderr, "kernel_launch: hipMemsetAsync failed\n"); return; }
    Args a{};
    for (int i = 0; i < 21; ++i) a.in[i] = (const float*)d_in[i];
    a.out = (float*)d_out; a.ws = (unsigned char*)d_ws;
    void* kargs[] = {&a};
    hipError_t e = hipLaunchCooperativeKernel((const void*)fwd_megakernel, dim3(grid), dim3(NWAVES * 64), kargs, LDS_BYTES, stream);
    if (e != hipSuccess) fprintf(stderr, "cooperative launch failed: %s (grid %d)\n", hipGetErrorString(e), grid);
}
```

```cpp
#include <hip/hip_runtime.h>
#include <hip/hip_cooperative_groups.h>
#include <cstdio>
#include <cstdint>
namespace pg8 {
#define PG8_LAS __attribute__((address_space(3)))
typedef unsigned short bf16_t;
typedef short bf16x8 __attribute__((ext_vector_type(8)));
typedef float f32x4 __attribute__((ext_vector_type(4)));
typedef unsigned u32x4 __attribute__((ext_vector_type(4)));
constexpr int BM = 256, BK = 64, HALF = 128, HTB = HALF * BK * 2  , STAGE_BYTES = 8 * HTB, NXCD = 8, WGM = 8;

__host__ __device__ __forceinline__ int lds_byte(int r, int c) { const int st = (r >> 4) * 2 + (c >> 5), rr = r & 15, cc = c & 31, ob = rr * 64 + cc * 2; return st * 1024 + (ob ^ (((ob >> 9) & 1) << 5)); }
__host__ __device__ __forceinline__ void stage_rc(int b, int& R, int& C) { const int st = b / 1024, sb = b % 1024, swz = sb ^ (((sb >> 9) & 1) << 5); R = (st >> 1) * 16 + swz / 64; C = (st & 1) * 32 + (swz % 64) / 2; }
__host__ __device__ __forceinline__ int perm32(int rho) { const int n = rho >> 4, i = rho & 15; return 8 * (i >> 2) + 4 * n + (i & 3); }

struct Unit { int pm, pn; };
struct Gemm { const bf16_t* A; const bf16_t* Bt; int M, N, K; };

struct StaticOrder {
    int nM, nN, nwg, G, c;
    __host__ __device__ void init(int M, int N, int G_, int c_) { nM = M / BM; nN = N / BM; nwg = nM * nN; G = G_; c = c_; }
    __host__ __device__ bool next(int i, Unit& u) const {
        const long L = (long)i * G + c; if (L >= nwg) return false;
        int wgid = (int)L; { const int q = nwg / NXCD, r = nwg % NXCD, xcd = wgid % NXCD, off = wgid / NXCD; wgid = (xcd < r ? xcd * (q + 1) : r * (q + 1) + (xcd - r) * q) + off; }
        const int nig = WGM * nN, gid = wgid / nig, fm = gid * WGM, gsz = (nM - fm) < WGM ? (nM - fm) : WGM;
        u.pm = fm + ((wgid % nig) % gsz); u.pn = (wgid % nig) / gsz; return true;
    }
    __device__ __forceinline__ void a_ready(const Unit&) const {}
    __device__ __forceinline__ void done(const Unit&) const {}
};

typedef float f32x2c_t __attribute__((ext_vector_type(2))); typedef __bf16 bf16x2c_t __attribute__((ext_vector_type(2)));
__device__ __forceinline__ unsigned cvt_pk_bf16(float lo, float hi) { f32x2c_t v = {lo, hi}; bf16x2c_t b = __builtin_convertvector(v, bf16x2c_t); return __builtin_bit_cast(unsigned, b); }
typedef float f32x2 __attribute__((ext_vector_type(2)));
__device__ __forceinline__ f32x2 gelu_pk(f32x2 v) {
    const f32x2 av = __builtin_elementwise_abs(v), d = av * 0.2316418882f + 1.0f;
    f32x2 t; t.x = __builtin_amdgcn_rcpf(d.x); t.y = __builtin_amdgcn_rcpf(d.y);
    f32x2 q = t * 0.5307027145f + (-0.7265760135f); q = q * t + 0.7107068705f; q = q * t + (-0.142248368f); q = q * t + 0.127414796f; q = q * t;
    const f32x2 s = (v * v) * (-0.72134752044f);
    f32x2 e; e.x = __builtin_amdgcn_exp2f(s.x); e.y = __builtin_amdgcn_exp2f(s.y);
    const f32x2 m = v * (q * e), r = v - m;
    f32x2 o; o.x = v.x < 0.f ? m.x : r.x; o.y = v.y < 0.f ? m.y : r.y; return o;
}

constexpr float LOG2E = 1.4426950408889634f;
constexpr float QC2 = 0.125f * 1.4426950408889634f;
__device__ __forceinline__ float sigm(float x) { return __builtin_amdgcn_rcpf(1.0f + __builtin_amdgcn_exp2f(-x * LOG2E)); }
__device__ __forceinline__ float gelu_tanh(float x) { const float z = 1.5957691216057308f * (x + 0.044715f * x * x * x); return x * sigm(z); }
__device__ __forceinline__ u32x4 pack8(const f32x4 v0, const f32x4 v1) { u32x4 w; w.x = cvt_pk_bf16(v0[0], v0[1]); w.y = cvt_pk_bf16(v0[2], v0[3]); w.z = cvt_pk_bf16(v1[0], v1[1]); w.w = cvt_pk_bf16(v1[2], v1[3]); return w; }
__device__ __forceinline__ float bf_lo(unsigned w) { return __uint_as_float(w << 16); }
__device__ __forceinline__ float bf_hi(unsigned w) { return __uint_as_float(w & 0xffff0000u); }
#define EPI_LOOP_BEGIN \
    _Pragma("unroll") for (int ai = 0; ai < 2; ++ai) _Pragma("unroll") for (int m = 0; m < 4; ++m) { const int row = u.pm * BM + ai * HALF + wr * 64 + m * 16 + fr; \
    _Pragma("unroll") for (int bj = 0; bj < 2; ++bj) { const int ct = bj * HALF + wc * 32 + 8 * fq; f32x4 v0 = acc[ai][bj][m][0], v1 = acc[ai][bj][m][1];
#define EPI_LOOP_END } }
#define EPI_SIG(v0, v1) do { _Pragma("unroll") for (int e_ = 0; e_ < 4; ++e_) { v0[e_] = sigm(v0[e_]); v1[e_] = sigm(v1[e_]); } } while (0)

struct EpiInProj {
    static constexpr bool PERM = true, AFTER_DRAIN = false;
    bf16_t *Q, *AS, *GA; size_t qkv_stride, gate_stride;
    __device__ __forceinline__ void operator()(const f32x4 (&acc)[2][2][4][2], const Unit& u, int wr, int wc, int fr, int fq) const {
        const int pn = u.pn;
        if (pn < 6) {
            bf16_t* base = Q + (size_t)(pn >> 1) * qkv_stride; const float sc = pn < 2 ? QC2 : 1.0f; const int cb = (pn & 1) * 256;
            EPI_LOOP_BEGIN v0 = v0 * sc; v1 = v1 * sc; *(u32x4*)(base + (size_t)row * 512 + cb + ct) = pack8(v0, v1); EPI_LOOP_END
        } else if (pn < 8) {
            const int cb = (pn - 6) * 256;
            EPI_LOOP_BEGIN const int j = cb + ct; const int g = j >> 4;
                *(u32x4*)(AS + ((size_t)(g * 4096 + (row >> 4))) * 384 + (row & 15) * 16 + (j & 15)) = pack8(v0, v1); EPI_LOOP_END
        } else {
            bf16_t* base = GA + (size_t)((pn - 8) >> 2) * gate_stride; const int cb = ((pn - 8) & 3) * 256;
            EPI_LOOP_BEGIN EPI_SIG(v0, v1); *(u32x4*)(base + (size_t)row * 1024 + cb + ct) = pack8(v0, v1); EPI_LOOP_END
        }
    }
};
struct EpiSsmState {
    static constexpr bool PERM = true, AFTER_DRAIN = false;
    float* SLOC;
    __device__ __forceinline__ void operator()(const f32x4 (&acc)[2][2][4][2], const Unit& u, int wr, int wc, int fr, int fq) const {
        EPI_LOOP_BEGIN if (bj == 0) { float* d = SLOC + (size_t)row * 128 + ct; *(f32x4*)d = v0; *(f32x4*)(d + 4) = v1; } EPI_LOOP_END
    }
};
struct EpiSsmY {
    static constexpr bool PERM = true, AFTER_DRAIN = false;
    bf16_t* YB;
    __device__ __forceinline__ void operator()(const f32x4 (&acc)[2][2][4][2], const Unit& u, int wr, int wc, int fr, int fq) const {
        EPI_LOOP_BEGIN const int g = row >> 12, cr = row & 4095, tl = ct >> 4, c0 = ct & 15;
            _Pragma("unroll") for (int e = 0; e < 4; ++e) { v0[e] = gelu_tanh(v0[e]); v1[e] = gelu_tanh(v1[e]); }
            *(u32x4*)(YB + ((size_t)(cr * 16 + tl)) * 512 + g * 16 + c0) = pack8(v0, v1); EPI_LOOP_END
    }
};
#define EPI_ROW(ai, m) (u.pm * BM + (ai) * HALF + wr * 64 + (m) * 16 + fr)
#define EPI_CT(bj) ((bj) * HALF + wc * 32 + 8 * fq)
struct EpiGlu {
    static constexpr bool PERM = true, AFTER_DRAIN = false;
    const bf16_t* YB; bf16_t* O; const float* bias;
    __device__ __forceinline__ void operator()(const f32x4 (&acc)[2][2][4][2], const Unit& u, int wr, int wc, int fr, int fq) const {
        u32x4 y[2][4][2]; f32x4 bb[2][2];
        _Pragma("unroll") for (int bj = 0; bj < 2; ++bj) { const int col = u.pn * BM + EPI_CT(bj); bb[bj][0] = *(const f32x4*)(bias + col); bb[bj][1] = *(const f32x4*)(bias + col + 4); }
        _Pragma("unroll") for (int ai = 0; ai < 2; ++ai) _Pragma("unroll") for (int m = 0; m < 4; ++m) _Pragma("unroll") for (int bj = 0; bj < 2; ++bj)
            y[ai][m][bj] = *(const u32x4*)(YB + (size_t)EPI_ROW(ai, m) * 512 + u.pn * BM + EPI_CT(bj));
        _Pragma("unroll") for (int ai = 0; ai < 2; ++ai) _Pragma("unroll") for (int m = 0; m < 4; ++m) _Pragma("unroll") for (int bj = 0; bj < 2; ++bj) {
            f32x4 v0 = acc[ai][bj][m][0] + bb[bj][0], v1 = acc[ai][bj][m][1] + bb[bj][1]; const u32x4 yy = y[ai][m][bj]; EPI_SIG(v0, v1);
            v0[0] *= bf_lo(yy.x); v0[1] *= bf_hi(yy.x); v0[2] *= bf_lo(yy.y); v0[3] *= bf_hi(yy.y); v1[0] *= bf_lo(yy.z); v1[1] *= bf_hi(yy.z); v1[2] *= bf_lo(yy.w); v1[3] *= bf_hi(yy.w);
            *(u32x4*)(O + (size_t)EPI_ROW(ai, m) * 512 + u.pn * BM + EPI_CT(bj)) = pack8(v0, v1); }
    }
};
template <bool ADD> struct EpiGate {
    static constexpr bool PERM = true, AFTER_DRAIN = false;
    const bf16_t* G; bf16_t* O;
    __device__ __forceinline__ void operator()(const f32x4 (&acc)[2][2][4][2], const Unit& u, int wr, int wc, int fr, int fq) const {
        _Pragma("unroll") for (int ai = 0; ai < 2; ++ai) {
            u32x4 gt[4][2], oo[4][2];
            _Pragma("unroll") for (int m = 0; m < 4; ++m) _Pragma("unroll") for (int bj = 0; bj < 2; ++bj) { const size_t off = (size_t)EPI_ROW(ai, m) * 1024 + u.pn * BM + EPI_CT(bj);
                gt[m][bj] = *(const u32x4*)(G + off); if (ADD) oo[m][bj] = *(const u32x4*)(O + off); }
            _Pragma("unroll") for (int m = 0; m < 4; ++m) _Pragma("unroll") for (int bj = 0; bj < 2; ++bj) { const size_t off = (size_t)EPI_ROW(ai, m) * 1024 + u.pn * BM + EPI_CT(bj);
                f32x4 v0 = acc[ai][bj][m][0], v1 = acc[ai][bj][m][1]; const u32x4 g4 = gt[m][bj];
                v0[0] *= bf_lo(g4.x); v0[1] *= bf_hi(g4.x); v0[2] *= bf_lo(g4.y); v0[3] *= bf_hi(g4.y); v1[0] *= bf_lo(g4.z); v1[1] *= bf_hi(g4.z); v1[2] *= bf_lo(g4.w); v1[3] *= bf_hi(g4.w);
                if (ADD) { const u32x4 o = oo[m][bj];
                    v0[0] += bf_lo(o.x); v0[1] += bf_hi(o.x); v0[2] += bf_lo(o.y); v0[3] += bf_hi(o.y); v1[0] += bf_lo(o.z); v1[1] += bf_hi(o.z); v1[2] += bf_lo(o.w); v1[3] += bf_hi(o.w); }
                *(u32x4*)(O + off) = pack8(v0, v1); }
            asm volatile("" ::: "memory");
        }
    }
};
struct EpiResid {
    static constexpr bool PERM = true, AFTER_DRAIN = false;
    bf16_t* X;
    __device__ __forceinline__ void operator()(const f32x4 (&acc)[2][2][4][2], const Unit& u, int wr, int wc, int fr, int fq) const {
        u32x4 xo[2][4][2];
        _Pragma("unroll") for (int ai = 0; ai < 2; ++ai) _Pragma("unroll") for (int m = 0; m < 4; ++m) _Pragma("unroll") for (int bj = 0; bj < 2; ++bj)
            xo[ai][m][bj] = *(const u32x4*)(X + (size_t)EPI_ROW(ai, m) * 1024 + u.pn * BM + EPI_CT(bj));
        _Pragma("unroll") for (int ai = 0; ai < 2; ++ai) _Pragma("unroll") for (int m = 0; m < 4; ++m) _Pragma("unroll") for (int bj = 0; bj < 2; ++bj) {
            f32x4 v0 = acc[ai][bj][m][0], v1 = acc[ai][bj][m][1]; const u32x4 o = xo[ai][m][bj];
            v0[0] += bf_lo(o.x); v0[1] += bf_hi(o.x); v0[2] += bf_lo(o.y); v0[3] += bf_hi(o.y); v1[0] += bf_lo(o.z); v1[1] += bf_hi(o.z); v1[2] += bf_lo(o.w); v1[3] += bf_hi(o.w);
            *(u32x4*)(X + (size_t)EPI_ROW(ai, m) * 1024 + u.pn * BM + EPI_CT(bj)) = pack8(v0, v1); }
    }
};
struct EpiRelu2 {
    static constexpr bool PERM = true, AFTER_DRAIN = false;
    bf16_t* O;
    __device__ __forceinline__ void operator()(const f32x4 (&acc)[2][2][4][2], const Unit& u, int wr, int wc, int fr, int fq) const {
        EPI_LOOP_BEGIN _Pragma("unroll") for (int e = 0; e < 4; ++e) { const float a = fmaxf(v0[e], 0.f), b = fmaxf(v1[e], 0.f); v0[e] = a * a; v1[e] = b * b; }
            *(u32x4*)(O + (size_t)row * 4096 + u.pn * BM + ct) = pack8(v0, v1); EPI_LOOP_END
    }
};
struct SsmOrder {
    int G, c;
    __device__ __forceinline__ bool next(int i, Unit& u) const { const int L = i * G + c; if (L >= 512) return false; u.pm = L; u.pn = L >> 4; return true; }
    __device__ __forceinline__ void a_ready(const Unit&) const {}
    __device__ __forceinline__ void done(const Unit&) const {}
};

template <class Epi, class Sched, bool ALIGN_EPI = false, bool SP2 = false>
__device__ __forceinline__ void gemm_phase(PG8_LAS unsigned char* lds, const Gemm g, const Sched& S, const Epi& E) {
    int tid_ = threadIdx.x; asm volatile("" : "+v"(tid_));
    const int tid = tid_, wid = __builtin_amdgcn_readfirstlane(tid >> 6), lane = tid & 63, wr = wid >> 2, wc = wid & 3, fr = lane & 15, fq = lane >> 4;
    const int K = g.K, nt = K / BK;
    unsigned voffA[2], voffB[2];
#pragma unroll
    for (int i = 0; i < 2; ++i) { int R, C; stage_rc(tid * 16 + i * 8192, R, C); const int Rb = Epi::PERM ? ((R & ~31) + perm32(R & 31)) : R;
        voffA[i] = (unsigned)(R * K + C) * 2u; voffB[i] = (unsigned)(Rb * K + C) * 2u; }
    const size_t kstep = (size_t)(BK * 2);
    const size_t hstep = (size_t)HALF * K * 2;
    const size_t tstep = 2 * hstep;
    const unsigned ldsw = (unsigned)wid * 1024u;
    const int aoff = lds_byte(wr * 64 + fr, fq * 8), boff = lds_byte(wc * 32 + fr, fq * 8);
#define PG8_SA(b, h) (((b) * 2 + (h)) * HTB)
#define PG8_SB(b, h) ((4 + (b) * 2 + (h)) * HTB)
#define PG8_STAGE(bufoff, gbase, voff) do { _Pragma("unroll") for (int _i = 0; _i < 2; ++_i) \
        __builtin_amdgcn_global_load_lds((const unsigned*)((const char*)(gbase) + (voff)[_i]), (PG8_LAS unsigned*)(lds + (bufoff) + ldsw + _i * 8192), 16, 0, 0); } while (0)
#define PG8_LDA(dst, b, h) do { _Pragma("unroll") for (int m = 0; m < 4; ++m) _Pragma("unroll") for (int k = 0; k < 2; ++k) dst[m][k] = *(const PG8_LAS bf16x8*)(lds + PG8_SA(b, h) + aoff + m * 2048 + k * 1024); } while (0)
#define PG8_LDB(dst, b, h) do { _Pragma("unroll") for (int n = 0; n < 2; ++n) _Pragma("unroll") for (int k = 0; k < 2; ++k) dst[n][k] = *(const PG8_LAS bf16x8*)(lds + PG8_SB(b, h) + boff + n * 2048 + k * 1024); } while (0)
#define PG8_MMA(ai, bj, At, Bt) do { __builtin_amdgcn_s_setprio(1); _Pragma("unroll") for (int m = 0; m < 4; ++m) _Pragma("unroll") for (int n = 0; n < 2; ++n) _Pragma("unroll") for (int k = 0; k < 2; ++k) \
        acc[ai][bj][m][n] = __builtin_amdgcn_mfma_f32_16x16x32_bf16(Bt[n][k], At[m][k], acc[ai][bj][m][n], 0, 0, 0); __builtin_amdgcn_s_setprio(0); } while (0)
#define PG8_WAIT_V(n) asm volatile("s_waitcnt vmcnt(" #n ")" ::: "memory")
#define PG8_WAIT_L(n) asm volatile("s_waitcnt lgkmcnt(" #n ")" ::: "memory")
#define PG8_BAR __builtin_amdgcn_s_barrier()
#define PG8_SCHED __builtin_amdgcn_sched_barrier(0)
    Unit cur, nxt; int ui = 0;
    if (!S.next(0, cur)) return;
    f32x4 acc[2][2][4][2];
#pragma unroll
    for (int a = 0; a < 2; ++a)
#pragma unroll
        for (int b = 0; b < 2; ++b)
#pragma unroll
            for (int m = 0; m < 4; ++m)
#pragma unroll
                for (int n = 0; n < 2; ++n) acc[a][b][m][n] = (f32x4){0.f, 0.f, 0.f, 0.f};
    bf16x8 At[4][2], B0[2][2], B1[2][2];
    const char* cA = (const char*)g.A + (size_t)cur.pm * tstep; const char* cB = (const char*)g.Bt + (size_t)cur.pn * tstep;
    S.a_ready(cur);
    if constexpr (SP2) {
        PG8_STAGE(PG8_SB(0, 0), cB, voffB); PG8_STAGE(PG8_SB(0, 1), cB + hstep, voffB); PG8_STAGE(PG8_SA(0, 0), cA, voffA); PG8_STAGE(PG8_SA(0, 1), cA + hstep, voffA);
        if (wr == 1) PG8_BAR;
        PG8_WAIT_V(2); PG8_BAR;
        PG8_STAGE(PG8_SB(1, 0), cB + kstep, voffB); PG8_STAGE(PG8_SA(1, 0), cA + kstep, voffA); PG8_STAGE(PG8_SB(1, 1), cB + hstep + kstep, voffB);
        PG8_WAIT_V(6); PG8_BAR;
    } else {
        PG8_STAGE(PG8_SB(0, 0), cB, voffB); PG8_STAGE(PG8_SA(0, 0), cA, voffA); PG8_STAGE(PG8_SB(0, 1), cB + hstep, voffB); PG8_STAGE(PG8_SA(0, 1), cA + hstep, voffA);
        if (wr == 1) PG8_BAR;
        PG8_WAIT_V(4); PG8_BAR;
        PG8_STAGE(PG8_SB(1, 0), cB + kstep, voffB); PG8_STAGE(PG8_SA(1, 0), cA + kstep, voffA); PG8_STAGE(PG8_SB(1, 1), cB + hstep + kstep, voffB);
        PG8_WAIT_V(6); PG8_BAR;
    }
    for (;;) {
        const bool has_next = S.next(ui + 1, nxt);
        const char* nA = has_next ? (const char*)g.A + (size_t)nxt.pm * tstep : cA; const char* nB = has_next ? (const char*)g.Bt + (size_t)nxt.pn * tstep : cB;
        for (int t = 0; t < nt; t += 2) {
            const bool last = (t == nt - 2);
            const char* a1 = cA + (size_t)(t + 1) * kstep;
            const char* a2 = last ? nA : cA + (size_t)(t + 2) * kstep; const char* b2 = last ? nB : cB + (size_t)(t + 2) * kstep;
            const char* a3 = a2 + kstep; const char* b3 = b2 + kstep;
            if (last && has_next) S.a_ready(nxt);
            if constexpr (SP2) {
            PG8_LDB(B0, 0, 0); PG8_LDB(B1, 0, 1); PG8_SCHED; PG8_LDA(At, 0, 0); PG8_STAGE(PG8_SA(1, 1), a1 + hstep, voffA);
            PG8_WAIT_V(8); PG8_WAIT_L(0); PG8_BAR; PG8_MMA(0, 0, At, B0); PG8_MMA(0, 1, At, B1); PG8_BAR; PG8_SCHED;
            PG8_LDA(At, 0, 1); PG8_STAGE(PG8_SB(0, 0), b2, voffB); PG8_STAGE(PG8_SB(0, 1), b2 + hstep, voffB); PG8_STAGE(PG8_SA(0, 0), a2, voffA);
            PG8_WAIT_V(8); PG8_WAIT_L(0); PG8_BAR; PG8_MMA(1, 0, At, B0); PG8_MMA(1, 1, At, B1); PG8_BAR; PG8_SCHED;
            PG8_LDB(B0, 1, 0); PG8_LDB(B1, 1, 1); PG8_SCHED; PG8_LDA(At, 1, 0); PG8_STAGE(PG8_SA(0, 1), a2 + hstep, voffA);
            PG8_WAIT_V(8); PG8_WAIT_L(0); PG8_BAR; PG8_MMA(0, 0, At, B0); PG8_MMA(0, 1, At, B1); PG8_BAR; PG8_SCHED;
            PG8_LDA(At, 1, 1); PG8_STAGE(PG8_SB(1, 0), b3, voffB); PG8_STAGE(PG8_SB(1, 1), b3 + hstep, voffB); PG8_STAGE(PG8_SA(1, 0), a3, voffA);
            PG8_WAIT_V(8); PG8_WAIT_L(0); PG8_BAR; PG8_MMA(1, 0, At, B0); PG8_MMA(1, 1, At, B1); PG8_BAR; PG8_SCHED;
            } else {
            PG8_LDB(B0, 0, 0); PG8_SCHED; PG8_LDA(At, 0, 0); PG8_STAGE(PG8_SA(1, 1), a1 + hstep, voffA);
            PG8_WAIT_L(8); PG8_BAR; PG8_WAIT_L(0); PG8_MMA(0, 0, At, B0); PG8_BAR; PG8_SCHED;
            PG8_LDB(B1, 0, 1); PG8_STAGE(PG8_SB(0, 0), b2, voffB);
            PG8_BAR; PG8_WAIT_L(0); PG8_MMA(0, 1, At, B1); PG8_BAR;
            PG8_LDA(At, 0, 1); PG8_STAGE(PG8_SA(0, 0), a2, voffA);
            PG8_BAR; PG8_WAIT_L(0); PG8_MMA(1, 0, At, B0); PG8_BAR; PG8_SCHED;
            PG8_STAGE(PG8_SB(0, 1), b2 + hstep, voffB);
            PG8_WAIT_V(6); PG8_BAR; PG8_MMA(1, 1, At, B1); PG8_BAR;
            PG8_LDB(B0, 1, 0); PG8_SCHED; PG8_LDA(At, 1, 0); PG8_STAGE(PG8_SA(0, 1), a2 + hstep, voffA);
            PG8_WAIT_L(8); PG8_BAR; PG8_WAIT_L(0); PG8_MMA(0, 0, At, B0); PG8_BAR; PG8_SCHED;
            PG8_LDB(B1, 1, 1); PG8_STAGE(PG8_SB(1, 0), b3, voffB);
            PG8_BAR; PG8_WAIT_L(0); PG8_MMA(0, 1, At, B1); PG8_BAR;
            PG8_LDA(At, 1, 1); PG8_STAGE(PG8_SA(1, 0), a3, voffA);
            PG8_BAR; PG8_WAIT_L(0); PG8_MMA(1, 0, At, B0); PG8_BAR; PG8_SCHED;
            PG8_STAGE(PG8_SB(1, 1), b3 + hstep, voffB);
            PG8_WAIT_V(6); PG8_BAR; PG8_MMA(1, 1, At, B1); PG8_BAR;
            }
        }
        if constexpr (ALIGN_EPI) { if (wr == 0) PG8_BAR; }
        if constexpr (!Epi::AFTER_DRAIN) { E(acc, cur, wr, wc, fr, fq); S.done(cur); }
        if (!has_next) break;
#pragma unroll
        for (int a = 0; a < 2; ++a)
#pragma unroll
            for (int b = 0; b < 2; ++b)
#pragma unroll
                for (int m = 0; m < 4; ++m)
#pragma unroll
                    for (int n = 0; n < 2; ++n) acc[a][b][m][n] = (f32x4){0.f, 0.f, 0.f, 0.f};
        cur = nxt; cA = nA; cB = nB; ++ui;
        if constexpr (ALIGN_EPI) { if (wr == 1) PG8_BAR; }
    }
    PG8_WAIT_V(0);
    if constexpr (!ALIGN_EPI) { if (wr == 0) PG8_BAR; }
    PG8_BAR;
    if constexpr (Epi::AFTER_DRAIN) { E.fused(acc, cur, wr, wc, fr, fq, lds, wid, lane); S.done(cur); }
#undef PG8_SA
#undef PG8_SB
#undef PG8_STAGE
#undef PG8_LDA
#undef PG8_LDB
#undef PG8_MMA
#undef PG8_WAIT_V
#undef PG8_WAIT_L
#undef PG8_BAR
#undef PG8_SCHED
}
}
#include <hip/hip_bf16.h>
#include <cmath>
namespace attn_body {
using bf16=__hip_bfloat16;
using bf16x8=__attribute__((ext_vector_type(8)))short;
using s16x4=__attribute__((ext_vector_type(4)))short;
using f32x16=__attribute__((ext_vector_type(16)))float;
using u32x4=__attribute__((ext_vector_type(4)))unsigned;
constexpr int BATCH=16,NHEAD=8,SEQ=4096,D=64,DM=NHEAD*D;
constexpr int NW=8,QBLK=32,QB=QBLK*NW,KVBLK=64,NQB=SEQ/QB;
constexpr int ATTN_PITCH=DM, ATTN_UNIT_ROWS=QB;
__device__ __forceinline__ int crow(int r,int hi){return (r&3)+8*(r>>2)+4*hi;}
#define SBAR() __builtin_amdgcn_sched_barrier(0)
__device__ __forceinline__ void cmask(f32x16&p0,f32x16&p1,int jb,int qrel,int hi){
  const float NEG=-INFINITY; int kb=64*jb+4*hi;
  #pragma unroll
  for(int r=0;r<16;++r){int kv=kb+(r&3)+8*(r>>2); if(kv>qrel)p0[r]=NEG; if(kv+32>qrel)p1[r]=NEG;}
}

constexpr int NSLOT=3, SLOTB=8192;
constexpr int LDS_K=0, LDS_V=NSLOT*SLOTB, LDS_WS=2*NSLOT*SLOTB, LDS_OST=LDS_WS+NW*64*4, LDS_BIAS=LDS_OST+NW*4096, LDS_BYTES=LDS_BIAS+SEQ*4;
constexpr float C2=0.125f*1.4426950408889634f;
__device__ __forceinline__ void glds16(const void*gsrc,unsigned lds_dst){unsigned keep;
  asm volatile("s_mov_b32 %0, m0\n\ts_mov_b32 m0, %2\n\ts_nop 0\n\tglobal_load_lds_dwordx4 %1, off\n\ts_mov_b32 m0, %0":"=&s"(keep):"v"(gsrc),"s"(lds_dst):"memory");}
__device__ __forceinline__ float max3f(float a,float b,float c){float r;asm("v_max3_f32 %0, %1, %2, %3":"=v"(r):"v"(a),"v"(b),"v"(c));return r;}
__device__ __forceinline__ float max2f(float a,float b){float r;asm("v_max_f32_e32 %0, %1, %2":"=v"(r):"v"(a),"v"(b));return r;}
__device__ __forceinline__ float fadd_s(float a,float b){float r;asm("v_add_f32_e32 %0, %1, %2":"=v"(r):"v"(a),"v"(b));return r;}
__device__ __forceinline__ float fsub_s(float a,float b){float r;asm("v_sub_f32_e32 %0, %1, %2":"=v"(r):"v"(a),"v"(b));return r;}
typedef float f32x4_t __attribute__((ext_vector_type(4))); typedef float f32x2_t __attribute__((ext_vector_type(2))); typedef __bf16 bf16x2_t __attribute__((ext_vector_type(2)));
__device__ __forceinline__ unsigned cvtpk_s(float lo,float hi){f32x2_t v={lo,hi};bf16x2_t b=__builtin_convertvector(v,bf16x2_t);return __builtin_bit_cast(unsigned,b);}
#define WAIT_BAR(N) asm volatile("s_waitcnt vmcnt(" #N ") lgkmcnt(0)\n\ts_barrier":::"memory")

__device__ __forceinline__ void qkt(f32x16&p0,f32x16&p1,const char*Kslot,const bf16x8*qr,const f32x16&negm,int r32,int hi){
  const char*kb=Kslot+hi*1024+r32*16;
  #pragma unroll
  for(int d0=0;d0<4;++d0){
    const bf16x8 b0=*reinterpret_cast<const bf16x8*>(kb+d0*2048);
    const bf16x8 b1=*reinterpret_cast<const bf16x8*>(kb+d0*2048+512);
    if(d0==0){p0=__builtin_amdgcn_mfma_f32_32x32x16_bf16(b0,qr[0],negm,0,0,0);p1=__builtin_amdgcn_mfma_f32_32x32x16_bf16(b1,qr[0],negm,0,0,0);}
    else{p0=__builtin_amdgcn_mfma_f32_32x32x16_bf16(b0,qr[d0],p0,0,0,0);p1=__builtin_amdgcn_mfma_f32_32x32x16_bf16(b1,qr[d0],p1,0,0,0);}}
}
typedef __attribute__((address_space(3))) const char* lds_cptr;
typedef short v4i16_t __attribute__((ext_vector_type(4)));
__device__ __forceinline__ void kload8(bf16x8*kf,lds_cptr kp){
  kf[0]=*(const __attribute__((address_space(3))) bf16x8*)(kp);      kf[1]=*(const __attribute__((address_space(3))) bf16x8*)(kp+512);
  kf[2]=*(const __attribute__((address_space(3))) bf16x8*)(kp+2048); kf[3]=*(const __attribute__((address_space(3))) bf16x8*)(kp+2560);
  kf[4]=*(const __attribute__((address_space(3))) bf16x8*)(kp+4096); kf[5]=*(const __attribute__((address_space(3))) bf16x8*)(kp+4608);
  kf[6]=*(const __attribute__((address_space(3))) bf16x8*)(kp+6144); kf[7]=*(const __attribute__((address_space(3))) bf16x8*)(kp+6656);
}
__device__ __forceinline__ void kload2(bf16x8*kf,lds_cptr kp,int j){ kf[2*j]=*(const __attribute__((address_space(3))) bf16x8*)(kp+j*2048); kf[2*j+1]=*(const __attribute__((address_space(3))) bf16x8*)(kp+j*2048+512); }
__device__ __forceinline__ s16x4 vtr(lds_cptr p){ return __builtin_bit_cast(s16x4,__builtin_amdgcn_ds_read_tr16_b64_v4i16((__attribute__((address_space(3))) v4i16_t*)p)); }
__device__ __forceinline__ float rowmax(const f32x16&p0,const f32x16&p1){
  float a=max3f(p0[0],p0[1],p1[0]),b=max3f(p0[2],p0[3],p1[1]);a=max3f(a,p1[2],p1[3]);
  #pragma unroll
  for(int r=4;r<16;r+=4){a=max3f(a,p0[r],p0[r+1]);b=max3f(b,p0[r+2],p0[r+3]);a=max3f(a,p1[r],p1[r+1]);b=max3f(b,p1[r+2],p1[r+3]);}
  const float m=max2f(a,b);
  auto rr=__builtin_amdgcn_permlane32_swap(__float_as_uint(m),__float_as_uint(m),false,false);
  return max2f(__uint_as_float(rr[0]),__uint_as_float(rr[1]));
}
__device__ __forceinline__ void pv(f32x16*o,int vb,bf16x8 pa0,bf16x8 pa1,bf16x8 pa2,bf16x8 pa3){
  #pragma unroll
  for(int d0=0;d0<2;++d0){s16x4 lo[4],hi[4];
    #pragma unroll
    for(int ks=0;ks<4;++ks){
      asm volatile("ds_read_b64_tr_b16 %0,%1 offset:%c2":"=&v"(lo[ks]):"v"(vb),"i"(d0*4096+ks*1024):"memory");
      asm volatile("ds_read_b64_tr_b16 %0,%1 offset:%c2":"=&v"(hi[ks]):"v"(vb),"i"(d0*4096+ks*1024+512):"memory");}
    asm volatile("s_waitcnt lgkmcnt(0)":::"memory");SBAR();
    #define PK(k) (bf16x8){lo[k][0],lo[k][1],lo[k][2],lo[k][3],hi[k][0],hi[k][1],hi[k][2],hi[k][3]}
    o[d0]=__builtin_amdgcn_mfma_f32_32x32x16_bf16(pa0,PK(0),o[d0],0,0,0);
    o[d0]=__builtin_amdgcn_mfma_f32_32x32x16_bf16(pa1,PK(1),o[d0],0,0,0);
    o[d0]=__builtin_amdgcn_mfma_f32_32x32x16_bf16(pa2,PK(2),o[d0],0,0,0);
    o[d0]=__builtin_amdgcn_mfma_f32_32x32x16_bf16(pa3,PK(3),o[d0],0,0,0);
    #undef PK
  }
}

#ifndef ATTN_STORE16
#define ATTN_STORE16(p,v) (*(u32x4*)(p)=(v))
#endif
template<int THRL> __device__ __forceinline__ void attn_unit(int b,int h,int qb,const bf16*Q,const bf16*__restrict__ K,const bf16*__restrict__ V,bf16*O,const float*__restrict__ BIASG,char*shm){
  int tid_=threadIdx.x; asm volatile("":"+v"(tid_)); const int tid=tid_,lane=tid&63,r32=lane&31,hi=lane>>5; const int wid=__builtin_amdgcn_readfirstlane(tid>>6);
  const long rowbase=(long)b*SEQ; const int q0=qb*QB;
  const bf16*Qw=Q+(rowbase+q0+wid*QBLK)*DM+h*D;
  const bf16*Kh=K+rowbase*DM+h*D,*Vh=V+rowbase*DM+h*D;
  const lds_cptr shm3=(lds_cptr)shm;
  const unsigned lds0=(unsigned)(uintptr_t)shm;
  float*wsf=(float*)(shm+LDS_WS)+wid*64;
  const bf16*ksrc=Kh+(long)lane*DM+wid*8;
  const bf16*vsrc=Vh+(long)(16*(wid&3)+(lane>>2))*DM+(wid>>2)*32+(lane&3)*8;
  const unsigned kdst=lds0+LDS_K+wid*1024, vdst=lds0+LDS_V+wid*1024;
  #define DMA_K(t,slot) glds16(ksrc+(long)(t)*KVBLK*DM,(unsigned)__builtin_amdgcn_readfirstlane(kdst+(slot)))
  #define DMA_V(t,slot) glds16(vsrc+(long)(t)*KVBLK*DM,(unsigned)__builtin_amdgcn_readfirstlane(vdst+(slot)))
  const int vb0=(int)(lds0+LDS_V)+((lane>>4)&1)*32+(lane&3)*8+(4*hi+((lane&15)>>2))*64;
  const char*Kbase=shm+LDS_K; bf16x8 kf[8];
  const lds_cptr kp0=shm3+LDS_K+hi*1024+r32*16; const lds_cptr vp0=shm3+LDS_V+((lane>>4)&1)*32+(lane&3)*8+(4*hi+((lane&15)>>2))*64;
  const int NT=(q0+QB)/KVBLK;
  const __attribute__((address_space(3))) float*biasl=(const __attribute__((address_space(3))) float*)(shm3+LDS_BIAS)+4*hi;
  #define ADDB(P0,P1,t) do{ const __attribute__((address_space(3))) float*bp_=biasl+64*(t); \
    _Pragma("unroll") for(int j_=0;j_<4;++j_){ const f32x4_t b0_=*(const __attribute__((address_space(3))) f32x4_t*)(bp_+8*j_), b1_=*(const __attribute__((address_space(3))) f32x4_t*)(bp_+32+8*j_); \
      _Pragma("unroll") for(int e_=0;e_<4;++e_){ P0[4*j_+e_]+=b0_[e_]; P1[4*j_+e_]+=b1_[e_]; } } }while(0)
  DMA_K(0,0);DMA_V(0,0);DMA_K(1,SLOTB);
  bf16x8 qr[4];
  #pragma unroll
  for(int d0=0;d0<4;++d0)qr[d0]=*reinterpret_cast<const bf16x8*>(&Qw[(long)r32*DM+d0*16+hi*8]);
  float mhat=0.f,l_reg=0.f;f32x16 o[2];o[0]=f32x16{};o[1]=f32x16{};f32x16 negm=f32x16{};asm volatile("":"+v"(negm));
  const int qrel=wid*QBLK+r32;
  #define CMASK(P0,P1,t) do{int jb_=(t)-(NT-4); if(jb_>=0)cmask(P0,P1,jb_,qrel,hi);}while(0)
  bool resc=false;
  #define START(P0,P1) do{ const float rm=rowmax(P0,P1); resc=false; \
    { const float dl=rm; mhat=fadd_s(mhat,dl); \
      _Pragma("unroll") for(int r=0;r<16;++r){P0[r]=fsub_s(P0[r],dl);P1[r]=fsub_s(P1[r],dl);} \
      _Pragma("unroll") for(int r=0;r<16;++r)negm[r]=-mhat; asm volatile("":"+v"(negm)); } \
    _Pragma("unroll") for(int r=0;r<16;++r)P0[r]=__builtin_amdgcn_exp2f(P0[r]); }while(0)
  #define RESC() do{ if(resc){ asm volatile("s_waitcnt lgkmcnt(0)":::"memory"); \
      _Pragma("unroll") for(int d_=0;d_<2;++d_) _Pragma("unroll") for(int r=0;r<16;++r)o[d_][r]*=wsf[crow(r,hi)]; } }while(0)
  f32x16 pA0,pA1,pB0,pB1;
  int sl_prev=0,sl_cur=0,sl_next=SLOTB;
  #define ROT() do{sl_prev=sl_cur;sl_cur=sl_next;sl_next=(sl_next==(NSLOT-1)*SLOTB)?0:sl_next+SLOTB;}while(0)
  DMA_K(2,2*SLOTB);
  { const float*gb=BIASG+(long)(b*NHEAD+h)*SEQ; __attribute__((address_space(3))) float*bl=(__attribute__((address_space(3))) float*)(shm3+LDS_BIAS);
    for(int i=tid*4;i<q0+QB;i+=NW*64*4){ const f32x4_t v=*(const f32x4_t*)(gb+i); *(__attribute__((address_space(3))) f32x4_t*)(bl+i)=v; } }
  WAIT_BAR(3);
  qkt(pA0,pA1,Kbase,qr,negm,r32,hi);asm volatile("s_nop 15\n\ts_nop 7":"+v"(pA0),"+v"(pA1));ADDB(pA0,pA1,0);CMASK(pA0,pA1,0);
  START(pA0,pA1);
  _Pragma("unroll") for(int r=0;r<16;++r)pA1[r]=__builtin_amdgcn_exp2f(pA1[r]);
  WAIT_BAR(0);
  DMA_K(3,0);DMA_V(1,SLOTB);
  ROT();
  kload8(kf,kp0+sl_cur);
  WAIT_BAR(2);
  s16x4 vlo[8],vhi[8]; u32x4 pw0,pw1,pw2,pw3;
  #define PKW(P,B) cvtpk_s(P[B],P[B+1])
  #define PAF(k) __builtin_bit_cast(bf16x8,pw##k)
  #define VFR(i) (bf16x8){vlo[i][0],vlo[i][1],vlo[i][2],vlo[i][3],vhi[i][0],vhi[i][1],vhi[i][2],vhi[i][3]}
  #define PIN(x) asm volatile("":"+v"(x))
  #define MX3(a,b,c) __builtin_fmaxf(__builtin_fmaxf((a),(b)),(c))
  #define GAPA(MF,A0,A1,A2,A3,W0,W1,PW) do{ MF; sacc+=A0; sacc+=A1; sacc+=A2; sacc+=A3; PIN(sacc); W0; W1; PIN(PW); SBAR(); }while(0)
  #define EX(v) __builtin_amdgcn_exp2f(v)
  #define GAPB(MF,X,B) do{ MF; X[B]=EX(X[B]); X[B+1]=EX(X[B+1]); X[B+2]=EX(X[B+2]); X[B+3]=EX(X[B+3]); PIN(X); SBAR(); }while(0)
  #define VRD(i) do{ vlo[i]=vtr(vp_+(((i)>>2)*4096+((i)&3)*1024)); vhi[i]=vtr(vp_+(((i)>>2)*4096+((i)&3)*1024+512)); }while(0)
  #define KRD(G,j) do{ if(G){ kload2(kf,kp0+sl_next,j); SBAR(); } }while(0)
  #define LDB4(off) (*(const __attribute__((address_space(3))) f32x4_t*)(bp_+(off)))
  #define BL0(t) do{ const __attribute__((address_space(3))) float*bp_=biasl+64*(t); bA0=LDB4(0); bA1=LDB4(8); bA2=LDB4(16); bA3=LDB4(24); }while(0)
  #define BL1(t) do{ const __attribute__((address_space(3))) float*bp_=biasl+64*(t); bB0=LDB4(32); bB1=LDB4(40); bB2=LDB4(48); bB3=LDB4(56); }while(0)
  #define BADD(C0,C1) do{ _Pragma("unroll") for(int e_=0;e_<4;++e_){ C0[e_]+=bA0[e_]; C0[4+e_]+=bA1[e_]; C0[8+e_]+=bA2[e_]; C0[12+e_]+=bA3[e_]; C1[e_]+=bB0[e_]; C1[4+e_]+=bB1[e_]; C1[8+e_]+=bB2[e_]; C1[12+e_]+=bB3[e_]; } }while(0)
  #define STEP(C0,C1,P0,P1,t,GK,GV,GL) do{ SBAR(); f32x4_t bA0,bA1,bA2,bA3,bB0,bB1,bB2,bB3; \
    const lds_cptr vp_=vp0+sl_prev; \
    VRD(0); SBAR(); float sacc=(P0[0]+P0[1]); \
    GAPA(C0=__builtin_amdgcn_mfma_f32_32x32x16_bf16(kf[0],qr[0],negm,0,0,0), P0[2],P0[3],P0[4],P0[5],     pw0[0]=PKW(P0,0), pw0[1]=PKW(P0,2), pw0); \
    VRD(4); SBAR(); GAPA(C1=__builtin_amdgcn_mfma_f32_32x32x16_bf16(kf[1],qr[0],negm,0,0,0), P0[6],P0[7],P0[8],P0[9],     pw0[2]=PKW(P0,4), pw0[3]=PKW(P0,6), pw0); \
    VRD(1); SBAR(); GAPA(C0=__builtin_amdgcn_mfma_f32_32x32x16_bf16(kf[2],qr[1],C0,0,0,0),   P0[10],P0[11],P0[12],P0[13], pw1[0]=PKW(P0,8), pw1[1]=PKW(P0,10), pw1); \
    VRD(5); SBAR(); GAPA(C1=__builtin_amdgcn_mfma_f32_32x32x16_bf16(kf[3],qr[1],C1,0,0,0),   P0[14],P0[15],P1[0],P1[1],   pw1[2]=PKW(P0,12),pw1[3]=PKW(P0,14), pw1); \
    VRD(2); SBAR(); GAPA(C0=__builtin_amdgcn_mfma_f32_32x32x16_bf16(kf[4],qr[2],C0,0,0,0),   P1[2],P1[3],P1[4],P1[5],     pw2[0]=PKW(P1,0), pw2[1]=PKW(P1,2), pw2); \
    VRD(6); SBAR(); GAPA(C1=__builtin_amdgcn_mfma_f32_32x32x16_bf16(kf[5],qr[2],C1,0,0,0),   P1[6],P1[7],P1[8],P1[9],     pw2[2]=PKW(P1,4), pw2[3]=PKW(P1,6), pw2); \
    VRD(3); SBAR(); GAPA(C0=__builtin_amdgcn_mfma_f32_32x32x16_bf16(kf[6],qr[3],C0,0,0,0),   P1[10],P1[11],P1[12],P1[13], pw3[0]=PKW(P1,8), pw3[1]=PKW(P1,10), pw3); \
    BL0(t); SBAR(); \
    VRD(7); SBAR(); GAPA(C1=__builtin_amdgcn_mfma_f32_32x32x16_bf16(kf[7],qr[3],C1,0,0,0),   P1[14],P1[15],0.f,0.f,       pw3[2]=PKW(P1,12),pw3[3]=PKW(P1,14), pw3); \
    BL1(t); SBAR(); \
    l_reg+=sacc; \
    if(GK){DMA_K((t)+3,sl_cur);} if(GV){DMA_V((t)+1,sl_next);} \
    BADD(C0,C1); CMASK(C0,C1,t); \
    { float a=MX3(C0[0],C0[1],C1[0]),b=MX3(C0[2],C0[3],C1[1]); a=MX3(a,C1[2],C1[3]); \
      _Pragma("unroll") for(int r=4;r<16;r+=4){a=MX3(a,C0[r],C0[r+1]);b=MX3(b,C0[r+2],C0[r+3]);a=MX3(a,C1[r],C1[r+1]);b=MX3(b,C1[r+2],C1[r+3]);} \
      float rm=__builtin_fmaxf(a,b); { auto rr=__builtin_amdgcn_permlane32_swap(__float_as_uint(rm),__float_as_uint(rm),false,false); rm=__builtin_fmaxf(__uint_as_float(rr[0]),__uint_as_float(rr[1])); } \
      resc=false; \
      if(__builtin_expect(__any(rm>(float)THRL),0)){ const float dl=__builtin_fmaxf(rm,0.f); mhat+=dl; \
        _Pragma("unroll") for(int r=0;r<16;++r){C0[r]-=dl;C1[r]-=dl;} \
        _Pragma("unroll") for(int r=0;r<16;++r)negm[r]=-mhat; asm volatile("":"+v"(negm)); \
        const float f=__builtin_amdgcn_exp2f(-dl); l_reg*=f; if(hi==0)wsf[r32]=f; resc=true; } } \
    SBAR(); \
    GAPB(o[0]=__builtin_amdgcn_mfma_f32_32x32x16_bf16(PAF(0),VFR(0),o[0],0,0,0), C0,0); \
    GAPB(o[1]=__builtin_amdgcn_mfma_f32_32x32x16_bf16(PAF(0),VFR(4),o[1],0,0,0), C0,4); \
    KRD(GL,0); GAPB(o[0]=__builtin_amdgcn_mfma_f32_32x32x16_bf16(PAF(1),VFR(1),o[0],0,0,0), C0,8); \
    KRD(GL,1); GAPB(o[1]=__builtin_amdgcn_mfma_f32_32x32x16_bf16(PAF(1),VFR(5),o[1],0,0,0), C0,12); \
    KRD(GL,2); GAPB(o[0]=__builtin_amdgcn_mfma_f32_32x32x16_bf16(PAF(2),VFR(2),o[0],0,0,0), C1,0); \
    KRD(GL,3); GAPB(o[1]=__builtin_amdgcn_mfma_f32_32x32x16_bf16(PAF(2),VFR(6),o[1],0,0,0), C1,4); \
    GAPB(o[0]=__builtin_amdgcn_mfma_f32_32x32x16_bf16(PAF(3),VFR(3),o[0],0,0,0), C1,8); \
    GAPB(o[1]=__builtin_amdgcn_mfma_f32_32x32x16_bf16(PAF(3),VFR(7),o[1],0,0,0), C1,12); \
    }while(0)
  int t=1;
  #undef CMASK
  #define CMASK(P0,P1,t) do{}while(0)
  for(;t+5<NT;t+=2){
    STEP(pB0,pB1,pA0,pA1,t,true,true,true);     WAIT_BAR(2); RESC(); ROT();
    STEP(pA0,pA1,pB0,pB1,t+1,true,true,true);   WAIT_BAR(2); RESC(); ROT();
  }
  #undef CMASK
  #define CMASK(P0,P1,t) do{int jb_=(t)-(NT-4); if(jb_>=0)cmask(P0,P1,jb_,qrel,hi);}while(0)
  #define ENDW(tt) do{ if((tt)+3<NT){WAIT_BAR(2);} else if((tt)+2<NT){WAIT_BAR(1);} else {WAIT_BAR(0);} }while(0)
  for(;t+1<NT;t+=2){
    STEP(pB0,pB1,pA0,pA1,t,(t+3<NT),(t+1<NT),(t+1<NT));       ENDW(t);   RESC(); ROT();
    STEP(pA0,pA1,pB0,pB1,t+1,(t+4<NT),(t+2<NT),(t+2<NT));     ENDW(t+1); RESC(); ROT();
  }
  STEP(pB0,pB1,pA0,pA1,NT-1,false,false,false); RESC();
  { float sacc=pB0[0]+pB0[1]; _Pragma("unroll") for(int r=2;r<16;++r)sacc+=pB0[r]; _Pragma("unroll") for(int r=0;r<16;++r)sacc+=pB1[r]; l_reg+=sacc;
    pw0=(u32x4){PKW(pB0,0),PKW(pB0,2),PKW(pB0,4),PKW(pB0,6)};pw1=(u32x4){PKW(pB0,8),PKW(pB0,10),PKW(pB0,12),PKW(pB0,14)};pw2=(u32x4){PKW(pB1,0),PKW(pB1,2),PKW(pB1,4),PKW(pB1,6)};pw3=(u32x4){PKW(pB1,8),PKW(pB1,10),PKW(pB1,12),PKW(pB1,14)};
    SBAR(); pv(o,vb0+sl_cur,PAF(0),PAF(1),PAF(2),PAF(3)); }
  #undef PKW
  #undef PAF
  #undef VFR
  #undef PIN
  #undef MX3
  #undef GAPA
  #undef GAPB
  #undef EX
  #undef VRD
  #undef KRD
  #undef STEP
  #undef ENDW
  {auto rr=__builtin_amdgcn_permlane32_swap(__float_as_uint(l_reg),__float_as_uint(l_reg),false,false);l_reg=__uint_as_float(rr[0])+__uint_as_float(rr[1]);}
  if(hi==0)wsf[32+r32]=l_reg;asm volatile("s_waitcnt lgkmcnt(0)":::"memory");
  float rli[16];
  #pragma unroll
  for(int r=0;r<16;++r)rli[r]=__builtin_amdgcn_rcpf(wsf[32+crow(r,hi)]);
  bf16*Ow=O+(rowbase+q0+wid*QBLK)*DM+h*D;
  { bf16*stg=(bf16*)(shm+LDS_OST)+wid*2048;
    #pragma unroll
    for(int r=0;r<16;++r){const int orow=crow(r,hi);
      #pragma unroll
      for(int d0=0;d0<2;++d0)stg[orow*64+d0*32+r32]=__float2bfloat16(o[d0][r]*rli[r]);}
    asm volatile("s_waitcnt lgkmcnt(0)":::"memory");
    #pragma unroll
    for(int i=0;i<4;++i){const int row=i*8+(lane>>3),ch=lane&7; const u32x4 v=*(const u32x4*)(stg+row*64+ch*8); ATTN_STORE16(Ow+(long)row*DM+ch*8,v);} }
  asm volatile("s_waitcnt lgkmcnt(0)\n\ts_barrier":::"memory");
  #undef ADDB
  #undef LDB4
  #undef BL0
  #undef BL1
  #undef BADD
  #undef DMA_K
  #undef DMA_V
  #undef CMASK
  #undef START
  #undef RESC
  #undef ROT
}
constexpr int ATTN_LDS_BYTES=LDS_BYTES;
struct AttnTensors { const bf16* Q; const bf16* K; const bf16* V; bf16* O; const float* BIAS; };
struct AttnUnit { int bh; int qb; };
struct StaticOrder {
  int vcu, grid;
  __device__ __forceinline__ explicit StaticOrder(int grid_,int block):vcu((grid_%8==0)?(block%8)*(grid_/8)+block/8:block),grid(grid_){}
  __device__ __forceinline__ bool next(int i,AttnUnit&u)const{ const int I=vcu+(i>>1)*grid; if(I>=BATCH*NHEAD*(NQB/2))return false; const int j=I%(NQB/2); u.bh=I/(NQB/2); u.qb=(i&1)?(NQB-1-j):j; return true; }
  __device__ __forceinline__ void a_ready(const AttnUnit&)const{}
  __device__ __forceinline__ void done(const AttnUnit&)const{}
};
template<class Sched,int THRL=64> __device__ __forceinline__ void attn_phase(char*lds,const AttnTensors&T,const Sched&S){
  AttnUnit u;
  for(int i=0;S.next(i,u);++i){ S.a_ready(u); attn_unit<THRL>(u.bh/NHEAD,u.bh%NHEAD,u.qb,T.Q,T.K,T.V,T.O,T.BIAS,lds); S.done(u); }
}
#undef SBAR
#undef WAIT_BAR
}
namespace cg = cooperative_groups;
constexpr int NWAVES = 8;
constexpr int BATCH = 16, SEQ = 4096, DMOD = 1024, DEPTH = 4, NHEADS = 8, AW = 512, SW = 512, NGRP = 32, GCH = 16, NST = 64, FF = 4096, NIN = 4104;
constexpr int M = BATCH * SEQ;
constexpr int CL = 16;
constexpr int NCR = M / CL;
constexpr int ASK = 384;
constexpr float RMS_EPS = 1e-6f;

constexpr size_t MiB = 1u << 20;
constexpr size_t WS_CTL = 0, CTL_ZERO_BYTES = 65536, WS_BARW = 16384;
constexpr int MISC_OFF = 131072 + 320;
constexpr size_t WS_WIN = 1 * MiB, WS_WUP = 9 * MiB, WS_WDN = 17 * MiB, WS_WOUT = 25 * MiB, WS_WA = 27 * MiB, WS_WB = 28 * MiB, WS_WGLU = 29 * MiB;
constexpr size_t WS_WSB = 30 * MiB, WS_WSY = 54 * MiB, WS_LPOW = 78 * MiB, SSM_W_LAYER = 6 * MiB;
constexpr size_t WS_LOGF = 79 * MiB, WS_BIAS = 81 * MiB;
constexpr size_t WS_H = 84 * MiB;
constexpr size_t WS_Q = 212 * MiB, WS_K = 276 * MiB, WS_V = 340 * MiB;
constexpr size_t WS_AS = 404 * MiB, WS_SLOC = 500 * MiB;
constexpr size_t WS_GA = 564 * MiB, WS_GB = 692 * MiB;
constexpr size_t WS_HID = 212 * MiB;
constexpr size_t WS_YB = WS_SLOC, WS_YB2 = WS_Q;
constexpr size_t WS_XB = 820 * MiB, WS_END = 948 * MiB;

constexpr int LDS_BYTES = 147456;
#define LAS __attribute__((address_space(3)))
typedef unsigned short bf16;
typedef unsigned v4u __attribute__((ext_vector_type(4)));
typedef float f32x4 __attribute__((ext_vector_type(4)));

__device__ __forceinline__ unsigned f2bf(float f) { unsigned u = __builtin_bit_cast(unsigned, f); return (u + 0x7fffu + ((u >> 16) & 1u)) >> 16; }
__device__ __forceinline__ unsigned pk2(float lo, float hi) { return f2bf(lo) | (f2bf(hi) << 16); }
__device__ __forceinline__ float wave_sum(float v, int lane) {
#pragma unroll
    for (int o = 1; o < 64; o <<= 1) v += __int_as_float(__builtin_amdgcn_ds_bpermute((lane ^ o) << 2, __float_as_int(v)));
    return v;
}
__device__ __forceinline__ void transpose_item(const float* W, int ldw, int K, int nblk, bf16* WT, int dst_row0, int src_col0, LAS float* scr, int item, int lane) {
    const int kb = item / nblk, nb = item % nblk, k0 = 64 * kb, n0 = 32 * nb;
#pragma unroll 8
    for (int i = 0; i < 32; ++i) { const int kk = 2 * i + (lane >> 5); scr[kk * 33 + (lane & 31)] = W[(size_t)(k0 + kk) * ldw + src_col0 + n0 + (lane & 31)]; }
    asm volatile("s_waitcnt lgkmcnt(0)" ::: "memory");
    const int c = lane & 7;
#pragma unroll
    for (int j = 0; j < 4; ++j) { const int n = (lane >> 3) + 8 * j; const LAS float* s = scr + (8 * c) * 33 + n;
        v4u o; o.x = pk2(s[0 * 33], s[1 * 33]); o.y = pk2(s[2 * 33], s[3 * 33]); o.z = pk2(s[4 * 33], s[5 * 33]); o.w = pk2(s[6 * 33], s[7 * 33]);
        *(v4u*)(WT + (size_t)(dst_row0 + n0 + n) * K + k0 + 8 * c) = o; }
    asm volatile("s_waitcnt lgkmcnt(0)" ::: "memory");
}

struct Args { const float* in[21]; float* out; unsigned char* ws; };

__device__ __forceinline__ void ssm_tables(const Args& a, int l, int g, unsigned char* ws, LAS unsigned char* lds, int tid) {
    typedef float f2 __attribute__((ext_vector_type(2)));
    LAS f2* P = (LAS f2*)lds;
    LAS f2* Qv = P + 17 * 64;
    LAS f2* Bb = Qv + 64;
    LAS f2* Cc = Bb + 64 * 16;
    LAS float* Km = (LAS float*)(Cc + 16 * 64);
    const float* lam_re = a.in[4] + (size_t)(l * NGRP + g) * NST; const float* lam_im = a.in[5] + (size_t)(l * NGRP + g) * NST;
    const float logdt = a.in[6][l * NGRP + g];
    const float* b_re = a.in[7] + (size_t)(l * NGRP + g) * NST * GCH; const float* b_im = a.in[8] + (size_t)(l * NGRP + g) * NST * GCH;
    const float* c_re = a.in[9] + (size_t)(l * NGRP + g) * GCH * NST; const float* c_im = a.in[10] + (size_t)(l * NGRP + g) * GCH * NST;
    const float* dsk = a.in[11] + (size_t)l * SW + g * GCH;
    const double dt = exp((double)logdt);
    for (int it = tid; it < 17 * 64; it += NWAVES * 64) { const int j = it >> 6, p = it & 63;
        const double ar = (double)lam_re[p] * dt, ai = (double)lam_im[p] * dt; const double mg = exp(ar * j), an = ai * j;
        const double pr = mg * cos(an), pi = mg * sin(an); P[it] = (f2){(float)pr, (float)pi};
        if (j == 1) { const double lr = lam_re[p], li = lam_im[p], nr = pr - 1.0, ni = pi, den = lr * lr + li * li;
            Qv[p] = (f2){(float)((nr * lr + ni * li) / den), (float)((ni * lr - nr * li) / den)}; } }
    __syncthreads();
    for (int it = tid; it < 1024; it += NWAVES * 64) { const int p = it >> 4; const f2 q = Qv[p]; const float br = b_re[it], bi = b_im[it];
        Bb[it] = (f2){q.x * br - q.y * bi, q.x * bi + q.y * br}; Cc[it] = (f2){c_re[it], c_im[it]}; }
    __syncthreads();
    for (int e = tid; e < 4096; e += NWAVES * 64) { const int ck = e & 15, c = (e >> 4) & 15, j = e >> 8; float s = 0.f;
        for (int p = 0; p < 64; ++p) { const f2 cc = Cc[c * 64 + p], pp = P[j * 64 + p], bb = Bb[p * 16 + ck];
            const float xr = cc.x * pp.x - cc.y * pp.y, xi = cc.x * pp.y + cc.y * pp.x; s += xr * bb.x - xi * bb.y; }
        Km[e] = s; }
    __syncthreads();
    bf16* WSB = (bf16*)(ws + WS_WSB + (size_t)l * SSM_W_LAYER) + (size_t)g * 256 * ASK; bf16* WSY = (bf16*)(ws + WS_WSY + (size_t)l * SSM_W_LAYER) + (size_t)g * 256 * ASK;
    for (int q = tid; q < 256 * 48; q += NWAVES * 64) { const int n = q / 48, k0 = (q % 48) * 8; float vy[8], vb[8];
        const int tl = n >> 4, c = n & 15;
        if (k0 < 256) { const int tk = k0 >> 4, ck0 = k0 & 15;
#pragma unroll
            for (int e = 0; e < 8; ++e) { float v = 0.f; if (tk <= tl) { v = Km[((tl - tk) * 16 + c) * 16 + ck0 + e]; if (tk == tl && ck0 + e == c) v += dsk[c]; } vy[e] = v; }
            if (n < 128) { const int p = n & 63; const f2 pw = P[(15 - tk) * 64 + p];
#pragma unroll
                for (int e = 0; e < 8; ++e) { const f2 bb = Bb[p * 16 + ck0 + e]; vb[e] = (n < 64) ? (pw.x * bb.x - pw.y * bb.y) : (pw.x * bb.y + pw.y * bb.x); } }
            else {
#pragma unroll
                for (int e = 0; e < 8; ++e) vb[e] = 0.f; }
        } else { const int p0 = (k0 - 256) & 63; const bool im = k0 >= 320;
#pragma unroll
            for (int e = 0; e < 8; ++e) { const f2 L = P[(tl + 1) * 64 + p0 + e], cc = Cc[c * 64 + p0 + e]; vy[e] = im ? -(cc.x * L.y + cc.y * L.x) : (cc.x * L.x - cc.y * L.y); vb[e] = 0.f; } }
        v4u oy, ob; oy.x = pk2(vy[0], vy[1]); oy.y = pk2(vy[2], vy[3]); oy.z = pk2(vy[4], vy[5]); oy.w = pk2(vy[6], vy[7]);
        ob.x = pk2(vb[0], vb[1]); ob.y = pk2(vb[2], vb[3]); ob.z = pk2(vb[4], vb[5]); ob.w = pk2(vb[6], vb[7]);
        *(v4u*)(WSY + (size_t)n * ASK + k0) = oy; *(v4u*)(WSB + (size_t)n * ASK + k0) = ob; }
    if (tid < 64) ((f2*)(ws + WS_LPOW))[(l * NGRP + g) * 64 + tid] = P[16 * 64 + tid];
    __syncthreads();
}

__device__ __forceinline__ float bperm(int lanesel, float v) { return __int_as_float(__builtin_amdgcn_ds_bpermute(lanesel << 2, __float_as_int(v))); }
template <bool FORGET, int R, bool F32IN>
__device__ __forceinline__ void norm_rows(const float* X, const bf16* XBr, bf16* XBw, const float* gvec, bf16* H, const float* win  , const float* bfg, float* LOGF, int gw, int NGW, int lane) {
    f32x4 gv[4];
#pragma unroll
    for (int j = 0; j < 4; ++j) gv[j] = *((const f32x4*)gvec + lane + 64 * j);
    f32x4 wf[4][4][2];
    if (FORGET) {
#pragma unroll
        for (int j = 0; j < 4; ++j)
#pragma unroll
            for (int e = 0; e < 4; ++e) { const int k = 256 * j + 4 * lane + e; const float* wp = win + (size_t)k * NIN + 1536;
                wf[j][e][0] = *(const f32x4*)wp * gv[j][e]; wf[j][e][1] = *(const f32x4*)(wp + 4) * gv[j][e]; }
    }
    const int hsel = 4 * (lane & 1) + 2 * ((lane >> 1) & 1) + ((lane >> 2) & 1);
    const float bfv = FORGET ? bfg[hsel] : 0.f;
    const bool b0 = lane & 1, b1 = lane & 2, b2 = lane & 4;
    for (int m0 = gw; m0 < M; m0 += NGW * R) {
        f32x4 v[R][4]; float s[R]; size_t mr[R]; bool ok[R];
#pragma unroll
        for (int r = 0; r < R; ++r) { const int m = m0 + r * NGW; ok[r] = m < M; mr[r] = (size_t)(ok[r] ? m : m0); }
        if constexpr (F32IN) {
#pragma unroll
            for (int r = 0; r < R; ++r) { const f32x4* xr = (const f32x4*)(X + mr[r] * DMOD) + lane;
#pragma unroll
                for (int j = 0; j < 4; ++j) v[r][j] = xr[64 * j]; }
#pragma unroll
            for (int r = 0; r < R; ++r) { unsigned long long* xw = (unsigned long long*)(XBw + mr[r] * DMOD) + lane;
#pragma unroll
                for (int j = 0; j < 4; ++j) { const unsigned lo = pk2(v[r][j].x, v[r][j].y), hi = pk2(v[r][j].z, v[r][j].w); if (ok[r]) xw[64 * j] = (unsigned long long)lo | ((unsigned long long)hi << 32);
                    v[r][j] = (f32x4){__uint_as_float(lo << 16), __uint_as_float(lo & 0xffff0000u), __uint_as_float(hi << 16), __uint_as_float(hi & 0xffff0000u)}; } }
        } else {
            unsigned long long w8[R][4];
#pragma unroll
            for (int r = 0; r < R; ++r) { const unsigned long long* xr = (const unsigned long long*)(XBr + mr[r] * DMOD) + lane;
#pragma unroll
                for (int j = 0; j < 4; ++j) w8[r][j] = xr[64 * j]; }
#pragma unroll
            for (int r = 0; r < R; ++r)
#pragma unroll
                for (int j = 0; j < 4; ++j) { const unsigned lo = (unsigned)w8[r][j], hi = (unsigned)(w8[r][j] >> 32);
                    v[r][j] = (f32x4){__uint_as_float(lo << 16), __uint_as_float(lo & 0xffff0000u), __uint_as_float(hi << 16), __uint_as_float(hi & 0xffff0000u)}; }
        }
#pragma unroll
        for (int r = 0; r < R; ++r) { float t = 0.f;
#pragma unroll
            for (int j = 0; j < 4; ++j) t += (v[r][j].x * v[r][j].x + v[r][j].y * v[r][j].y) + (v[r][j].z * v[r][j].z + v[r][j].w * v[r][j].w);
            s[r] = t; }
        f32x4 a0[R], a1[R];
        if (FORGET) {
#pragma unroll
            for (int r = 0; r < R; ++r) { a0[r] = (f32x4){0.f, 0.f, 0.f, 0.f}; a1[r] = (f32x4){0.f, 0.f, 0.f, 0.f};
#pragma unroll
                for (int j = 0; j < 4; ++j)
#pragma unroll
                    for (int e = 0; e < 4; ++e) { a0[r] += wf[j][e][0] * v[r][j][e]; a1[r] += wf[j][e][1] * v[r][j][e]; } }
        }
#pragma unroll
        for (int o = 1; o < 64; o <<= 1)
#pragma unroll
            for (int r = 0; r < R; ++r) s[r] += bperm(lane ^ o, s[r]);
        float rstd[R];
#pragma unroll
        for (int r = 0; r < R; ++r) { rstd[r] = 1.0f / sqrtf(s[r] * (1.f / DMOD) + RMS_EPS);
            unsigned long long* o8 = (unsigned long long*)(H + mr[r] * DMOD) + lane;
#pragma unroll
            for (int j = 0; j < 4; ++j) { const f32x4 h = v[r][j] * rstd[r] * gv[j]; if (ok[r]) o8[64 * j] = (unsigned long long)pk2(h.x, h.y) | ((unsigned long long)pk2(h.z, h.w) << 32); } }
        if (FORGET) {
            float t4[R][4], t2[R][2], w[R];
#pragma unroll
            for (int i = 0; i < 4; ++i)
#pragma unroll
                for (int r = 0; r < R; ++r) { const float snd = b0 ? a0[r][i] : a1[r][i], kp = b0 ? a1[r][i] : a0[r][i]; t4[r][i] = kp + bperm(lane ^ 1, snd); }
#pragma unroll
            for (int i = 0; i < 2; ++i)
#pragma unroll
                for (int r = 0; r < R; ++r) { const float snd = b1 ? t4[r][i] : t4[r][2 + i], kp = b1 ? t4[r][2 + i] : t4[r][i]; t2[r][i] = kp + bperm(lane ^ 2, snd); }
#pragma unroll
            for (int r = 0; r < R; ++r) w[r] = (b2 ? t2[r][1] : t2[r][0]) + bperm(lane ^ 4, b2 ? t2[r][0] : t2[r][1]);
#pragma unroll
            for (int o = 8; o < 64; o <<= 1)
#pragma unroll
                for (int r = 0; r < R; ++r) w[r] += bperm(lane ^ o, w[r]);
#pragma unroll
            for (int r = 0; r < R; ++r) if (lane < 8 && ok[r]) { const float z = w[r] * rstd[r] + bfv;
                const float ls = fminf(z, 0.f) - 0.6931471805599453f * __builtin_amdgcn_logf(1.0f + __builtin_amdgcn_exp2f(-fabsf(z) * 1.4426950408889634f));
                LOGF[mr[r] * 8 + hsel] = ls; }
        }
    }
}
template <int R>
__device__ __forceinline__ void norm_rows_final(const bf16* XBr, float* OUT, const float* gvec, int gw, int NGW, int lane) {
    f32x4 gv[4];
#pragma unroll
    for (int j = 0; j < 4; ++j) gv[j] = *((const f32x4*)gvec + lane + 64 * j);
    for (int m0 = gw; m0 < M; m0 += NGW * R) {
        f32x4 v[R][4]; float s[R];
#pragma unroll
        for (int r = 0; r < R; ++r) { const int m = m0 + r * NGW; const unsigned long long* xr = (const unsigned long long*)(XBr + (size_t)(m < M ? m : m0) * DMOD) + lane;
#pragma unroll
            for (int j = 0; j < 4; ++j) { const unsigned long long w = xr[64 * j]; const unsigned lo = (unsigned)w, hi = (unsigned)(w >> 32);
                v[r][j] = (f32x4){__uint_as_float(lo << 16), __uint_as_float(lo & 0xffff0000u), __uint_as_float(hi << 16), __uint_as_float(hi & 0xffff0000u)}; } }
#pragma unroll
        for (int r = 0; r < R; ++r) { float t = 0.f;
#pragma unroll
            for (int j = 0; j < 4; ++j) t += (v[r][j].x * v[r][j].x + v[r][j].y * v[r][j].y) + (v[r][j].z * v[r][j].z + v[r][j].w * v[r][j].w);
            s[r] = t; }
#pragma unroll
        for (int o = 1; o < 64; o <<= 1)
#pragma unroll
            for (int r = 0; r < R; ++r) s[r] += bperm(lane ^ o, s[r]);
#pragma unroll
        for (int r = 0; r < R; ++r) { const int m = m0 + r * NGW; if (m >= M) break;
            const float rstd = 1.0f / sqrtf(s[r] * (1.f / DMOD) + RMS_EPS); f32x4* xw = (f32x4*)(OUT + (size_t)m * DMOD) + lane;
#pragma unroll
            for (int j = 0; j < 4; ++j) xw[64 * j] = v[r][j] * rstd * gv[j]; }
    }
}

#define XB_TMO      128
#define XB_XCNT(j)  (256  + 64 * (j))
#define XB_XSUB(j)  (1280 + 64 * (j))
#define XB_XGEN(j)  (2304 + 64 * (j))
#define XB_TOP      3328
#define XB_TOPGEN   3392
#define XCD_BAR_WORDS 3456
#define XB_SPIN_CAP (1u << 18)

__device__ __forceinline__ unsigned xb_ld(unsigned* p)              { return __hip_atomic_load(p, __ATOMIC_RELAXED, __HIP_MEMORY_SCOPE_AGENT); }
__device__ __forceinline__ unsigned xb_add(unsigned* p, unsigned v) { return __hip_atomic_fetch_add(p, v, __ATOMIC_RELAXED, __HIP_MEMORY_SCOPE_AGENT); }
__device__ __forceinline__ unsigned xb_xcc_id() { return (unsigned)__builtin_amdgcn_s_getreg((3 << 11) | 20) & 0xFu; }
#define XB_SPIN(cond, bar) do { unsigned _sp = 0; while (cond) { __builtin_amdgcn_s_sleep(1); \
    if ((++_sp & 255u) == 0u) { if (xb_ld(&(bar)[XB_TMO])) break; if (_sp > XB_SPIN_CAP) { atomicAdd(&(bar)[XB_TMO], 1u); break; } } } } while (0)

struct XcdBarrier {
    unsigned* bar; unsigned x;
    volatile LAS unsigned* st;
};

__device__ __forceinline__ XcdBarrier xcd_barrier_post(unsigned* bar, volatile LAS unsigned* st) {
    XcdBarrier b; b.bar = bar; b.x = xb_xcc_id(); b.st = st;
    if (threadIdx.x == 0) (void)xb_add(&bar[XB_XCNT(b.x)], 1u);
    return b;
}
__device__ __forceinline__ void xcd_barrier_complete(unsigned* bar, unsigned x, unsigned& nloc, unsigned& nx) {
    const unsigned G = gridDim.x * gridDim.y * gridDim.z;
    unsigned sum, cnt, mine, sp = 0u;
    for (;;) {
        sum = 0u; cnt = 0u; mine = 0u;
#pragma unroll
        for (unsigned j = 0; j < 16; ++j) { const unsigned c = xb_ld(&bar[XB_XCNT(j)]); sum += c; cnt += (c > 0u) ? 1u : 0u; mine = (j == x) ? c : mine; }
        if (sum == G) break;
        __builtin_amdgcn_s_sleep(1);
        if ((++sp & 255u) == 0u) { if (xb_ld(&bar[XB_TMO])) break; if (sp > XB_SPIN_CAP) { atomicAdd(&bar[XB_TMO], 1u); break; } }
    }
    nloc = mine > 0u ? mine : 1u; nx = cnt > 0u ? cnt : 1u;
}

__device__ __forceinline__ void xcd_barrier(const XcdBarrier& b) {
    asm volatile("s_waitcnt vmcnt(0)" ::: "memory");
    __syncthreads();
    if (threadIdx.x == 0) {
        unsigned* bar = b.bar;
        __builtin_amdgcn_s_waitcnt(0);
        unsigned nloc = b.st[0], nx = b.st[1];
        if (nloc == 0u) { xcd_barrier_complete(bar, b.x, nloc, nx); b.st[0] = nloc; b.st[1] = nx; }
        const unsigned old = xb_add(&bar[XB_XSUB(b.x)], 1u);
        const unsigned gen = old / nloc;
        if (old + 1u == (gen + 1u) * nloc) {
            __builtin_amdgcn_fence(__ATOMIC_RELEASE, "agent");
            asm volatile("s_waitcnt vmcnt(0)" ::: "memory");
            const unsigned og = xb_add(&bar[XB_TOP], 1u);
            const unsigned tg = og / nx;
            if (og + 1u == (tg + 1u) * nx) xb_add(&bar[XB_TOPGEN], 1u);
            else XB_SPIN(xb_ld(&bar[XB_TOPGEN]) == tg, bar);
            __builtin_amdgcn_fence(__ATOMIC_ACQUIRE, "agent");
            xb_add(&bar[XB_XGEN(b.x)], 1u);
            asm volatile("s_waitcnt vmcnt(0)" ::: "memory");
        } else {
            XB_SPIN(xb_ld(&bar[XB_XGEN(b.x)]) == gen, bar);
            __builtin_amdgcn_fence(__ATOMIC_ACQUIRE, "agent");
            asm volatile("s_waitcnt vmcnt(0)" ::: "memory");
        }
    }
    __syncthreads();
}
#ifndef PHMASK
#define PHMASK 0xFFFF
#endif
#ifndef SMALLK_ALIGN
#define SMALLK_ALIGN true
#endif
#ifndef BIGK_ALIGN
#define BIGK_ALIGN true
#endif
#ifndef DUPMASK
#define DUPMASK 0
#endif
__global__ void __launch_bounds__(NWAVES * 64, 2) fwd_megakernel(Args args) {
    extern __shared__ __attribute__((aligned(16))) unsigned char lds[];
    cg::grid_group grid = cg::this_grid();
    {
        volatile LAS unsigned* misc = (volatile LAS unsigned*)((LAS unsigned char*)lds + MISC_OFF);
        if (threadIdx.x < 32) misc[threadIdx.x] = 0u;
        __syncthreads();
    }
    XcdBarrier xbar = xcd_barrier_post((unsigned*)(args.ws + WS_CTL + WS_BARW), (volatile LAS unsigned*)((LAS unsigned char*)lds + MISC_OFF) + 8);
    if (args.ws == nullptr) grid.sync();
    LAS unsigned char* L = (LAS unsigned char*)lds;
    const int G = gridDim.x, bx = blockIdx.x, NGW = G * NWAVES;
#define TID_OPAQUE() int tid_ = threadIdx.x; asm volatile("" : "+v"(tid_)); const int tid = tid_, lane = tid & 63, wave = __builtin_amdgcn_readfirstlane(tid >> 6), gw = bx * NWAVES + wave; (void)tid; (void)lane; (void)gw
    float* out = args.out;
#define GASP __attribute__((address_space(1)))
#define WS_OPAQUE() GASP unsigned char* ws = (GASP unsigned char*)args.ws; asm volatile("" : "+s"(ws))
#define WSP(T, off) ((T*)(GASP T*)(ws + (off)))
#define GRID_SYNC1() xcd_barrier(xbar)
#ifdef DUPSYNC
#define GRID_SYNC() do { GRID_SYNC1(); GRID_SYNC1(); } while (0)
#else
#define GRID_SYNC() GRID_SYNC1()
#endif
    { TID_OPAQUE(); WS_OPAQUE(); for (int it = bx; it < DEPTH * NGRP; it += G) ssm_tables(args, it >> 5, it & 31, (unsigned char*)ws, L, tid); }
    for (int l_ = 0; l_ < DEPTH; ++l_) {
        int l = l_; asm volatile("" : "+s"(l));
#if (PHMASK >> 0) & 1
        for (int rep_ = 0; rep_ < (int)((DUPMASK >> 0) & 1) + 1; ++rep_) {
        {
            TID_OPAQUE(); WS_OPAQUE(); bf16* Win_t = WSP(bf16, WS_WIN); bf16* Wup_t = WSP(bf16, WS_WUP); bf16* Wdn_t = WSP(bf16, WS_WDN); bf16* Wout_t = WSP(bf16, WS_WOUT);
            bf16* Wa_t = WSP(bf16, WS_WA); bf16* Wb_t = WSP(bf16, WS_WB); bf16* Wglu_t = WSP(bf16, WS_WGLU); bf16* H = WSP(bf16, WS_H); float* LOGF = WSP(float, WS_LOGF);
            LAS float* scr = (LAS float*)(L + wave * 16384);
            const float* w_in = args.in[2] + (size_t)l * DMOD * NIN; const float* w_glu = args.in[12] + (size_t)l * SW * SW;
            const float* w_a = args.in[14] + (size_t)l * AW * DMOD; const float* w_b = args.in[15] + (size_t)l * SW * DMOD; const float* w_out = args.in[16] + (size_t)l * DMOD * DMOD;
            const float* w_up = args.in[18] + (size_t)l * DMOD * FF; const float* w_dn = args.in[19] + (size_t)l * FF * DMOD;
            constexpr int I_IN = 16 * 128, I_GLU = 8 * 16, I_A = 8 * 32, I_B = 8 * 32, I_OUT = 16 * 32, I_UP = 16 * 128, I_DN = 64 * 32;
            constexpr int NITEMS = I_IN + I_GLU + I_A + I_B + I_OUT + I_UP + I_DN;
            for (int it = gw; it < NITEMS; it += NGW) {
                int r = it;
                if (r < I_IN) { const int nb = r % 128; const int sc0 = (nb >= 48) ? 8 : 0;
                    transpose_item(w_in, NIN, DMOD, 128, Win_t, 0, sc0, scr, r, lane); continue; } r -= I_IN;
                if (r < I_GLU) { transpose_item(w_glu, SW, SW, 16, Wglu_t, 0, 0, scr, r, lane); continue; } r -= I_GLU;
                if (r < I_A) { transpose_item(w_a, DMOD, AW, 32, Wa_t, 0, 0, scr, r, lane); continue; } r -= I_A;
                if (r < I_B) { transpose_item(w_b, DMOD, SW, 32, Wb_t, 0, 0, scr, r, lane); continue; } r -= I_B;
                if (r < I_OUT) { transpose_item(w_out, DMOD, DMOD, 32, Wout_t, 0, 0, scr, r, lane); continue; } r -= I_OUT;
                if (r < I_UP) { transpose_item(w_up, FF, DMOD, 128, Wup_t, 0, 0, scr, r, lane); continue; } r -= I_UP;
                transpose_item(w_dn, DMOD, FF, 32, Wdn_t, 0, 0, scr, r, lane);
            }
            if (l == 0) norm_rows<true, 2, true>(args.in[0], nullptr, WSP(bf16, WS_XB), args.in[1] + (size_t)l * DMOD, H, w_in, args.in[3] + (size_t)l * NHEADS, LOGF, gw, NGW, lane);
            else norm_rows<true, 2, false>(nullptr, WSP(bf16, WS_XB), nullptr, args.in[1] + (size_t)l * DMOD, H, w_in, args.in[3] + (size_t)l * NHEADS, LOGF, gw, NGW, lane);
        }
        }
#endif
        GRID_SYNC();
#if (PHMASK >> 1) & 1
        for (int rep_ = 0; rep_ < (int)((DUPMASK >> 1) & 1) + 1; ++rep_) {
        {
            WS_OPAQUE(); bf16* H = WSP(bf16, WS_H); bf16* Win_t = WSP(bf16, WS_WIN); bf16* Qb = WSP(bf16, WS_Q); bf16* AS = WSP(bf16, WS_AS); bf16* GA = WSP(bf16, WS_GA);
            static_assert(WS_V - WS_K == WS_K - WS_Q, "Q|K|V equally spaced");
            pg8::Gemm g{H, Win_t, M, 4096, DMOD}; pg8::StaticOrder S; S.init(M, 4096, G, bx);
            pg8::EpiInProj E{Qb, AS, GA, (size_t)(WS_K - WS_Q) / 2, (size_t)(WS_GB - WS_GA) / 2};
            pg8::gemm_phase<pg8::EpiInProj, pg8::StaticOrder, BIGK_ALIGN, true>(L, g, S, E);
        }
        }
#endif
        GRID_SYNC();
#if (PHMASK >> 2) & 1
        for (int rep_ = 0; rep_ < (int)((DUPMASK >> 2) & 1) + 1; ++rep_) {
        {
            WS_OPAQUE(); bf16* AS = WSP(bf16, WS_AS); bf16* WSB_t = WSP(bf16, WS_WSB + (size_t)l * SSM_W_LAYER); float* SLOC = WSP(float, WS_SLOC);
            pg8::Gemm g{AS, WSB_t, NGRP * NCR, NGRP * 256, ASK}; pg8::SsmOrder S{G, bx};
            pg8::EpiSsmState E{SLOC};
            pg8::gemm_phase<pg8::EpiSsmState, pg8::SsmOrder, SMALLK_ALIGN, true>(L, g, S, E);
        }
        }
#endif
#if (PHMASK >> 3) & 1
        for (int rep_ = 0; rep_ < (int)((DUPMASK >> 3) & 1) + 1; ++rep_) {
        {
            typedef float f2 __attribute__((ext_vector_type(2)));
            TID_OPAQUE(); WS_OPAQUE(); bf16* AS = WSP(bf16, WS_AS); float* SLOC = WSP(float, WS_SLOC); float* LOGF = WSP(float, WS_LOGF); float* BIAS = WSP(float, WS_BIAS);
            if ((wave & 1) == 0) {
                for (int i = 0; i * G + bx < NGRP * BATCH; ++i) { if (wave != ((2 * i) & 7)) continue; const int it = i * G + bx; const int g = it >> 4, b = it & 15;
                    const f2 l16 = WSP(const f2, WS_LPOW)[(l * NGRP + g) * 64 + lane];
                    const float* sl = SLOC + ((size_t)(g * NCR + b * 256)) * 128 + lane; bf16* as = AS + ((size_t)(g * NCR + b * 256)) * ASK + 256 + lane;
                    float sr = 0.f, si = 0.f;
                    for (int ch0 = 0; ch0 < 256; ch0 += 32) {
                        float ar[32], ai[32];
#pragma unroll
                        for (int i = 0; i < 32; ++i) { ar[i] = sl[(size_t)(ch0 + i) * 128]; ai[i] = sl[(size_t)(ch0 + i) * 128 + 64]; }
#pragma unroll
                        for (int i = 0; i < 32; ++i) { as[(size_t)(ch0 + i) * ASK] = (bf16)f2bf(sr); as[(size_t)(ch0 + i) * ASK + 64] = (bf16)f2bf(si);
                            const float nr = l16.x * sr - l16.y * si + ar[i], ni = l16.x * si + l16.y * sr + ai[i]; sr = nr; si = ni; } } }
            } else if ((gw & 3) == 1) {
                for (int sq = gw >> 2; sq < BATCH * NHEADS; sq += NGW >> 2) { const int b = sq >> 3, h = sq & 7;
                    const float* lf = LOGF + ((size_t)b * SEQ + lane * 64) * 8 + h; float tot = 0.f; float vals[64];
#pragma unroll
                    for (int i = 0; i < 64; ++i) vals[i] = lf[i * 8];
#pragma unroll
                    for (int i = 0; i < 64; ++i) tot += vals[i];
                    float incl = tot;
#pragma unroll
                    for (int o = 1; o < 64; o <<= 1) { const float t = __int_as_float(__builtin_amdgcn_ds_bpermute((lane - o) << 2, __float_as_int(incl))); if (lane >= o) incl += t; }
                    float run = incl - tot; float* bo = BIAS + (size_t)sq * SEQ + lane * 64;
#pragma unroll
                    for (int i = 0; i < 64; ++i) { run += vals[i]; bo[i] = -run * 1.4426950408889634f; } }
            }
        }
        }
#endif
        GRID_SYNC();
#if (PHMASK >> 4) & 1
        for (int rep_ = 0; rep_ < (int)((DUPMASK >> 4) & 1) + 1; ++rep_) {
        {
            WS_OPAQUE(); bf16* AS = WSP(bf16, WS_AS); bf16* WSY_t = WSP(bf16, WS_WSY + (size_t)l * SSM_W_LAYER); bf16* YB = WSP(bf16, WS_YB);
            pg8::Gemm g{AS, WSY_t, NGRP * NCR, NGRP * 256, ASK}; pg8::SsmOrder S{G, bx};
            pg8::EpiSsmY E{YB};
            pg8::gemm_phase<pg8::EpiSsmY, pg8::SsmOrder, SMALLK_ALIGN, true>(L, g, S, E);
        }
        {
            WS_OPAQUE(); bf16* Qb = WSP(bf16, WS_Q); bf16* Kb = WSP(bf16, WS_K); bf16* Vb = WSP(bf16, WS_V); float* BIAS = WSP(float, WS_BIAS);
            const attn_body::AttnTensors AT{(const attn_body::bf16*)Qb, (const attn_body::bf16*)Kb, (const attn_body::bf16*)Vb, (attn_body::bf16*)WSP(bf16, WS_H), BIAS};
            const attn_body::StaticOrder S(G, bx);
#ifndef NO_ATTN
            attn_body::attn_phase<attn_body::StaticOrder>((char*)lds, AT, S);
        }
#endif
        }
#endif
        GRID_SYNC();
#if (PHMASK >> 5) & 1
        for (int rep_ = 0; rep_ < (int)((DUPMASK >> 5) & 1) + 1; ++rep_) {
        {
            WS_OPAQUE(); bf16* YB = WSP(bf16, WS_YB); bf16* YB2 = WSP(bf16, WS_YB2); bf16* Wglu_t = WSP(bf16, WS_WGLU);
            pg8::Gemm g{YB, Wglu_t, M, SW, SW}; pg8::StaticOrder S; S.init(M, SW, G, bx);
            pg8::EpiGlu E{YB, YB2, args.in[13] + (size_t)l * SW};
            pg8::gemm_phase<pg8::EpiGlu, pg8::StaticOrder, SMALLK_ALIGN, true>(L, g, S, E);
        }
        }
#endif
#if (PHMASK >> 6) & 1
        for (int rep_ = 0; rep_ < (int)((DUPMASK >> 6) & 1) + 1; ++rep_) {
        {
            WS_OPAQUE(); bf16* Qb = WSP(bf16, WS_H)  ; bf16* Wa_t = WSP(bf16, WS_WA); bf16* GA = WSP(bf16, WS_GA); bf16* MIXED = WSP(bf16, WS_K)  ;
            pg8::Gemm g{Qb, Wa_t, M, DMOD, AW}; pg8::StaticOrder S; S.init(M, DMOD, G, bx);
            pg8::EpiGate<false> E{GA, MIXED};
            pg8::gemm_phase<pg8::EpiGate<false>, pg8::StaticOrder, SMALLK_ALIGN, true>(L, g, S, E);
        }
        }
#endif
        GRID_SYNC();
#if (PHMASK >> 7) & 1
        for (int rep_ = 0; rep_ < (int)((DUPMASK >> 7) & 1) + 1; ++rep_) {
        {
            WS_OPAQUE(); bf16* YB2 = WSP(bf16, WS_YB2); bf16* Wb_t = WSP(bf16, WS_WB); bf16* GB = WSP(bf16, WS_GB); bf16* MIXED = WSP(bf16, WS_K);
            pg8::Gemm g{YB2, Wb_t, M, DMOD, SW}; pg8::StaticOrder S; S.init(M, DMOD, G, bx);
            pg8::EpiGate<true> E{GB, rep_ ? WSP(bf16, WS_H) : MIXED};
            pg8::gemm_phase<pg8::EpiGate<true>, pg8::StaticOrder, SMALLK_ALIGN, true>(L, g, S, E);
        }
        }
#endif
        GRID_SYNC();
#if (PHMASK >> 8) & 1
        for (int rep_ = 0; rep_ < (int)((DUPMASK >> 8) & 1) + 1; ++rep_) {
        {
            WS_OPAQUE(); bf16* MIXED = WSP(bf16, WS_K); bf16* Wout_t = WSP(bf16, WS_WOUT);
            pg8::Gemm g{MIXED, Wout_t, M, DMOD, DMOD}; pg8::StaticOrder S; S.init(M, DMOD, G, bx);
            pg8::EpiResid E{rep_ ? WSP(bf16, WS_H) : WSP(bf16, WS_XB)};
            pg8::gemm_phase<pg8::EpiResid, pg8::StaticOrder, BIGK_ALIGN, true>(L, g, S, E);
        }
        }
#endif
        GRID_SYNC();
#if (PHMASK >> 9) & 1
        for (int rep_ = 0; rep_ < (int)((DUPMASK >> 9) & 1) + 1; ++rep_) {
        { TID_OPAQUE(); WS_OPAQUE(); norm_rows<false, 4, false>(nullptr, WSP(bf16, WS_XB), nullptr, args.in[17] + (size_t)l * DMOD, WSP(bf16, WS_H), nullptr, nullptr, nullptr, gw, NGW, lane); }
        }
#endif
        GRID_SYNC();
#if (PHMASK >> 10) & 1
        for (int rep_ = 0; rep_ < (int)((DUPMASK >> 10) & 1) + 1; ++rep_) {
        {
            WS_OPAQUE(); bf16* H = WSP(bf16, WS_H); bf16* Wup_t = WSP(bf16, WS_WUP); bf16* HID = WSP(bf16, WS_HID);
            pg8::Gemm g{H, Wup_t, M, FF, DMOD}; pg8::StaticOrder S; S.init(M, FF, G, bx);
            pg8::EpiRelu2 E{HID};
            pg8::gemm_phase<pg8::EpiRelu2, pg8::StaticOrder, BIGK_ALIGN, true>(L, g, S, E);
        }
        }
#endif
        GRID_SYNC();
#if (PHMASK >> 11) & 1
        for (int rep_ = 0; rep_ < (int)((DUPMASK >> 11) & 1) + 1; ++rep_) {
        {
            WS_OPAQUE(); bf16* HID = WSP(bf16, WS_HID); bf16* Wdn_t = WSP(bf16, WS_WDN);
            pg8::Gemm g{HID, Wdn_t, M, DMOD, FF}; pg8::StaticOrder S; S.init(M, DMOD, G, bx);
            pg8::EpiResid E{rep_ ? WSP(bf16, WS_H) : WSP(bf16, WS_XB)};
            pg8::gemm_phase<pg8::EpiResid, pg8::StaticOrder, BIGK_ALIGN, true>(L, g, S, E);
        }
        }
#endif
        GRID_SYNC();
    }
    { TID_OPAQUE(); WS_OPAQUE(); norm_rows_final<4>(WSP(bf16, WS_XB), out, args.in[20], gw, NGW, lane); }
}

extern "C" void kernel_launch(void* const* d_in, const int* in_sizes, int n_in, void* d_out, int out_size, void* d_ws, size_t ws_size, hipStream_t stream) {
    static int grid = 0;
    if (grid == 0) {
        if (n_in != 21 || in_sizes[0] != M * DMOD || out_size != M * DMOD || ws_size < WS_END) {
            fprintf(stderr, "kernel_launch: unexpected shapes: n_in %d in0 %d out %d ws %zu (need %zu)\n", n_in, n_in > 0 ? in_sizes[0] : -1, out_size, ws_size, (size_t)WS_END); grid = -1; return; }
        int dev = 0, cus = 0, per_cu = 0;
        hipGetDevice(&dev); hipDeviceGetAttribute(&cus, hipDeviceAttributeMultiprocessorCount, dev);
        if (hipFuncSetAttribute((const void*)fwd_megakernel, hipFuncAttributeMaxDynamicSharedMemorySize, LDS_BYTES) != hipSuccess) { fprintf(stderr, "kernel_launch: hipFuncSetAttribute failed\n"); grid = -1; return; }
        if (hipOccupancyMaxActiveBlocksPerMultiprocessor(&per_cu, (const void*)fwd_megakernel, NWAVES * 64, LDS_BYTES) != hipSuccess || per_cu < 1) per_cu = 1;
        (void)hipGetLastError();
        grid = cus * per_cu;
    }
    if (grid < 0) return;
    if (hipMemsetAsync((char*)d_ws + WS_CTL, 0, CTL_ZERO_BYTES, stream) != hipSuccess) { fprintf(stderr, "kernel_launch: hipMemsetAsync failed\n"); return; }
    Args a{};
    for (int i = 0; i < 21; ++i) a.in[i] = (const float*)d_in[i];
    a.out = (float*)d_out; a.ws = (unsigned char*)d_ws;
    void* kargs[] = {&a};
    hipError_t e = hipLaunchCooperativeKernel((const void*)fwd_megakernel, dim3(grid), dim3(NWAVES * 64), kargs, LDS_BYTES, stream);
    if (e != hipSuccess) fprintf(stderr, "cooperative launch failed: %s (grid %d)\n", hipGetErrorString(e), grid);
}
```

```cpp
#include <hip/hip_runtime.h>
#include <hip/hip_cooperative_groups.h>
#include <cstdio>
#include <cstdint>
namespace pg8 {
#define PG8_LAS __attribute__((address_space(3)))
typedef unsigned short bf16_t;
typedef short bf16x8 __attribute__((ext_vector_type(8)));
typedef float f32x4 __attribute__((ext_vector_type(4)));
typedef unsigned u32x4 __attribute__((ext_vector_type(4)));
constexpr int BM = 256, BK = 64, HALF = 128, HTB = HALF * BK * 2  , STAGE_BYTES = 8 * HTB, NXCD = 8, WGM = 8;

__host__ __device__ __forceinline__ int lds_byte(int r, int c) { const int st = (r >> 4) * 2 + (c >> 5), rr = r & 15, cc = c & 31, ob = rr * 64 + cc * 2; return st * 1024 + (ob ^ (((ob >> 9) & 1) << 5)); }
__host__ __device__ __forceinline__ void stage_rc(int b, int& R, int& C) { const int st = b / 1024, sb = b % 1024, swz = sb ^ (((sb >> 9) & 1) << 5); R = (st >> 1) * 16 + swz / 64; C = (st & 1) * 32 + (swz % 64) / 2; }
__host__ __device__ __forceinline__ int perm32(int rho) { const int n = rho >> 4, i = rho & 15; return 8 * (i >> 2) + 4 * n + (i & 3); }

struct Unit { int pm, pn; };
struct Gemm { const bf16_t* A; const bf16_t* Bt; int M, N, K; };

struct StaticOrder {
    int nM, nN, nwg, G, c;
    __host__ __device__ void init(int M, int N, int G_, int c_) { nM = M / BM; nN = N / BM; nwg = nM * nN; G = G_; c = c_; }
    __host__ __device__ bool next(int i, Unit& u) const {
        const long L = (long)i * G + c; if (L >= nwg) return false;
        int wgid = (int)L; { const int q = nwg / NXCD, r = nwg % NXCD, xcd = wgid % NXCD, off = wgid / NXCD; wgid = (xcd < r ? xcd * (q + 1) : r * (q + 1) + (xcd - r) * q) + off; }
        const int nig = WGM * nN, gid = wgid / nig, fm = gid * WGM, gsz = (nM - fm) < WGM ? (nM - fm) : WGM;
        u.pm = fm + ((wgid % nig) % gsz); u.pn = (wgid % nig) / gsz; return true;
    }
    __device__ __forceinline__ void a_ready(const Unit&) const {}
    __device__ __forceinline__ void done(const Unit&) const {}
};

typedef float f32x2c_t __attribute__((ext_vector_type(2))); typedef __bf16 bf16x2c_t __attribute__((ext_vector_type(2)));
__device__ __forceinline__ unsigned cvt_pk_bf16(float lo, float hi) { f32x2c_t v = {lo, hi}; bf16x2c_t b = __builtin_convertvector(v, bf16x2c_t); return __builtin_bit_cast(unsigned, b); }
typedef float f32x2 __attribute__((ext_vector_type(2)));
__device__ __forceinline__ f32x2 gelu_pk(f32x2 v) {
    const f32x2 av = __builtin_elementwise_abs(v), d = av * 0.2316418882f + 1.0f;
    f32x2 t; t.x = __builtin_amdgcn_rcpf(d.x); t.y = __builtin_amdgcn_rcpf(d.y);
    f32x2 q = t * 0.5307027145f + (-0.7265760135f); q = q * t + 0.7107068705f; q = q * t + (-0.142248368f); q = q * t + 0.127414796f; q = q * t;
    const f32x2 s = (v * v) * (-0.72134752044f);
    f32x2 e; e.x = __builtin_amdgcn_exp2f(s.x); e.y = __builtin_amdgcn_exp2f(s.y);
    const f32x2 m = v * (q * e), r = v - m;
    f32x2 o; o.x = v.x < 0.f ? m.x : r.x; o.y = v.y < 0.f ? m.y : r.y; return o;
}

constexpr float LOG2E = 1.4426950408889634f;
constexpr float QC2 = 0.125f * 1.4426950408889634f;
__device__ __forceinline__ float sigm(float x) { return __builtin_amdgcn_rcpf(1.0f + __builtin_amdgcn_exp2f(-x * LOG2E)); }
__device__ __forceinline__ float gelu_tanh(float x) { const float z = 1.5957691216057308f * (x + 0.044715f * x * x * x); return x * sigm(z); }
__device__ __forceinline__ u32x4 pack8(const f32x4 v0, const f32x4 v1) { u32x4 w; w.x = cvt_pk_bf16(v0[0], v0[1]); w.y = cvt_pk_bf16(v0[2], v0[3]); w.z = cvt_pk_bf16(v1[0], v1[1]); w.w = cvt_pk_bf16(v1[2], v1[3]); return w; }
__device__ __forceinline__ float bf_lo(unsigned w) { return __uint_as_float(w << 16); }
__device__ __forceinline__ float bf_hi(unsigned w) { return __uint_as_float(w & 0xffff0000u); }
#define EPI_LOOP_BEGIN \
    _Pragma("unroll") for (int ai = 0; ai < 2; ++ai) _Pragma("unroll") for (int m = 0; m < 4; ++m) { const int row = u.pm * BM + ai * HALF + wr * 64 + m * 16 + fr; \
    _Pragma("unroll") for (int bj = 0; bj < 2; ++bj) { const int ct = bj * HALF + wc * 32 + 8 * fq; f32x4 v0 = acc[ai][bj][m][0], v1 = acc[ai][bj][m][1];
#define EPI_LOOP_END } }
#define EPI_SIG(v0, v1) do { _Pragma("unroll") for (int e_ = 0; e_ < 4; ++e_) { v0[e_] = sigm(v0[e_]); v1[e_] = sigm(v1[e_]); } } while (0)

struct EpiInProj {
    static constexpr bool PERM = true, AFTER_DRAIN = false;
    bf16_t *Q, *AS, *GA; size_t qkv_stride, gate_stride;
    __device__ __forceinline__ void operator()(const f32x4 (&acc)[2][2][4][2], const Unit& u, int wr, int wc, int fr, int fq) const {
        const int pn = u.pn;
        if (pn < 6) {
            bf16_t* base = Q + (size_t)(pn >> 1) * qkv_stride; const float sc = pn < 2 ? QC2 : 1.0f; const int cb = (pn & 1) * 256;
            EPI_LOOP_BEGIN v0 = v0 * sc; v1 = v1 * sc; *(u32x4*)(base + (size_t)row * 512 + cb + ct) = pack8(v0, v1); EPI_LOOP_END
        } else if (pn < 8) {
            const int cb = (pn - 6) * 256;
            EPI_LOOP_BEGIN const int j = cb + ct; const int g = j >> 4;
                *(u32x4*)(AS + ((size_t)(g * 4096 + (row >> 4))) * 384 + (row & 15) * 16 + (j & 15)) = pack8(v0, v1); EPI_LOOP_END
        } else {
            bf16_t* base = GA + (size_t)((pn - 8) >> 2) * gate_stride; const int cb = ((pn - 8) & 3) * 256;
            EPI_LOOP_BEGIN EPI_SIG(v0, v1); *(u32x4*)(base + (size_t)row * 1024 + cb + ct) = pack8(v0, v1); EPI_LOOP_END
        }
    }
};
struct EpiSsmState {
    static constexpr bool PERM = true, AFTER_DRAIN = false;
    float* SLOC;
    __device__ __forceinline__ void operator()(const f32x4 (&acc)[2][2][4][2], const Unit& u, int wr, int wc, int fr, int fq) const {
        EPI_LOOP_BEGIN if (bj == 0) { float* d = SLOC + (size_t)row * 128 + ct; *(f32x4*)d = v0; *(f32x4*)(d + 4) = v1; } EPI_LOOP_END
    }
};
struct EpiSsmY {
    static constexpr bool PERM = true, AFTER_DRAIN = false;
    bf16_t* YB;
    __device__ __forceinline__ void operator()(const f32x4 (&acc)[2][2][4][2], const Unit& u, int wr, int wc, int fr, int fq) const {
        EPI_LOOP_BEGIN const int g = row >> 12, cr = row & 4095, tl = ct >> 4, c0 = ct & 15;
            _Pragma("unroll") for (int e = 0; e < 4; ++e) { v0[e] = gelu_tanh(v0[e]); v1[e] = gelu_tanh(v1[e]); }
            *(u32x4*)(YB + ((size_t)(cr * 16 + tl)) * 512 + g * 16 + c0) = pack8(v0, v1); EPI_LOOP_END
    }
};
#define EPI_ROW(ai, m) (u.pm * BM + (ai) * HALF + wr * 64 + (m) * 16 + fr)
#define EPI_CT(bj) ((bj) * HALF + wc * 32 + 8 * fq)
struct EpiGlu {
    static constexpr bool PERM = true, AFTER_DRAIN = false;
    const bf16_t* YB; bf16_t* O; const float* bias;
    __device__ __forceinline__ void operator()(const f32x4 (&acc)[2][2][4][2], const Unit& u, int wr, int wc, int fr, int fq) const {
        u32x4 y[2][4][2]; f32x4 bb[2][2];
        _Pragma("unroll") for (int bj = 0; bj < 2; ++bj) { const int col = u.pn * BM + EPI_CT(bj); bb[bj][0] = *(const f32x4*)(bias + col); bb[bj][1] = *(const f32x4*)(bias + col + 4); }
        _Pragma("unroll") for (int ai = 0; ai < 2; ++ai) _Pragma("unroll") for (int m = 0; m < 4; ++m) _Pragma("unroll") for (int bj = 0; bj < 2; ++bj)
            y[ai][m][bj] = *(const u32x4*)(YB + (size_t)EPI_ROW(ai, m) * 512 + u.pn * BM + EPI_CT(bj));
        _Pragma("unroll") for (int ai = 0; ai < 2; ++ai) _Pragma("unroll") for (int m = 0; m < 4; ++m) _Pragma("unroll") for (int bj = 0; bj < 2; ++bj) {
            f32x4 v0 = acc[ai][bj][m][0] + bb[bj][0], v1 = acc[ai][bj][m][1] + bb[bj][1]; const u32x4 yy = y[ai][m][bj]; EPI_SIG(v0, v1);
            v0[0] *= bf_lo(yy.x); v0[1] *= bf_hi(yy.x); v0[2] *= bf_lo(yy.y); v0[3] *= bf_hi(yy.y); v1[0] *= bf_lo(yy.z); v1[1] *= bf_hi(yy.z); v1[2] *= bf_lo(yy.w); v1[3] *= bf_hi(yy.w);
            *(u32x4*)(O + (size_t)EPI_ROW(ai, m) * 512 + u.pn * BM + EPI_CT(bj)) = pack8(v0, v1); }
    }
};
template <bool ADD> struct EpiGate {
    static constexpr bool PERM = true, AFTER_DRAIN = false;
    const bf16_t* G; bf16_t* O;
    __device__ __forceinline__ void operator()(const f32x4 (&acc)[2][2][4][2], const Unit& u, int wr, int wc, int fr, int fq) const {
        _Pragma("unroll") for (int ai = 0; ai < 2; ++ai) {
            u32x4 gt[4][2], oo[4][2];
            _Pragma("unroll") for (int m = 0; m < 4; ++m) _Pragma("unroll") for (int bj = 0; bj < 2; ++bj) { const size_t off = (size_t)EPI_ROW(ai, m) * 1024 + u.pn * BM + EPI_CT(bj);
                gt[m][bj] = *(const u32x4*)(G + off); if (ADD) oo[m][bj] = *(const u32x4*)(O + off); }
            _Pragma("unroll") for (int m = 0; m < 4; ++m) _Pragma("unroll") for (int bj = 0; bj < 2; ++bj) { const size_t off = (size_t)EPI_ROW(ai, m) * 1024 + u.pn * BM + EPI_CT(bj);
                f32x4 v0 = acc[ai][bj][m][0], v1 = acc[ai][bj][m][1]; const u32x4 g4 = gt[m][bj];
                v0[0] *= bf_lo(g4.x); v0[1] *= bf_hi(g4.x); v0[2] *= bf_lo(g4.y); v0[3] *= bf_hi(g4.y); v1[0] *= bf_lo(g4.z); v1[1] *= bf_hi(g4.z); v1[2] *= bf_lo(g4.w); v1[3] *= bf_hi(g4.w);
                if (ADD) { const u32x4 o = oo[m][bj];
                    v0[0] += bf_lo(o.x); v0[1] += bf_hi(o.x); v0[2] += bf_lo(o.y); v0[3] += bf_hi(o.y); v1[0] += bf_lo(o.z); v1[1] += bf_hi(o.z); v1[2] += bf_lo(o.w); v1[3] += bf_hi(o.w); }
                *(u32x4*)(O + off) = pack8(v0, v1); }
            asm volatile("" ::: "memory");
        }
    }
};
struct EpiResid {
    static constexpr bool PERM = true, AFTER_DRAIN = false;
    bf16_t* X;
    __device__ __forceinline__ void operator()(const f32x4 (&acc)[2][2][4][2], const Unit& u, int wr, int wc, int fr, int fq) const {
        u32x4 xo[2][4][2];
        _Pragma("unroll") for (int ai = 0; ai < 2; ++ai) _Pragma("unroll") for (int m = 0; m < 4; ++m) _Pragma("unroll") for (int bj = 0; bj < 2; ++bj)
            xo[ai][m][bj] = *(const u32x4*)(X + (size_t)EPI_ROW(ai, m) * 1024 + u.pn * BM + EPI_CT(bj));
        _Pragma("unroll") for (int ai = 0; ai < 2; ++ai) _Pragma("unroll") for (int m = 0; m < 4; ++m) _Pragma("unroll") for (int bj = 0; bj < 2; ++bj) {
            f32x4 v0 = acc[ai][bj][m][0], v1 = acc[ai][bj][m][1]; const u32x4 o = xo[ai][m][bj];
            v0[0] += bf_lo(o.x); v0[1] += bf_hi(o.x); v0[2] += bf_lo(o.y); v0[3] += bf_hi(o.y); v1[0] += bf_lo(o.z); v1[1] += bf_hi(o.z); v1[2] += bf_lo(o.w); v1[3] += bf_hi(o.w);
            *(u32x4*)(X + (size_t)EPI_ROW(ai, m) * 1024 + u.pn * BM + EPI_CT(bj)) = pack8(v0, v1); }
    }
};
struct EpiRelu2 {
    static constexpr bool PERM = true, AFTER_DRAIN = false;
    bf16_t* O;
    __device__ __forceinline__ void operator()(const f32x4 (&acc)[2][2][4][2], const Unit& u, int wr, int wc, int fr, int fq) const {
        EPI_LOOP_BEGIN _Pragma("unroll") for (int e = 0; e < 4; ++e) { const float a = fmaxf(v0[e], 0.f), b = fmaxf(v1[e], 0.f); v0[e] = a * a; v1[e] = b * b; }
            *(u32x4*)(O + (size_t)row * 4096 + u.pn * BM + ct) = pack8(v0, v1); EPI_LOOP_END
    }
};
struct SsmOrder {
    int G, c;
    __device__ __forceinline__ bool next(int i, Unit& u) const { const int L = i * G + c; if (L >= 512) return false; u.pm = L; u.pn = L >> 4; return true; }
    __device__ __forceinline__ void a_ready(const Unit&) const {}
    __device__ __forceinline__ void done(const Unit&) const {}
};

template <class Epi, class Sched, bool ALIGN_EPI = false, bool SP2 = false>
__device__ __forceinline__ void gemm_phase(PG8_LAS unsigned char* lds, const Gemm g, const Sched& S, const Epi& E) {
    int tid_ = threadIdx.x; asm volatile("" : "+v"(tid_));
    const int tid = tid_, wid = __builtin_amdgcn_readfirstlane(tid >> 6), lane = tid & 63, wr = wid >> 2, wc = wid & 3, fr = lane & 15, fq = lane >> 4;
    const int K = g.K, nt = K / BK;
    unsigned voffA[2], voffB[2];
#pragma unroll
    for (int i = 0; i < 2; ++i) { int R, C; stage_rc(tid * 16 + i * 8192, R, C); const int Rb = Epi::PERM ? ((R & ~31) + perm32(R & 31)) : R;
        voffA[i] = (unsigned)(R * K + C) * 2u; voffB[i] = (unsigned)(Rb * K + C) * 2u; }
    const size_t kstep = (size_t)(BK * 2);
    const size_t hstep = (size_t)HALF * K * 2;
    const size_t tstep = 2 * hstep;
    const unsigned ldsw = (unsigned)wid * 1024u;
    const int aoff = lds_byte(wr * 64 + fr, fq * 8), boff = lds_byte(wc * 32 + fr, fq * 8);
#define PG8_SA(b, h) (((b) * 2 + (h)) * HTB)
#define PG8_SB(b, h) ((4 + (b) * 2 + (h)) * HTB)
#define PG8_STAGE(bufoff, gbase, voff) do { _Pragma("unroll") for (int _i = 0; _i < 2; ++_i) \
        __builtin_amdgcn_global_load_lds((const unsigned*)((const char*)(gbase) + (voff)[_i]), (PG8_LAS unsigned*)(lds + (bufoff) + ldsw + _i * 8192), 16, 0, 0); } while (0)
#define PG8_LDA(dst, b, h) do { _Pragma("unroll") for (int m = 0; m < 4; ++m) _Pragma("unroll") for (int k = 0; k < 2; ++k) dst[m][k] = *(const PG8_LAS bf16x8*)(lds + PG8_SA(b, h) + aoff + m * 2048 + k * 1024); } while (0)
#define PG8_LDB(dst, b, h) do { _Pragma("unroll") for (int n = 0; n < 2; ++n) _Pragma("unroll") for (int k = 0; k < 2; ++k) dst[n][k] = *(const PG8_LAS bf16x8*)(lds + PG8_SB(b, h) + boff + n * 2048 + k * 1024); } while (0)
#define PG8_MMA(ai, bj, At, Bt) do { __builtin_amdgcn_s_setprio(1); _Pragma("unroll") for (int m = 0; m < 4; ++m) _Pragma("unroll") for (int n = 0; n < 2; ++n) _Pragma("unroll") for (int k = 0; k < 2; ++k) \
        acc[ai][bj][m][n] = __builtin_amdgcn_mfma_f32_16x16x32_bf16(Bt[n][k], At[m][k], acc[ai][bj][m][n], 0, 0, 0); __builtin_amdgcn_s_setprio(0); } while (0)
#define PG8_WAIT_V(n) asm volatile("s_waitcnt vmcnt(" #n ")" ::: "memory")
#define PG8_WAIT_L(n) asm volatile("s_waitcnt lgkmcnt(" #n ")" ::: "memory")
#define PG8_BAR __builtin_amdgcn_s_barrier()
#define PG8_SCHED __builtin_amdgcn_sched_barrier(0)
    Unit cur, nxt; int ui = 0;
    if (!S.next(0, cur)) return;
    f32x4 acc[2][2][4][2];
#pragma unroll
    for (int a = 0; a < 2; ++a)
#pragma unroll
        for (int b = 0; b < 2; ++b)
#pragma unroll
            for (int m = 0; m < 4; ++m)
#pragma unroll
                for (int n = 0; n < 2; ++n) acc[a][b][m][n] = (f32x4){0.f, 0.f, 0.f, 0.f};
    bf16x8 At[4][2], B0[2][2], B1[2][2];
    const char* cA = (const char*)g.A + (size_t)cur.pm * tstep; const char* cB = (const char*)g.Bt + (size_t)cur.pn * tstep;
    S.a_ready(cur);
    if constexpr (SP2) {
        PG8_STAGE(PG8_SB(0, 0), cB, voffB); PG8_STAGE(PG8_SB(0, 1), cB + hstep, voffB); PG8_STAGE(PG8_SA(0, 0), cA, voffA); PG8_STAGE(PG8_SA(0, 1), cA + hstep, voffA);
        if (wr == 1) PG8_BAR;
        PG8_WAIT_V(2); PG8_BAR;
        PG8_STAGE(PG8_SB(1, 0), cB + kstep, voffB); PG8_STAGE(PG8_SA(1, 0), cA + kstep, voffA); PG8_STAGE(PG8_SB(1, 1), cB + hstep + kstep, voffB);
        PG8_WAIT_V(6); PG8_BAR;
    } else {
        PG8_STAGE(PG8_SB(0, 0), cB, voffB); PG8_STAGE(PG8_SA(0, 0), cA, voffA); PG8_STAGE(PG8_SB(0, 1), cB + hstep, voffB); PG8_STAGE(PG8_SA(0, 1), cA + hstep, voffA);
        if (wr == 1) PG8_BAR;
        PG8_WAIT_V(4); PG8_BAR;
        PG8_STAGE(PG8_SB(1, 0), cB + kstep, voffB); PG8_STAGE(PG8_SA(1, 0), cA + kstep, voffA); PG8_STAGE(PG8_SB(1, 1), cB + hstep + kstep, voffB);
        PG8_WAIT_V(6); PG8_BAR;
    }
    for (;;) {
        const bool has_next = S.next(ui + 1, nxt);
        const char* nA = has_next ? (const char*)g.A + (size_t)nxt.pm * tstep : cA; const char* nB = has_next ? (const char*)g.Bt + (size_t)nxt.pn * tstep : cB;
        for (int t = 0; t < nt; t += 2) {
            const bool last = (t == nt - 2);
            const char* a1 = cA + (size_t)(t + 1) * kstep;
            const char* a2 = last ? nA : cA + (size_t)(t + 2) * kstep; const char* b2 = last ? nB : cB + (size_t)(t + 2) * kstep;
            const char* a3 = a2 + kstep; const char* b3 = b2 + kstep;
            if (last && has_next) S.a_ready(nxt);
            if constexpr (SP2) {
            PG8_LDB(B0, 0, 0); PG8_LDB(B1, 0, 1); PG8_SCHED; PG8_LDA(At, 0, 0); PG8_STAGE(PG8_SA(1, 1), a1 + hstep, voffA);
            PG8_WAIT_V(8); PG8_WAIT_L(0); PG8_BAR; PG8_MMA(0, 0, At, B0); PG8_MMA(0, 1, At, B1); PG8_BAR; PG8_SCHED;
            PG8_LDA(At, 0, 1); PG8_STAGE(PG8_SB(0, 0), b2, voffB); PG8_STAGE(PG8_SB(0, 1), b2 + hstep, voffB); PG8_STAGE(PG8_SA(0, 0), a2, voffA);
            PG8_WAIT_V(8); PG8_WAIT_L(0); PG8_BAR; PG8_MMA(1, 0, At, B0); PG8_MMA(1, 1, At, B1); PG8_BAR; PG8_SCHED;
            PG8_LDB(B0, 1, 0); PG8_LDB(B1, 1, 1); PG8_SCHED; PG8_LDA(At, 1, 0); PG8_STAGE(PG8_SA(0, 1), a2 + hstep, voffA);
            PG8_WAIT_V(8); PG8_WAIT_L(0); PG8_BAR; PG8_MMA(0, 0, At, B0); PG8_MMA(0, 1, At, B1); PG8_BAR; PG8_SCHED;
            PG8_LDA(At, 1, 1); PG8_STAGE(PG8_SB(1, 0), b3, voffB); PG8_STAGE(PG8_SB(1, 1), b3 + hstep, voffB); PG8_STAGE(PG8_SA(1, 0), a3, voffA);
            PG8_WAIT_V(8); PG8_WAIT_L(0); PG8_BAR; PG8_MMA(1, 0, At, B0); PG8_MMA(1, 1, At, B1); PG8_BAR; PG8_SCHED;
            } else {
            PG8_LDB(B0, 0, 0); PG8_SCHED; PG8_LDA(At, 0, 0); PG8_STAGE(PG8_SA(1, 1), a1 + hstep, voffA);
            PG8_WAIT_L(8); PG8_BAR; PG8_WAIT_L(0); PG8_MMA(0, 0, At, B0); PG8_BAR; PG8_SCHED;
            PG8_LDB(B1, 0, 1); PG8_STAGE(PG8_SB(0, 0), b2, voffB);
            PG8_BAR; PG8_WAIT_L(0); PG8_MMA(0, 1, At, B1); PG8_BAR;
            PG8_LDA(At, 0, 1); PG8_STAGE(PG8_SA(0, 0), a2, voffA);
            PG8_BAR; PG8_WAIT_L(0); PG8_MMA(1, 0, At, B0); PG8_BAR; PG8_SCHED;
            PG8_STAGE(PG8_SB(0, 1), b2 + hstep, voffB);
            PG8_WAIT_V(6); PG8_BAR; PG8_MMA(1, 1, At, B1); PG8_BAR;
            PG8_LDB(B0, 1, 0); PG8_SCHED; PG8_LDA(At, 1, 0); PG8_STAGE(PG8_SA(0, 1), a2 + hstep, voffA);
            PG8_WAIT_L(8); PG8_BAR; PG8_WAIT_L(0); PG8_MMA(0, 0, At, B0); PG8_BAR; PG8_SCHED;
            PG8_LDB(B1, 1, 1); PG8_STAGE(PG8_SB(1, 0), b3, voffB);
            PG8_BAR; PG8_WAIT_L(0); PG8_MMA(0, 1, At, B1); PG8_BAR;
            PG8_LDA(At, 1, 1); PG8_STAGE(PG8_SA(1, 0), a3, voffA);
            PG8_BAR; PG8_WAIT_L(0); PG8_MMA(1, 0, At, B0); PG8_BAR; PG8_SCHED;
            PG8_STAGE(PG8_SB(1, 1), b3 + hstep, voffB);
            PG8_WAIT_V(6); PG8_BAR; PG8_MMA(1, 1, At, B1); PG8_BAR;
            }
        }
        if constexpr (ALIGN_EPI) { if (wr == 0) PG8_BAR; }
        if constexpr (!Epi::AFTER_DRAIN) { E(acc, cur, wr, wc, fr, fq); S.done(cur); }
        if (!has_next) break;
#pragma unroll
        for (int a = 0; a < 2; ++a)
#pragma unroll
            for (int b = 0; b < 2; ++b)
#pragma unroll
                for (int m = 0; m < 4; ++m)
#pragma unroll
                    for (int n = 0; n < 2; ++n) acc[a][b][m][n] = (f32x4){0.f, 0.f, 0.f, 0.f};
        cur = nxt; cA = nA; cB = nB; ++ui;
        if constexpr (ALIGN_EPI) { if (wr == 1) PG8_BAR; }
    }
    PG8_WAIT_V(0);
    if constexpr (!ALIGN_EPI) { if (wr == 0) PG8_BAR; }
    PG8_BAR;
    if constexpr (Epi::AFTER_DRAIN) { E.fused(acc, cur, wr, wc, fr, fq, lds, wid, lane); S.done(cur); }
#undef PG8_SA
#undef PG8_SB
#undef PG8_STAGE
#undef PG8_LDA
#undef PG8_LDB
#undef PG8_MMA
#undef PG8_WAIT_V
#undef PG8_WAIT_L
#undef PG8_BAR
#undef PG8_SCHED
}
}
#include <hip/hip_bf16.h>
#include <cmath>
namespace attn_body {
using bf16=__hip_bfloat16;
using bf16x8=__attribute__((ext_vector_type(8)))short;
using s16x4=__attribute__((ext_vector_type(4)))short;
using f32x16=__attribute__((ext_vector_type(16)))float;
using u32x4=__attribute__((ext_vector_type(4)))unsigned;
constexpr int BATCH=16,NHEAD=8,SEQ=4096,D=64,DM=NHEAD*D;
constexpr int NW=8,QBLK=32,QB=QBLK*NW,KVBLK=64,NQB=SEQ/QB;
constexpr int ATTN_PITCH=DM, ATTN_UNIT_ROWS=QB;
__device__ __forceinline__ int crow(int r,int hi){return (r&3)+8*(r>>2)+4*hi;}
#define SBAR() __builtin_amdgcn_sched_barrier(0)
__device__ __forceinline__ void cmask(f32x16&p0,f32x16&p1,int jb,int qrel,int hi){
  const float NEG=-INFINITY; int kb=64*jb+4*hi;
  #pragma unroll
  for(int r=0;r<16;++r){int kv=kb+(r&3)+8*(r>>2); if(kv>qrel)p0[r]=NEG; if(kv+32>qrel)p1[r]=NEG;}
}

constexpr int NSLOT=3, SLOTB=8192;
constexpr int LDS_K=0, LDS_V=NSLOT*SLOTB, LDS_WS=2*NSLOT*SLOTB, LDS_OST=LDS_WS+NW*64*4, LDS_BIAS=LDS_OST+NW*4096, LDS_BYTES=LDS_BIAS+SEQ*4;
constexpr float C2=0.125f*1.4426950408889634f;
__device__ __forceinline__ void glds16(const void*gsrc,unsigned lds_dst){unsigned keep;
  asm volatile("s_mov_b32 %0, m0\n\ts_mov_b32 m0, %2\n\ts_nop 0\n\tglobal_load_lds_dwordx4 %1, off\n\ts_mov_b32 m0, %0":"=&s"(keep):"v"(gsrc),"s"(lds_dst):"memory");}
__device__ __forceinline__ float max3f(float a,float b,float c){float r;asm("v_max3_f32 %0, %1, %2, %3":"=v"(r):"v"(a),"v"(b),"v"(c));return r;}
__device__ __forceinline__ float max2f(float a,float b){float r;asm("v_max_f32_e32 %0, %1, %2":"=v"(r):"v"(a),"v"(b));return r;}
__device__ __forceinline__ float fadd_s(float a,float b){float r;asm("v_add_f32_e32 %0, %1, %2":"=v"(r):"v"(a),"v"(b));return r;}
__device__ __forceinline__ float fsub_s(float a,float b){float r;asm("v_sub_f32_e32 %0, %1, %2":"=v"(r):"v"(a),"v"(b));return r;}
typedef float f32x4_t __attribute__((ext_vector_type(4))); typedef float f32x2_t __attribute__((ext_vector_type(2))); typedef __bf16 bf16x2_t __attribute__((ext_vector_type(2)));
__device__ __forceinline__ unsigned cvtpk_s(float lo,float hi){f32x2_t v={lo,hi};bf16x2_t b=__builtin_convertvector(v,bf16x2_t);return __builtin_bit_cast(unsigned,b);}
#define WAIT_BAR(N) asm volatile("s_waitcnt vmcnt(" #N ") lgkmcnt(0)\n\ts_barrier":::"memory")

__device__ __forceinline__ void qkt(f32x16&p0,f32x16&p1,const char*Kslot,const bf16x8*qr,const f32x16&negm,int r32,int hi){
  const char*kb=Kslot+hi*1024+r32*16;
  #pragma unroll
  for(int d0=0;d0<4;++d0){
    const bf16x8 b0=*reinterpret_cast<const bf16x8*>(kb+d0*2048);
    const bf16x8 b1=*reinterpret_cast<const bf16x8*>(kb+d0*2048+512);
    if(d0==0){p0=__builtin_amdgcn_mfma_f32_32x32x16_bf16(b0,qr[0],negm,0,0,0);p1=__builtin_amdgcn_mfma_f32_32x32x16_bf16(b1,qr[0],negm,0,0,0);}
    else{p0=__builtin_amdgcn_mfma_f32_32x32x16_bf16(b0,qr[d0],p0,0,0,0);p1=__builtin_amdgcn_mfma_f32_32x32x16_bf16(b1,qr[d0],p1,0,0,0);}}
}
typedef __attribute__((address_space(3))) const char* lds_cptr;
typedef short v4i16_t __attribute__((ext_vector_type(4)));
__device__ __forceinline__ void kload8(bf16x8*kf,lds_cptr kp){
  kf[0]=*(const __attribute__((address_space(3))) bf16x8*)(kp);      kf[1]=*(const __attribute__((address_space(3))) bf16x8*)(kp+512);
  kf[2]=*(const __attribute__((address_space(3))) bf16x8*)(kp+2048); kf[3]=*(const __attribute__((address_space(3))) bf16x8*)(kp+2560);
  kf[4]=*(const __attribute__((address_space(3))) bf16x8*)(kp+4096); kf[5]=*(const __attribute__((address_space(3))) bf16x8*)(kp+4608);
  kf[6]=*(const __attribute__((address_space(3))) bf16x8*)(kp+6144); kf[7]=*(const __attribute__((address_space(3))) bf16x8*)(kp+6656);
}
__device__ __forceinline__ void kload2(bf16x8*kf,lds_cptr kp,int j){ kf[2*j]=*(const __attribute__((address_space(3))) bf16x8*)(kp+j*2048); kf[2*j+1]=*(const __attribute__((address_space(3))) bf16x8*)(kp+j*2048+512); }
__device__ __forceinline__ s16x4 vtr(lds_cptr p){ return __builtin_bit_cast(s16x4,__builtin_amdgcn_ds_read_tr16_b64_v4i16((__attribute__((address_space(3))) v4i16_t*)p)); }
__device__ __forceinline__ float rowmax(const f32x16&p0,const f32x16&p1){
  float a=max3f(p0[0],p0[1],p1[0]),b=max3f(p0[2],p0[3],p1[1]);a=max3f(a,p1[2],p1[3]);
  #pragma unroll
  for(int r=4;r<16;r+=4){a=max3f(a,p0[r],p0[r+1]);b=max3f(b,p0[r+2],p0[r+3]);a=max3f(a,p1[r],p1[r+1]);b=max3f(b,p1[r+2],p1[r+3]);}
  const float m=max2f(a,b);
  auto rr=__builtin_amdgcn_permlane32_swap(__float_as_uint(m),__float_as_uint(m),false,false);
  return max2f(__uint_as_float(rr[0]),__uint_as_float(rr[1]));
}
__device__ __forceinline__ void pv(f32x16*o,int vb,bf16x8 pa0,bf16x8 pa1,bf16x8 pa2,bf16x8 pa3){
  #pragma unroll
  for(int d0=0;d0<2;++d0){s16x4 lo[4],hi[4];
    #pragma unroll
    for(int ks=0;ks<4;++ks){
      asm volatile("ds_read_b64_tr_b16 %0,%1 offset:%c2":"=&v"(lo[ks]):"v"(vb),"i"(d0*4096+ks*1024):"memory");
      asm volatile("ds_read_b64_tr_b16 %0,%1 offset:%c2":"=&v"(hi[ks]):"v"(vb),"i"(d0*4096+ks*1024+512):"memory");}
    asm volatile("s_waitcnt lgkmcnt(0)":::"memory");SBAR();
    #define PK(k) (bf16x8){lo[k][0],lo[k][1],lo[k][2],lo[k][3],hi[k][0],hi[k][1],hi[k][2],hi[k][3]}
    o[d0]=__builtin_amdgcn_mfma_f32_32x32x16_bf16(pa0,PK(0),o[d0],0,0,0);
    o[d0]=__builtin_amdgcn_mfma_f32_32x32x16_bf16(pa1,PK(1),o[d0],0,0,0);
    o[d0]=__builtin_amdgcn_mfma_f32_32x32x16_bf16(pa2,PK(2),o[d0],0,0,0);
    o[d0]=__builtin_amdgcn_mfma_f32_32x32x16_bf16(pa3,PK(3),o[d0],0,0,0);
    #undef PK
  }
}

#ifndef ATTN_STORE16
#define ATTN_STORE16(p,v) (*(u32x4*)(p)=(v))
#endif
template<int THRL> __device__ __forceinline__ void attn_unit(int b,int h,int qb,const bf16*Q,const bf16*__restrict__ K,const bf16*__restrict__ V,bf16*O,const float*__restrict__ BIASG,char*shm){
  int tid_=threadIdx.x; asm volatile("":"+v"(tid_)); const int tid=tid_,lane=tid&63,r32=lane&31,hi=lane>>5; const int wid=__builtin_amdgcn_readfirstlane(tid>>6);
  const long rowbase=(long)b*SEQ; const int q0=qb*QB;
  const bf16*Qw=Q+(rowbase+q0+wid*QBLK)*DM+h*D;
  const bf16*Kh=K+rowbase*DM+h*D,*Vh=V+rowbase*DM+h*D;
  const lds_cptr shm3=(lds_cptr)shm;
  const unsigned lds0=(unsigned)(uintptr_t)shm;
  float*wsf=(float*)(shm+LDS_WS)+wid*64;
  const bf16*ksrc=Kh+(long)lane*DM+wid*8;
  const bf16*vsrc=Vh+(long)(16*(wid&3)+(lane>>2))*DM+(wid>>2)*32+(lane&3)*8;
  const unsigned kdst=lds0+LDS_K+wid*1024, vdst=lds0+LDS_V+wid*1024;
  #define DMA_K(t,slot) glds16(ksrc+(long)(t)*KVBLK*DM,(unsigned)__builtin_amdgcn_readfirstlane(kdst+(slot)))
  #define DMA_V(t,slot) glds16(vsrc+(long)(t)*KVBLK*DM,(unsigned)__builtin_amdgcn_readfirstlane(vdst+(slot)))
  const int vb0=(int)(lds0+LDS_V)+((lane>>4)&1)*32+(lane&3)*8+(4*hi+((lane&15)>>2))*64;
  const char*Kbase=shm+LDS_K; bf16x8 kf[8];
  const lds_cptr kp0=shm3+LDS_K+hi*1024+r32*16; const lds_cptr vp0=shm3+LDS_V+((lane>>4)&1)*32+(lane&3)*8+(4*hi+((lane&15)>>2))*64;
  const int NT=(q0+QB)/KVBLK;
  const __attribute__((address_space(3))) float*biasl=(const __attribute__((address_space(3))) float*)(shm3+LDS_BIAS)+4*hi;
  #define ADDB(P0,P1,t) do{ const __attribute__((address_space(3))) float*bp_=biasl+64*(t); \
    _Pragma("unroll") for(int j_=0;j_<4;++j_){ const f32x4_t b0_=*(const __attribute__((address_space(3))) f32x4_t*)(bp_+8*j_), b1_=*(const __attribute__((address_space(3))) f32x4_t*)(bp_+32+8*j_); \
      _Pragma("unroll") for(int e_=0;e_<4;++e_){ P0[4*j_+e_]+=b0_[e_]; P1[4*j_+e_]+=b1_[e_]; } } }while(0)
  DMA_K(0,0);DMA_V(0,0);DMA_K(1,SLOTB);
  bf16x8 qr[4];
  #pragma unroll
  for(int d0=0;d0<4;++d0)qr[d0]=*reinterpret_cast<const bf16x8*>(&Qw[(long)r32*DM+d0*16+hi*8]);
  float mhat=0.f,l_reg=0.f;f32x16 o[2];o[0]=f32x16{};o[1]=f32x16{};f32x16 negm=f32x16{};asm volatile("":"+v"(negm));
  const int qrel=wid*QBLK+r32;
  #define CMASK(P0,P1,t) do{int jb_=(t)-(NT-4); if(jb_>=0)cmask(P0,P1,jb_,qrel,hi);}while(0)
  bool resc=false;
  #define START(P0,P1) do{ const float rm=rowmax(P0,P1); resc=false; \
    { const float dl=rm; mhat=fadd_s(mhat,dl); \
      _Pragma("unroll") for(int r=0;r<16;++r){P0[r]=fsub_s(P0[r],dl);P1[r]=fsub_s(P1[r],dl);} \
      _Pragma("unroll") for(int r=0;r<16;++r)negm[r]=-mhat; asm volatile("":"+v"(negm)); } \
    _Pragma("unroll") for(int r=0;r<16;++r)P0[r]=__builtin_amdgcn_exp2f(P0[r]); }while(0)
  #define RESC() do{ if(resc){ asm volatile("s_waitcnt lgkmcnt(0)":::"memory"); \
      _Pragma("unroll") for(int d_=0;d_<2;++d_) _Pragma("unroll") for(int r=0;r<16;++r)o[d_][r]*=wsf[crow(r,hi)]; } }while(0)
  f32x16 pA0,pA1,pB0,pB1;
  int sl_prev=0,sl_cur=0,sl_next=SLOTB;
  #define ROT() do{sl_prev=sl_cur;sl_cur=sl_next;sl_next=(sl_next==(NSLOT-1)*SLOTB)?0:sl_next+SLOTB;}while(0)
  DMA_K(2,2*SLOTB);
  { const float*gb=BIASG+(long)(b*NHEAD+h)*SEQ; __attribute__((address_space(3))) float*bl=(__attribute__((address_space(3))) float*)(shm3+LDS_BIAS);
    for(int i=tid*4;i<q0+QB;i+=NW*64*4){ const f32x4_t v=*(const f32x4_t*)(gb+i); *(__attribute__((address_space(3))) f32x4_t*)(bl+i)=v; } }
  WAIT_BAR(3);
  qkt(pA0,pA1,Kbase,qr,negm,r32,hi);asm volatile("s_nop 15\n\ts_nop 7":"+v"(pA0),"+v"(pA1));ADDB(pA0,pA1,0);CMASK(pA0,pA1,0);
  START(pA0,pA1);
  _Pragma("unroll") for(int r=0;r<16;++r)pA1[r]=__builtin_amdgcn_exp2f(pA1[r]);
  WAIT_BAR(0);
  DMA_K(3,0);DMA_V(1,SLOTB);
  ROT();
  kload8(kf,kp0+sl_cur);
  WAIT_BAR(2);
  s16x4 vlo[8],vhi[8]; u32x4 pw0,pw1,pw2,pw3;
  #define PKW(P,B) cvtpk_s(P[B],P[B+1])
  #define PAF(k) __builtin_bit_cast(bf16x8,pw##k)
  #define VFR(i) (bf16x8){vlo[i][0],vlo[i][1],vlo[i][2],vlo[i][3],vhi[i][0],vhi[i][1],vhi[i][2],vhi[i][3]}
  #define PIN(x) asm volatile("":"+v"(x))
  #define MX3(a,b,c) __builtin_fmaxf(__builtin_fmaxf((a),(b)),(c))
  #define GAPA(MF,A0,A1,A2,A3,W0,W1,PW) do{ MF; sacc+=A0; sacc+=A1; sacc+=A2; sacc+=A3; PIN(sacc); W0; W1; PIN(PW); SBAR(); }while(0)
  #define EX(v) __builtin_amdgcn_exp2f(v)
  #define GAPB(MF,X,B) do{ MF; X[B]=EX(X[B]); X[B+1]=EX(X[B+1]); X[B+2]=EX(X[B+2]); X[B+3]=EX(X[B+3]); PIN(X); SBAR(); }while(0)
  #define VRD(i) do{ vlo[i]=vtr(vp_+(((i)>>2)*4096+((i)&3)*1024)); vhi[i]=vtr(vp_+(((i)>>2)*4096+((i)&3)*1024+512)); }while(0)
  #define KRD(G,j) do{ if(G){ kload2(kf,kp0+sl_next,j); SBAR(); } }while(0)
  #define LDB4(off) (*(const __attribute__((address_space(3))) f32x4_t*)(bp_+(off)))
  #define BL0(t) do{ const __attribute__((address_space(3))) float*bp_=biasl+64*(t); bA0=LDB4(0); bA1=LDB4(8); bA2=LDB4(16); bA3=LDB4(24); }while(0)
  #define BL1(t) do{ const __attribute__((address_space(3))) float*bp_=biasl+64*(t); bB0=LDB4(32); bB1=LDB4(40); bB2=LDB4(48); bB3=LDB4(56); }while(0)
  #define BADD(C0,C1) do{ _Pragma("unroll") for(int e_=0;e_<4;++e_){ C0[e_]+=bA0[e_]; C0[4+e_]+=bA1[e_]; C0[8+e_]+=bA2[e_]; C0[12+e_]+=bA3[e_]; C1[e_]+=bB0[e_]; C1[4+e_]+=bB1[e_]; C1[8+e_]+=bB2[e_]; C1[12+e_]+=bB3[e_]; } }while(0)
  #define STEP(C0,C1,P0,P1,t,GK,GV,GL) do{ SBAR(); f32x4_t bA0,bA1,bA2,bA3,bB0,bB1,bB2,bB3; \
    const lds_cptr vp_=vp0+sl_prev; \
    VRD(0); SBAR(); float sacc=(P0[0]+P0[1]); \
    GAPA(C0=__builtin_amdgcn_mfma_f32_32x32x16_bf16(kf[0],qr[0],negm,0,0,0), P0[2],P0[3],P0[4],P0[5],     pw0[0]=PKW(P0,0), pw0[1]=PKW(P0,2), pw0); \
    VRD(4); SBAR(); GAPA(C1=__builtin_amdgcn_mfma_f32_32x32x16_bf16(kf[1],qr[0],negm,0,0,0), P0[6],P0[7],P0[8],P0[9],     pw0[2]=PKW(P0,4), pw0[3]=PKW(P0,6), pw0); \
    VRD(1); SBAR(); GAPA(C0=__builtin_amdgcn_mfma_f32_32x32x16_bf16(kf[2],qr[1],C0,0,0,0),   P0[10],P0[11],P0[12],P0[13], pw1[0]=PKW(P0,8), pw1[1]=PKW(P0,10), pw1); \
    VRD(5); SBAR(); GAPA(C1=__builtin_amdgcn_mfma_f32_32x32x16_bf16(kf[3],qr[1],C1,0,0,0),   P0[14],P0[15],P1[0],P1[1],   pw1[2]=PKW(P0,12),pw1[3]=PKW(P0,14), pw1); \
    VRD(2); SBAR(); GAPA(C0=__builtin_amdgcn_mfma_f32_32x32x16_bf16(kf[4],qr[2],C0,0,0,0),   P1[2],P1[3],P1[4],P1[5],     pw2[0]=PKW(P1,0), pw2[1]=PKW(P1,2), pw2); \
    VRD(6); SBAR(); GAPA(C1=__builtin_amdgcn_mfma_f32_32x32x16_bf16(kf[5],qr[2],C1,0,0,0),   P1[6],P1[7],P1[8],P1[9],     pw2[2]=PKW(P1,4), pw2[3]=PKW(P1,6), pw2); \
    VRD(3); SBAR(); GAPA(C0=__builtin_amdgcn_mfma_f32_32x32x16_bf16(kf[6],qr[3],C0,0,0,0),   P1[10],P1[11],P1[12],P1[13], pw3[0]=PKW(P1,8), pw3[1]=PKW(P1,10), pw3); \
    BL0(t); SBAR(); \
    VRD(7); SBAR(); GAPA(C1=__builtin_amdgcn_mfma_f32_32x32x16_bf16(kf[7],qr[3],C1,0,0,0),   P1[14],P1[15],0.f,0.f,       pw3[2]=PKW(P1,12),pw3[3]=PKW(P1,14), pw3); \
    BL1(t); SBAR(); \
    l_reg+=sacc; \
    if(GK){DMA_K((t)+3,sl_cur);} if(GV){DMA_V((t)+1,sl_next);} \
    BADD(C0,C1); CMASK(C0,C1,t); \
    { float a=MX3(C0[0],C0[1],C1[0]),b=MX3(C0[2],C0[3],C1[1]); a=MX3(a,C1[2],C1[3]); \
      _Pragma("unroll") for(int r=4;r<16;r+=4){a=MX3(a,C0[r],C0[r+1]);b=MX3(b,C0[r+2],C0[r+3]);a=MX3(a,C1[r],C1[r+1]);b=MX3(b,C1[r+2],C1[r+3]);} \
      float rm=__builtin_fmaxf(a,b); { auto rr=__builtin_amdgcn_permlane32_swap(__float_as_uint(rm),__float_as_uint(rm),false,false); rm=__builtin_fmaxf(__uint_as_float(rr[0]),__uint_as_float(rr[1])); } \
      resc=false; \
      if(__builtin_expect(__any(rm>(float)THRL),0)){ const float dl=__builtin_fmaxf(rm,0.f); mhat+=dl; \
        _Pragma("unroll") for(int r=0;r<16;++r){C0[r]-=dl;C1[r]-=dl;} \
        _Pragma("unroll") for(int r=0;r<16;++r)negm[r]=-mhat; asm volatile("":"+v"(negm)); \
        const float f=__builtin_amdgcn_exp2f(-dl); l_reg*=f; if(hi==0)wsf[r32]=f; resc=true; } } \
    SBAR(); \
    GAPB(o[0]=__builtin_amdgcn_mfma_f32_32x32x16_bf16(PAF(0),VFR(0),o[0],0,0,0), C0,0); \
    GAPB(o[1]=__builtin_amdgcn_mfma_f32_32x32x16_bf16(PAF(0),VFR(4),o[1],0,0,0), C0,4); \
    KRD(GL,0); GAPB(o[0]=__builtin_amdgcn_mfma_f32_32x32x16_bf16(PAF(1),VFR(1),o[0],0,0,0), C0,8); \
    KRD(GL,1); GAPB(o[1]=__builtin_amdgcn_mfma_f32_32x32x16_bf16(PAF(1),VFR(5),o[1],0,0,0), C0,12); \
    KRD(GL,2); GAPB(o[0]=__builtin_amdgcn_mfma_f32_32x32x16_bf16(PAF(2),VFR(2),o[0],0,0,0), C1,0); \
    KRD(GL,3); GAPB(o[1]=__builtin_amdgcn_mfma_f32_32x32x16_bf16(PAF(2),VFR(6),o[1],0,0,0), C1,4); \
    GAPB(o[0]=__builtin_amdgcn_mfma_f32_32x32x16_bf16(PAF(3),VFR(3),o[0],0,0,0), C1,8); \
    GAPB(o[1]=__builtin_amdgcn_mfma_f32_32x32x16_bf16(PAF(3),VFR(7),o[1],0,0,0), C1,12); \
    }while(0)
  int t=1;
  #undef CMASK
  #define CMASK(P0,P1,t) do{}while(0)
  for(;t+5<NT;t+=2){
    STEP(pB0,pB1,pA0,pA1,t,true,true,true);     WAIT_BAR(2); RESC(); ROT();
    STEP(pA0,pA1,pB0,pB1,t+1,true,true,true);   WAIT_BAR(2); RESC(); ROT();
  }
  #undef CMASK
  #define CMASK(P0,P1,t) do{int jb_=(t)-(NT-4); if(jb_>=0)cmask(P0,P1,jb_,qrel,hi);}while(0)
  #define ENDW(tt) do{ if((tt)+3<NT){WAIT_BAR(2);} else if((tt)+2<NT){WAIT_BAR(1);} else {WAIT_BAR(0);} }while(0)
  for(;t+1<NT;t+=2){
    STEP(pB0,pB1,pA0,pA1,t,(t+3<NT),(t+1<NT),(t+1<NT));       ENDW(t);   RESC(); ROT();
    STEP(pA0,pA1,pB0,pB1,t+1,(t+4<NT),(t+2<NT),(t+2<NT));     ENDW(t+1); RESC(); ROT();
  }
  STEP(pB0,pB1,pA0,pA1,NT-1,false,false,false); RESC();
  { float sacc=pB0[0]+pB0[1]; _Pragma("unroll") for(int r=2;r<16;++r)sacc+=pB0[r]; _Pragma("unroll") for(int r=0;r<16;++r)sacc+=pB1[r]; l_reg+=sacc;
    pw0=(u32x4){PKW(pB0,0),PKW(pB0,2),PKW(pB0,4),PKW(pB0,6)};pw1=(u32x4){PKW(pB0,8),PKW(pB0,10),PKW(pB0,12),PKW(pB0,14)};pw2=(u32x4){PKW(pB1,0),PKW(pB1,2),PKW(pB1,4),PKW(pB1,6)};pw3=(u32x4){PKW(pB1,8),PKW(pB1,10),PKW(pB1,12),PKW(pB1,14)};
    SBAR(); pv(o,vb0+sl_cur,PAF(0),PAF(1),PAF(2),PAF(3)); }
  #undef PKW
  #undef PAF
  #undef VFR
  #undef PIN
  #undef MX3
  #undef GAPA
  #undef GAPB
  #undef EX
  #undef VRD
  #undef KRD
  #undef STEP
  #undef ENDW
  {auto rr=__builtin_amdgcn_permlane32_swap(__float_as_uint(l_reg),__float_as_uint(l_reg),false,false);l_reg=__uint_as_float(rr[0])+__uint_as_float(rr[1]);}
  if(hi==0)wsf[32+r32]=l_reg;asm volatile("s_waitcnt lgkmcnt(0)":::"memory");
  float rli[16];
  #pragma unroll
  for(int r=0;r<16;++r)rli[r]=__builtin_amdgcn_rcpf(wsf[32+crow(r,hi)]);
  bf16*Ow=O+(rowbase+q0+wid*QBLK)*DM+h*D;
  { bf16*stg=(bf16*)(shm+LDS_OST)+wid*2048;
    #pragma unroll
    for(int r=0;r<16;++r){const int orow=crow(r,hi);
      #pragma unroll
      for(int d0=0;d0<2;++d0)stg[orow*64+d0*32+r32]=__float2bfloat16(o[d0][r]*rli[r]);}
    asm volatile("s_waitcnt lgkmcnt(0)":::"memory");
    #pragma unroll
    for(int i=0;i<4;++i){const int row=i*8+(lane>>3),ch=lane&7; const u32x4 v=*(const u32x4*)(stg+row*64+ch*8); ATTN_STORE16(Ow+(long)row*DM+ch*8,v);} }
  asm volatile("s_waitcnt lgkmcnt(0)\n\ts_barrier":::"memory");
  #undef ADDB
  #undef LDB4
  #undef BL0
  #undef BL1
  #undef BADD
  #undef DMA_K
  #undef DMA_V
  #undef CMASK
  #undef START
  #undef RESC
  #undef ROT
}
constexpr int ATTN_LDS_BYTES=LDS_BYTES;
struct AttnTensors { const bf16* Q; const bf16* K; const bf16* V; bf16* O; const float* BIAS; };
struct AttnUnit { int bh; int qb; };
struct StaticOrder {
  int vcu, grid;
  __device__ __forceinline__ explicit StaticOrder(int grid_,int block):vcu((grid_%8==0)?(block%8)*(grid_/8)+block/8:block),grid(grid_){}
  __device__ __forceinline__ bool next(int i,AttnUnit&u)const{ const int I=vcu+(i>>1)*grid; if(I>=BATCH*NHEAD*(NQB/2))return false; const int j=I%(NQB/2); u.bh=I/(NQB/2); u.qb=(i&1)?(NQB-1-j):j; return true; }
  __device__ __forceinline__ void a_ready(const AttnUnit&)const{}
  __device__ __forceinline__ void done(const AttnUnit&)const{}
};
template<class Sched,int THRL=64> __device__ __forceinline__ void attn_phase(char*lds,const AttnTensors&T,const Sched&S){
  AttnUnit u;
  for(int i=0;S.next(i,u);++i){ S.a_ready(u); attn_unit<THRL>(u.bh/NHEAD,u.bh%NHEAD,u.qb,T.Q,T.K,T.V,T.O,T.BIAS,lds); S.done(u); }
}
#undef SBAR
#undef WAIT_BAR
}
namespace cg = cooperative_groups;
constexpr int NWAVES = 8;
constexpr int BATCH = 16, SEQ = 4096, DMOD = 1024, DEPTH = 4, NHEADS = 8, AW = 512, SW = 512, NGRP = 32, GCH = 16, NST = 64, FF = 4096, NIN = 4104;
constexpr int M = BATCH * SEQ;
constexpr int CL = 16;
constexpr int NCR = M / CL;
constexpr int ASK = 384;
constexpr float RMS_EPS = 1e-6f;

constexpr size_t MiB = 1u << 20;
constexpr size_t WS_CTL = 0, CTL_ZERO_BYTES = 65536, WS_BARW = 16384;
constexpr int MISC_OFF = 131072 + 320;
constexpr size_t WS_WIN = 1 * MiB, WS_WUP = 9 * MiB, WS_WDN = 17 * MiB, WS_WOUT = 25 * MiB, WS_WA = 27 * MiB, WS_WB = 28 * MiB, WS_WGLU = 29 * MiB;
constexpr size_t WS_WSB = 30 * MiB, WS_WSY = 54 * MiB, WS_LPOW = 78 * MiB, SSM_W_LAYER = 6 * MiB;
constexpr size_t WS_LOGF = 79 * MiB, WS_BIAS = 81 * MiB;
constexpr size_t WS_H = 84 * MiB;
constexpr size_t WS_Q = 212 * MiB, WS_K = 276 * MiB, WS_V = 340 * MiB;
constexpr size_t WS_AS = 404 * MiB, WS_SLOC = 500 * MiB;
constexpr size_t WS_GA = 564 * MiB, WS_GB = 692 * MiB;
constexpr size_t WS_HID = 212 * MiB;
constexpr size_t WS_YB = WS_SLOC, WS_YB2 = WS_Q;
constexpr size_t WS_XB = 820 * MiB, WS_END = 948 * MiB;

constexpr int LDS_BYTES = 147456;
#define LAS __attribute__((address_space(3)))
typedef unsigned short bf16;
typedef unsigned v4u __attribute__((ext_vector_type(4)));
typedef float f32x4 __attribute__((ext_vector_type(4)));

__device__ __forceinline__ unsigned f2bf(float f) { unsigned u = __builtin_bit_cast(unsigned, f); return (u + 0x7fffu + ((u >> 16) & 1u)) >> 16; }
__device__ __forceinline__ unsigned pk2(float lo, float hi) { return f2bf(lo) | (f2bf(hi) << 16); }
__device__ __forceinline__ float wave_sum(float v, int lane) {
#pragma unroll
    for (int o = 1; o < 64; o <<= 1) v += __int_as_float(__builtin_amdgcn_ds_bpermute((lane ^ o) << 2, __float_as_int(v)));
    return v;
}
__device__ __forceinline__ void transpose_item(const float* W, int ldw, int K, int nblk, bf16* WT, int dst_row0, int src_col0, LAS float* scr, int item, int lane) {
    const int kb = item / nblk, nb = item % nblk, k0 = 64 * kb, n0 = 32 * nb;
    float vals[32];
#pragma unroll
    for (int i = 0; i < 32; ++i) { const int kk = 2 * i + (lane >> 5); vals[i] = W[(size_t)(k0 + kk) * ldw + src_col0 + n0 + (lane & 31)]; }
#pragma unroll
    for (int i = 0; i < 32; ++i) { const int kk = 2 * i + (lane >> 5); scr[kk * 33 + (lane & 31)] = vals[i]; }
    asm volatile("s_waitcnt lgkmcnt(0)" ::: "memory");
    const int c = lane & 7;
#pragma unroll
    for (int j = 0; j < 4; ++j) { const int n = (lane >> 3) + 8 * j; const LAS float* s = scr + (8 * c) * 33 + n;
        v4u o; o.x = pk2(s[0 * 33], s[1 * 33]); o.y = pk2(s[2 * 33], s[3 * 33]); o.z = pk2(s[4 * 33], s[5 * 33]); o.w = pk2(s[6 * 33], s[7 * 33]);
        *(v4u*)(WT + (size_t)(dst_row0 + n0 + n) * K + k0 + 8 * c) = o; }
    asm volatile("s_waitcnt lgkmcnt(0)" ::: "memory");
}

struct Args { const float* in[21]; float* out; unsigned char* ws; };

__device__ __forceinline__ void ssm_tables(const Args& a, int l, int g, unsigned char* ws, LAS unsigned char* lds, int tid) {
    typedef float f2 __attribute__((ext_vector_type(2)));
    LAS f2* P = (LAS f2*)lds;
    LAS f2* Qv = P + 17 * 64;
    LAS f2* Bb = Qv + 64;
    LAS f2* Cc = Bb + 64 * 16;
    LAS float* Km = (LAS float*)(Cc + 16 * 64);
    const float* lam_re = a.in[4] + (size_t)(l * NGRP + g) * NST; const float* lam_im = a.in[5] + (size_t)(l * NGRP + g) * NST;
    const float logdt = a.in[6][l * NGRP + g];
    const float* b_re = a.in[7] + (size_t)(l * NGRP + g) * NST * GCH; const float* b_im = a.in[8] + (size_t)(l * NGRP + g) * NST * GCH;
    const float* c_re = a.in[9] + (size_t)(l * NGRP + g) * GCH * NST; const float* c_im = a.in[10] + (size_t)(l * NGRP + g) * GCH * NST;
    const float* dsk = a.in[11] + (size_t)l * SW + g * GCH;
    const double dt = exp((double)logdt);
    for (int it = tid; it < 17 * 64; it += NWAVES * 64) { const int j = it >> 6, p = it & 63;
        const double ar = (double)lam_re[p] * dt, ai = (double)lam_im[p] * dt; const double mg = exp(ar * j), an = ai * j;
        const double pr = mg * cos(an), pi = mg * sin(an); P[it] = (f2){(float)pr, (float)pi};
        if (j == 1) { const double lr = lam_re[p], li = lam_im[p], nr = pr - 1.0, ni = pi, den = lr * lr + li * li;
            Qv[p] = (f2){(float)((nr * lr + ni * li) / den), (float)((ni * lr - nr * li) / den)}; } }
    __syncthreads();
    for (int it = tid; it < 1024; it += NWAVES * 64) { const int p = it >> 4; const f2 q = Qv[p]; const float br = b_re[it], bi = b_im[it];
        Bb[it] = (f2){q.x * br - q.y * bi, q.x * bi + q.y * br}; Cc[it] = (f2){c_re[it], c_im[it]}; }
    __syncthreads();
    for (int e = tid; e < 4096; e += NWAVES * 64) { const int ck = e & 15, c = (e >> 4) & 15, j = e >> 8; float s = 0.f;
        for (int p = 0; p < 64; ++p) { const f2 cc = Cc[c * 64 + p], pp = P[j * 64 + p], bb = Bb[p * 16 + ck];
            const float xr = cc.x * pp.x - cc.y * pp.y, xi = cc.x * pp.y + cc.y * pp.x; s += xr * bb.x - xi * bb.y; }
        Km[e] = s; }
    __syncthreads();
    bf16* WSB = (bf16*)(ws + WS_WSB + (size_t)l * SSM_W_LAYER) + (size_t)g * 256 * ASK; bf16* WSY = (bf16*)(ws + WS_WSY + (size_t)l * SSM_W_LAYER) + (size_t)g * 256 * ASK;
    for (int q = tid; q < 256 * 48; q += NWAVES * 64) { const int n = q / 48, k0 = (q % 48) * 8; float vy[8], vb[8];
        const int tl = n >> 4, c = n & 15;
        if (k0 < 256) { const int tk = k0 >> 4, ck0 = k0 & 15;
#pragma unroll
            for (int e = 0; e < 8; ++e) { float v = 0.f; if (tk <= tl) { v = Km[((tl - tk) * 16 + c) * 16 + ck0 + e]; if (tk == tl && ck0 + e == c) v += dsk[c]; } vy[e] = v; }
            if (n < 128) { const int p = n & 63; const f2 pw = P[(15 - tk) * 64 + p];
#pragma unroll
                for (int e = 0; e < 8; ++e) { const f2 bb = Bb[p * 16 + ck0 + e]; vb[e] = (n < 64) ? (pw.x * bb.x - pw.y * bb.y) : (pw.x * bb.y + pw.y * bb.x); } }
            else {
#pragma unroll
                for (int e = 0; e < 8; ++e) vb[e] = 0.f; }
        } else { const int p0 = (k0 - 256) & 63; const bool im = k0 >= 320;
#pragma unroll
            for (int e = 0; e < 8; ++e) { const f2 L = P[(tl + 1) * 64 + p0 + e], cc = Cc[c * 64 + p0 + e]; vy[e] = im ? -(cc.x * L.y + cc.y * L.x) : (cc.x * L.x - cc.y * L.y); vb[e] = 0.f; } }
        v4u oy, ob; oy.x = pk2(vy[0], vy[1]); oy.y = pk2(vy[2], vy[3]); oy.z = pk2(vy[4], vy[5]); oy.w = pk2(vy[6], vy[7]);
        ob.x = pk2(vb[0], vb[1]); ob.y = pk2(vb[2], vb[3]); ob.z = pk2(vb[4], vb[5]); ob.w = pk2(vb[6], vb[7]);
        *(v4u*)(WSY + (size_t)n * ASK + k0) = oy; *(v4u*)(WSB + (size_t)n * ASK + k0) = ob; }
    if (tid < 64) ((f2*)(ws + WS_LPOW))[(l * NGRP + g) * 64 + tid] = P[16 * 64 + tid];
    __syncthreads();
}

__device__ __forceinline__ float bperm(int lanesel, float v) { return __int_as_float(__builtin_amdgcn_ds_bpermute(lanesel << 2, __float_as_int(v))); }
template <bool FORGET, int R, bool F32IN>
__device__ __forceinline__ void norm_rows(const float* X, const bf16* XBr, bf16* XBw, const float* gvec, bf16* H, const float* win  , const float* bfg, float* LOGF, int gw, int NGW, int lane) {
    f32x4 gv[4];
#pragma unroll
    for (int j = 0; j < 4; ++j) gv[j] = *((const f32x4*)gvec + lane + 64 * j);
    f32x4 wf[4][4][2];
    if (FORGET) {
#pragma unroll
        for (int j = 0; j < 4; ++j)
#pragma unroll
            for (int e = 0; e < 4; ++e) { const int k = 256 * j + 4 * lane + e; const float* wp = win + (size_t)k * NIN + 1536;
                wf[j][e][0] = *(const f32x4*)wp * gv[j][e]; wf[j][e][1] = *(const f32x4*)(wp + 4) * gv[j][e]; }
    }
    const int hsel = 4 * (lane & 1) + 2 * ((lane >> 1) & 1) + ((lane >> 2) & 1);
    const float bfv = FORGET ? bfg[hsel] : 0.f;
    const bool b0 = lane & 1, b1 = lane & 2, b2 = lane & 4;
    for (int m0 = gw; m0 < M; m0 += NGW * R) {
        f32x4 v[R][4]; float s[R]; size_t mr[R]; bool ok[R];
#pragma unroll
        for (int r = 0; r < R; ++r) { const int m = m0 + r * NGW; ok[r] = m < M; mr[r] = (size_t)(ok[r] ? m : m0); }
        if constexpr (F32IN) {
#pragma unroll
            for (int r = 0; r < R; ++r) { const f32x4* xr = (const f32x4*)(X + mr[r] * DMOD) + lane;
#pragma unroll
                for (int j = 0; j < 4; ++j) v[r][j] = xr[64 * j]; }
#pragma unroll
            for (int r = 0; r < R; ++r) { unsigned long long* xw = (unsigned long long*)(XBw + mr[r] * DMOD) + lane;
#pragma unroll
                for (int j = 0; j < 4; ++j) { const unsigned lo = pk2(v[r][j].x, v[r][j].y), hi = pk2(v[r][j].z, v[r][j].w); if (ok[r]) xw[64 * j] = (unsigned long long)lo | ((unsigned long long)hi << 32);
                    v[r][j] = (f32x4){__uint_as_float(lo << 16), __uint_as_float(lo & 0xffff0000u), __uint_as_float(hi << 16), __uint_as_float(hi & 0xffff0000u)}; } }
        } else {
            unsigned long long w8[R][4];
#pragma unroll
            for (int r = 0; r < R; ++r) { const unsigned long long* xr = (const unsigned long long*)(XBr + mr[r] * DMOD) + lane;
#pragma unroll
                for (int j = 0; j < 4; ++j) w8[r][j] = xr[64 * j]; }
#pragma unroll
            for (int r = 0; r < R; ++r)
#pragma unroll
                for (int j = 0; j < 4; ++j) { const unsigned lo = (unsigned)w8[r][j], hi = (unsigned)(w8[r][j] >> 32);
                    v[r][j] = (f32x4){__uint_as_float(lo << 16), __uint_as_float(lo & 0xffff0000u), __uint_as_float(hi << 16), __uint_as_float(hi & 0xffff0000u)}; }
        }
#pragma unroll
        for (int r = 0; r < R; ++r) { float t = 0.f;
#pragma unroll
            for (int j = 0; j < 4; ++j) t += (v[r][j].x * v[r][j].x + v[r][j].y * v[r][j].y) + (v[r][j].z * v[r][j].z + v[r][j].w * v[r][j].w);
            s[r] = t; }
        f32x4 a0[R], a1[R];
        if (FORGET) {
#pragma unroll
            for (int r = 0; r < R; ++r) { a0[r] = (f32x4){0.f, 0.f, 0.f, 0.f}; a1[r] = (f32x4){0.f, 0.f, 0.f, 0.f};
#pragma unroll
                for (int j = 0; j < 4; ++j)
#pragma unroll
                    for (int e = 0; e < 4; ++e) { a0[r] += wf[j][e][0] * v[r][j][e]; a1[r] += wf[j][e][1] * v[r][j][e]; } }
        }
#pragma unroll
        for (int o = 1; o < 64; o <<= 1)
#pragma unroll
            for (int r = 0; r < R; ++r) s[r] += bperm(lane ^ o, s[r]);
        float rstd[R];
#pragma unroll
        for (int r = 0; r < R; ++r) { rstd[r] = 1.0f / sqrtf(s[r] * (1.f / DMOD) + RMS_EPS);
            unsigned long long* o8 = (unsigned long long*)(H + mr[r] * DMOD) + lane;
#pragma unroll
            for (int j = 0; j < 4; ++j) { const f32x4 h = v[r][j] * rstd[r] * gv[j]; if (ok[r]) o8[64 * j] = (unsigned long long)pk2(h.x, h.y) | ((unsigned long long)pk2(h.z, h.w) << 32); } }
        if (FORGET) {
            float t4[R][4], t2[R][2], w[R];
#pragma unroll
            for (int i = 0; i < 4; ++i)
#pragma unroll
                for (int r = 0; r < R; ++r) { const float snd = b0 ? a0[r][i] : a1[r][i], kp = b0 ? a1[r][i] : a0[r][i]; t4[r][i] = kp + bperm(lane ^ 1, snd); }
#pragma unroll
            for (int i = 0; i < 2; ++i)
#pragma unroll
                for (int r = 0; r < R; ++r) { const float snd = b1 ? t4[r][i] : t4[r][2 + i], kp = b1 ? t4[r][2 + i] : t4[r][i]; t2[r][i] = kp + bperm(lane ^ 2, snd); }
#pragma unroll
            for (int r = 0; r < R; ++r) w[r] = (b2 ? t2[r][1] : t2[r][0]) + bperm(lane ^ 4, b2 ? t2[r][0] : t2[r][1]);
#pragma unroll
            for (int o = 8; o < 64; o <<= 1)
#pragma unroll
                for (int r = 0; r < R; ++r) w[r] += bperm(lane ^ o, w[r]);
#pragma unroll
            for (int r = 0; r < R; ++r) if (lane < 8 && ok[r]) { const float z = w[r] * rstd[r] + bfv;
                const float ls = fminf(z, 0.f) - 0.6931471805599453f * __builtin_amdgcn_logf(1.0f + __builtin_amdgcn_exp2f(-fabsf(z) * 1.4426950408889634f));
                LOGF[mr[r] * 8 + hsel] = ls; }
        }
    }
}
template <int R>
__device__ __forceinline__ void norm_rows_final(const bf16* XBr, float* OUT, const float* gvec, int gw, int NGW, int lane) {
    f32x4 gv[4];
#pragma unroll
    for (int j = 0; j < 4; ++j) gv[j] = *((const f32x4*)gvec + lane + 64 * j);
    for (int m0 = gw; m0 < M; m0 += NGW * R) {
        f32x4 v[R][4]; float s[R];
#pragma unroll
        for (int r = 0; r < R; ++r) { const int m = m0 + r * NGW; const unsigned long long* xr = (const unsigned long long*)(XBr + (size_t)(m < M ? m : m0) * DMOD) + lane;
#pragma unroll
            for (int j = 0; j < 4; ++j) { const unsigned long long w = xr[64 * j]; const unsigned lo = (unsigned)w, hi = (unsigned)(w >> 32);
                v[r][j] = (f32x4){__uint_as_float(lo << 16), __uint_as_float(lo & 0xffff0000u), __uint_as_float(hi << 16), __uint_as_float(hi & 0xffff0000u)}; } }
#pragma unroll
        for (int r = 0; r < R; ++r) { float t = 0.f;
#pragma unroll
            for (int j = 0; j < 4; ++j) t += (v[r][j].x * v[r][j].x + v[r][j].y * v[r][j].y) + (v[r][j].z * v[r][j].z + v[r][j].w * v[r][j].w);
            s[r] = t; }
#pragma unroll
        for (int o = 1; o < 64; o <<= 1)
#pragma unroll
            for (int r = 0; r < R; ++r) s[r] += bperm(lane ^ o, s[r]);
#pragma unroll
        for (int r = 0; r < R; ++r) { const int m = m0 + r * NGW; if (m >= M) break;
            const float rstd = 1.0f / sqrtf(s[r] * (1.f / DMOD) + RMS_EPS); f32x4* xw = (f32x4*)(OUT + (size_t)m * DMOD) + lane;
#pragma unroll
            for (int j = 0; j < 4; ++j) xw[64 * j] = v[r][j] * rstd * gv[j]; }
    }
}

#define XB_TMO      128
#define XB_XCNT(j)  (256  + 64 * (j))
#define XB_XSUB(j)  (1280 + 64 * (j))
#define XB_XGEN(j)  (2304 + 64 * (j))
#define XB_TOP      3328
#define XB_TOPGEN   3392
#define XCD_BAR_WORDS 3456
#define XB_SPIN_CAP (1u << 18)

__device__ __forceinline__ unsigned xb_ld(unsigned* p)              { return __hip_atomic_load(p, __ATOMIC_RELAXED, __HIP_MEMORY_SCOPE_AGENT); }
__device__ __forceinline__ unsigned xb_add(unsigned* p, unsigned v) { return __hip_atomic_fetch_add(p, v, __ATOMIC_RELAXED, __HIP_MEMORY_SCOPE_AGENT); }
__device__ __forceinline__ unsigned xb_xcc_id() { return (unsigned)__builtin_amdgcn_s_getreg((3 << 11) | 20) & 0xFu; }
#define XB_SPIN(cond, bar) do { unsigned _sp = 0; while (cond) { __builtin_amdgcn_s_sleep(1); \
    if ((++_sp & 255u) == 0u) { if (xb_ld(&(bar)[XB_TMO])) break; if (_sp > XB_SPIN_CAP) { atomicAdd(&(bar)[XB_TMO], 1u); break; } } } } while (0)

struct XcdBarrier {
    unsigned* bar; unsigned x;
    volatile LAS unsigned* st;
};

__device__ __forceinline__ XcdBarrier xcd_barrier_post(unsigned* bar, volatile LAS unsigned* st) {
    XcdBarrier b; b.bar = bar; b.x = xb_xcc_id(); b.st = st;
    if (threadIdx.x == 0) (void)xb_add(&bar[XB_XCNT(b.x)], 1u);
    return b;
}
__device__ __forceinline__ void xcd_barrier_complete(unsigned* bar, unsigned x, unsigned& nloc, unsigned& nx) {
    const unsigned G = gridDim.x * gridDim.y * gridDim.z;
    unsigned sum, cnt, mine, sp = 0u;
    for (;;) {
        sum = 0u; cnt = 0u; mine = 0u;
#pragma unroll
        for (unsigned j = 0; j < 16; ++j) { const unsigned c = xb_ld(&bar[XB_XCNT(j)]); sum += c; cnt += (c > 0u) ? 1u : 0u; mine = (j == x) ? c : mine; }
        if (sum == G) break;
        __builtin_amdgcn_s_sleep(1);
        if ((++sp & 255u) == 0u) { if (xb_ld(&bar[XB_TMO])) break; if (sp > XB_SPIN_CAP) { atomicAdd(&bar[XB_TMO], 1u); break; } }
    }
    nloc = mine > 0u ? mine : 1u; nx = cnt > 0u ? cnt : 1u;
}

__device__ __forceinline__ void xcd_barrier(const XcdBarrier& b) {
    asm volatile("s_waitcnt vmcnt(0)" ::: "memory");
    __syncthreads();
    if (threadIdx.x == 0) {
        unsigned* bar = b.bar;
        __builtin_amdgcn_s_waitcnt(0);
        unsigned nloc = b.st[0], nx = b.st[1];
        if (nloc == 0u) { xcd_barrier_complete(bar, b.x, nloc, nx); b.st[0] = nloc; b.st[1] = nx; }
        const unsigned old = xb_add(&bar[XB_XSUB(b.x)], 1u);
        const unsigned gen = old / nloc;
        if (old + 1u == (gen + 1u) * nloc) {
            __builtin_amdgcn_fence(__ATOMIC_RELEASE, "agent");
            asm volatile("s_waitcnt vmcnt(0)" ::: "memory");
            const unsigned og = xb_add(&bar[XB_TOP], 1u);
            const unsigned tg = og / nx;
            if (og + 1u == (tg + 1u) * nx) xb_add(&bar[XB_TOPGEN], 1u);
            else XB_SPIN(xb_ld(&bar[XB_TOPGEN]) == tg, bar);
            __builtin_amdgcn_fence(__ATOMIC_ACQUIRE, "agent");
            xb_add(&bar[XB_XGEN(b.x)], 1u);
            asm volatile("s_waitcnt vmcnt(0)" ::: "memory");
        } else {
            XB_SPIN(xb_ld(&bar[XB_XGEN(b.x)]) == gen, bar);
            __builtin_amdgcn_fence(__ATOMIC_ACQUIRE, "agent");
            asm volatile("s_waitcnt vmcnt(0)" ::: "memory");
        }
    }
    __syncthreads();
}
#ifndef PHMASK
#define PHMASK 0xFFFF
#endif
#ifndef SMALLK_ALIGN
#define SMALLK_ALIGN true
#endif
#ifndef BIGK_ALIGN
#define BIGK_ALIGN true
#endif
#ifndef DUPMASK
#define DUPMASK 0
#endif
__global__ void __launch_bounds__(NWAVES * 64, 2) fwd_megakernel(Args args) {
    extern __shared__ __attribute__((aligned(16))) unsigned char lds[];
    cg::grid_group grid = cg::this_grid();
    {
        volatile LAS unsigned* misc = (volatile LAS unsigned*)((LAS unsigned char*)lds + MISC_OFF);
        if (threadIdx.x < 32) misc[threadIdx.x] = 0u;
        __syncthreads();
    }
    XcdBarrier xbar = xcd_barrier_post((unsigned*)(args.ws + WS_CTL + WS_BARW), (volatile LAS unsigned*)((LAS unsigned char*)lds + MISC_OFF) + 8);
    if (args.ws == nullptr) grid.sync();
    LAS unsigned char* L = (LAS unsigned char*)lds;
    const int G = gridDim.x, bx = blockIdx.x, NGW = G * NWAVES;
#define TID_OPAQUE() int tid_ = threadIdx.x; asm volatile("" : "+v"(tid_)); const int tid = tid_, lane = tid & 63, wave = __builtin_amdgcn_readfirstlane(tid >> 6), gw = bx * NWAVES + wave; (void)tid; (void)lane; (void)gw
    float* out = args.out;
#define GASP __attribute__((address_space(1)))
#define WS_OPAQUE() GASP unsigned char* ws = (GASP unsigned char*)args.ws; asm volatile("" : "+s"(ws))
#define WSP(T, off) ((T*)(GASP T*)(ws + (off)))
#define GRID_SYNC1() xcd_barrier(xbar)
#ifdef DUPSYNC
#define GRID_SYNC() do { GRID_SYNC1(); GRID_SYNC1(); } while (0)
#else
#define GRID_SYNC() GRID_SYNC1()
#endif
    { TID_OPAQUE(); WS_OPAQUE(); for (int it = bx; it < DEPTH * NGRP; it += G) ssm_tables(args, it >> 5, it & 31, (unsigned char*)ws, L, tid); }
    for (int l_ = 0; l_ < DEPTH; ++l_) {
        int l = l_; asm volatile("" : "+s"(l));
#if (PHMASK >> 0) & 1
        for (int rep_ = 0; rep_ < (int)((DUPMASK >> 0) & 1) + 1; ++rep_) {
        {
            TID_OPAQUE(); WS_OPAQUE(); bf16* Win_t = WSP(bf16, WS_WIN); bf16* Wup_t = WSP(bf16, WS_WUP); bf16* Wdn_t = WSP(bf16, WS_WDN); bf16* Wout_t = WSP(bf16, WS_WOUT);
            bf16* Wa_t = WSP(bf16, WS_WA); bf16* Wb_t = WSP(bf16, WS_WB); bf16* Wglu_t = WSP(bf16, WS_WGLU); bf16* H = WSP(bf16, WS_H); float* LOGF = WSP(float, WS_LOGF);
            LAS float* scr = (LAS float*)(L + wave * 16384);
            const float* w_in = args.in[2] + (size_t)l * DMOD * NIN; const float* w_glu = args.in[12] + (size_t)l * SW * SW;
            const float* w_a = args.in[14] + (size_t)l * AW * DMOD; const float* w_b = args.in[15] + (size_t)l * SW * DMOD; const float* w_out = args.in[16] + (size_t)l * DMOD * DMOD;
            const float* w_up = args.in[18] + (size_t)l * DMOD * FF; const float* w_dn = args.in[19] + (size_t)l * FF * DMOD;
            constexpr int I_IN = 16 * 128, I_GLU = 8 * 16, I_A = 8 * 32, I_B = 8 * 32, I_OUT = 16 * 32, I_UP = 16 * 128, I_DN = 64 * 32;
            constexpr int NITEMS = I_IN + I_GLU + I_A + I_B + I_OUT + I_UP + I_DN;
            for (int it = gw; it < NITEMS; it += NGW) {
                int r = it;
                if (r < I_IN) { const int nb = r % 128; const int sc0 = (nb >= 48) ? 8 : 0;
                    transpose_item(w_in, NIN, DMOD, 128, Win_t, 0, sc0, scr, r, lane); continue; } r -= I_IN;
                if (r < I_GLU) { transpose_item(w_glu, SW, SW, 16, Wglu_t, 0, 0, scr, r, lane); continue; } r -= I_GLU;
                if (r < I_A) { transpose_item(w_a, DMOD, AW, 32, Wa_t, 0, 0, scr, r, lane); continue; } r -= I_A;
                if (r < I_B) { transpose_item(w_b, DMOD, SW, 32, Wb_t, 0, 0, scr, r, lane); continue; } r -= I_B;
                if (r < I_OUT) { transpose_item(w_out, DMOD, DMOD, 32, Wout_t, 0, 0, scr, r, lane); continue; } r -= I_OUT;
                if (r < I_UP) { transpose_item(w_up, FF, DMOD, 128, Wup_t, 0, 0, scr, r, lane); continue; } r -= I_UP;
                transpose_item(w_dn, DMOD, FF, 32, Wdn_t, 0, 0, scr, r, lane);
            }
            if (l == 0) norm_rows<true, 2, true>(args.in[0], nullptr, WSP(bf16, WS_XB), args.in[1] + (size_t)l * DMOD, H, w_in, args.in[3] + (size_t)l * NHEADS, LOGF, gw, NGW, lane);
            else norm_rows<true, 2, false>(nullptr, WSP(bf16, WS_XB), nullptr, args.in[1] + (size_t)l * DMOD, H, w_in, args.in[3] + (size_t)l * NHEADS, LOGF, gw, NGW, lane);
        }
        }
#endif
        GRID_SYNC();
#if (PHMASK >> 1) & 1
        for (int rep_ = 0; rep_ < (int)((DUPMASK >> 1) & 1) + 1; ++rep_) {
        {
            WS_OPAQUE(); bf16* H = WSP(bf16, WS_H); bf16* Win_t = WSP(bf16, WS_WIN); bf16* Qb = WSP(bf16, WS_Q); bf16* AS = WSP(bf16, WS_AS); bf16* GA = WSP(bf16, WS_GA);
            static_assert(WS_V - WS_K == WS_K - WS_Q, "Q|K|V equally spaced");
            pg8::Gemm g{H, Win_t, M, 4096, DMOD}; pg8::StaticOrder S; S.init(M, 4096, G, bx);
            pg8::EpiInProj E{Qb, AS, GA, (size_t)(WS_K - WS_Q) / 2, (size_t)(WS_GB - WS_GA) / 2};
            pg8::gemm_phase<pg8::EpiInProj, pg8::StaticOrder, BIGK_ALIGN, true>(L, g, S, E);
        }
        }
#endif
        GRID_SYNC();
#if (PHMASK >> 2) & 1
        for (int rep_ = 0; rep_ < (int)((DUPMASK >> 2) & 1) + 1; ++rep_) {
        {
            WS_OPAQUE(); bf16* AS = WSP(bf16, WS_AS); bf16* WSB_t = WSP(bf16, WS_WSB + (size_t)l * SSM_W_LAYER); float* SLOC = WSP(float, WS_SLOC);
            pg8::Gemm g{AS, WSB_t, NGRP * NCR, NGRP * 256, ASK}; pg8::SsmOrder S{G, bx};
            pg8::EpiSsmState E{SLOC};
            pg8::gemm_phase<pg8::EpiSsmState, pg8::SsmOrder, SMALLK_ALIGN, true>(L, g, S, E);
        }
        }
#endif
#if (PHMASK >> 3) & 1
        for (int rep_ = 0; rep_ < (int)((DUPMASK >> 3) & 1) + 1; ++rep_) {
        {
            typedef float f2 __attribute__((ext_vector_type(2)));
            TID_OPAQUE(); WS_OPAQUE(); bf16* AS = WSP(bf16, WS_AS); float* SLOC = WSP(float, WS_SLOC); float* LOGF = WSP(float, WS_LOGF); float* BIAS = WSP(float, WS_BIAS);
            if ((wave & 1) == 0) {
                for (int i = 0; i * G + bx < NGRP * BATCH; ++i) { if (wave != ((2 * i) & 7)) continue; const int it = i * G + bx; const int g = it >> 4, b = it & 15;
                    const f2 l16 = WSP(const f2, WS_LPOW)[(l * NGRP + g) * 64 + lane];
                    const float* sl = SLOC + ((size_t)(g * NCR + b * 256)) * 128 + lane; bf16* as = AS + ((size_t)(g * NCR + b * 256)) * ASK + 256 + lane;
                    float sr = 0.f, si = 0.f;
                    for (int ch0 = 0; ch0 < 256; ch0 += 32) {
                        float ar[32], ai[32];
#pragma unroll
                        for (int i = 0; i < 32; ++i) { ar[i] = sl[(size_t)(ch0 + i) * 128]; ai[i] = sl[(size_t)(ch0 + i) * 128 + 64]; }
#pragma unroll
                        for (int i = 0; i < 32; ++i) { as[(size_t)(ch0 + i) * ASK] = (bf16)f2bf(sr); as[(size_t)(ch0 + i) * ASK + 64] = (bf16)f2bf(si);
                            const float nr = l16.x * sr - l16.y * si + ar[i], ni = l16.x * si + l16.y * sr + ai[i]; sr = nr; si = ni; } } }
            } else if ((gw & 3) == 1) {
                for (int sq = gw >> 2; sq < BATCH * NHEADS; sq += NGW >> 2) { const int b = sq >> 3, h = sq & 7;
                    const float* lf = LOGF + ((size_t)b * SEQ + lane * 64) * 8 + h; float tot = 0.f; float vals[64];
#pragma unroll
                    for (int i = 0; i < 64; ++i) vals[i] = lf[i * 8];
#pragma unroll
                    for (int i = 0; i < 64; ++i) tot += vals[i];
                    float incl = tot;
#pragma unroll
                    for (int o = 1; o < 64; o <<= 1) { const float t = __int_as_float(__builtin_amdgcn_ds_bpermute((lane - o) << 2, __float_as_int(incl))); if (lane >= o) incl += t; }
                    float run = incl - tot; float* bo = BIAS + (size_t)sq * SEQ + lane * 64;
#pragma unroll
                    for (int i = 0; i < 64; ++i) { run += vals[i]; bo[i] = -run * 1.4426950408889634f; } }
            }
        }
        }
#endif
        GRID_SYNC();
#if (PHMASK >> 4) & 1
        for (int rep_ = 0; rep_ < (int)((DUPMASK >> 4) & 1) + 1; ++rep_) {
        {
            WS_OPAQUE(); bf16* AS = WSP(bf16, WS_AS); bf16* WSY_t = WSP(bf16, WS_WSY + (size_t)l * SSM_W_LAYER); bf16* YB = WSP(bf16, WS_YB);
            pg8::Gemm g{AS, WSY_t, NGRP * NCR, NGRP * 256, ASK}; pg8::SsmOrder S{G, bx};
            pg8::EpiSsmY E{YB};
            pg8::gemm_phase<pg8::EpiSsmY, pg8::SsmOrder, SMALLK_ALIGN, true>(L, g, S, E);
        }
        {
            WS_OPAQUE(); bf16* Qb = WSP(bf16, WS_Q); bf16* Kb = WSP(bf16, WS_K); bf16* Vb = WSP(bf16, WS_V); float* BIAS = WSP(float, WS_BIAS);
            const attn_body::AttnTensors AT{(const attn_body::bf16*)Qb, (const attn_body::bf16*)Kb, (const attn_body::bf16*)Vb, (attn_body::bf16*)WSP(bf16, WS_H), BIAS};
            const attn_body::StaticOrder S(G, bx);
#ifndef NO_ATTN
            attn_body::attn_phase<attn_body::StaticOrder>((char*)lds, AT, S);
        }
#endif
        }
#endif
        GRID_SYNC();
#if (PHMASK >> 5) & 1
        for (int rep_ = 0; rep_ < (int)((DUPMASK >> 5) & 1) + 1; ++rep_) {
        {
            WS_OPAQUE(); bf16* YB = WSP(bf16, WS_YB); bf16* YB2 = WSP(bf16, WS_YB2); bf16* Wglu_t = WSP(bf16, WS_WGLU);
            pg8::Gemm g{YB, Wglu_t, M, SW, SW}; pg8::StaticOrder S; S.init(M, SW, G, bx);
            pg8::EpiGlu E{YB, YB2, args.in[13] + (size_t)l * SW};
            pg8::gemm_phase<pg8::EpiGlu, pg8::StaticOrder, SMALLK_ALIGN, true>(L, g, S, E);
        }
        }
#endif
#if (PHMASK >> 6) & 1
        for (int rep_ = 0; rep_ < (int)((DUPMASK >> 6) & 1) + 1; ++rep_) {
        {
            WS_OPAQUE(); bf16* Qb = WSP(bf16, WS_H)  ; bf16* Wa_t = WSP(bf16, WS_WA); bf16* GA = WSP(bf16, WS_GA); bf16* MIXED = WSP(bf16, WS_K)  ;
            pg8::Gemm g{Qb, Wa_t, M, DMOD, AW}; pg8::StaticOrder S; S.init(M, DMOD, G, bx);
            pg8::EpiGate<false> E{GA, MIXED};
            pg8::gemm_phase<pg8::EpiGate<false>, pg8::StaticOrder, SMALLK_ALIGN, true>(L, g, S, E);
        }
        }
#endif
        GRID_SYNC();
#if (PHMASK >> 7) & 1
        for (int rep_ = 0; rep_ < (int)((DUPMASK >> 7) & 1) + 1; ++rep_) {
        {
            WS_OPAQUE(); bf16* YB2 = WSP(bf16, WS_YB2); bf16* Wb_t = WSP(bf16, WS_WB); bf16* GB = WSP(bf16, WS_GB); bf16* MIXED = WSP(bf16, WS_K);
            pg8::Gemm g{YB2, Wb_t, M, DMOD, SW}; pg8::StaticOrder S; S.init(M, DMOD, G, bx);
            pg8::EpiGate<true> E{GB, rep_ ? WSP(bf16, WS_H) : MIXED};
            pg8::gemm_phase<pg8::EpiGate<true>, pg8::StaticOrder, SMALLK_ALIGN, true>(L, g, S, E);
        }
        }
#endif
        GRID_SYNC();
#if (PHMASK >> 8) & 1
        for (int rep_ = 0; rep_ < (int)((DUPMASK >> 8) & 1) + 1; ++rep_) {
        {
            WS_OPAQUE(); bf16* MIXED = WSP(bf16, WS_K); bf16* Wout_t = WSP(bf16, WS_WOUT);
            pg8::Gemm g{MIXED, Wout_t, M, DMOD, DMOD}; pg8::StaticOrder S; S.init(M, DMOD, G, bx);
            pg8::EpiResid E{rep_ ? WSP(bf16, WS_H) : WSP(bf16, WS_XB)};
            pg8::gemm_phase<pg8::EpiResid, pg8::StaticOrder, BIGK_ALIGN, true>(L, g, S, E);
        }
        }
#endif
        GRID_SYNC();
#if (PHMASK >> 9) & 1
        for (int rep_ = 0; rep_ < (int)((DUPMASK >> 9) & 1) + 1; ++rep_) {
        { TID_OPAQUE(); WS_OPAQUE(); norm_rows<false, 4, false>(nullptr, WSP(bf16, WS_XB), nullptr, args.in[17] + (size_t)l * DMOD, WSP(bf16, WS_H), nullptr, nullptr, nullptr, gw, NGW, lane); }
        }
#endif
        GRID_SYNC();
#if (PHMASK >> 10) & 1
        for (int rep_ = 0; rep_ < (int)((DUPMASK >> 10) & 1) + 1; ++rep_) {
        {
            WS_OPAQUE(); bf16* H = WSP(bf16, WS_H); bf16* Wup_t = WSP(bf16, WS_WUP); bf16* HID = WSP(bf16, WS_HID);
            pg8::Gemm g{H, Wup_t, M, FF, DMOD}; pg8::StaticOrder S; S.init(M, FF, G, bx);
            pg8::EpiRelu2 E{HID};
            pg8::gemm_phase<pg8::EpiRelu2, pg8::StaticOrder, BIGK_ALIGN, true>(L, g, S, E);
        }
        }
#endif
        GRID_SYNC();
#if (PHMASK >> 11) & 1
        for (int rep_ = 0; rep_ < (int)((DUPMASK >> 11) & 1) + 1; ++rep_) {
        {
            WS_OPAQUE(); bf16* HID = WSP(bf16, WS_HID); bf16* Wdn_t = WSP(bf16, WS_WDN);
            pg8::Gemm g{HID, Wdn_t, M, DMOD, FF}; pg8::StaticOrder S; S.init(M, DMOD, G, bx);
            pg8::EpiResid E{rep_ ? WSP(bf16, WS_H) : WSP(bf16, WS_XB)};
            pg8::gemm_phase<pg8::EpiResid, pg8::StaticOrder, BIGK_ALIGN, true>(L, g, S, E);
        }
        }
#endif
        GRID_SYNC();
    }
    { TID_OPAQUE(); WS_OPAQUE(); norm_rows_final<4>(WSP(bf16, WS_XB), out, args.in[20], gw, NGW, lane); }
}

extern "C" void kernel_launch(void* const* d_in, const int* in_sizes, int n_in, void* d_out, int out_size, void* d_ws, size_t ws_size, hipStream_t stream) {
    static int grid = 0;
    if (grid == 0) {
        if (n_in != 21 || in_sizes[0] != M * DMOD || out_size != M * DMOD || ws_size < WS_END) {
            fprintf(stderr, "kernel_launch: unexpected shapes: n_in %d in0 %d out %d ws %zu (need %zu)\n", n_in, n_in > 0 ? in_sizes[0] : -1, out_size, ws_size, (size_t)WS_END); grid = -1; return; }
        int dev = 0, cus = 0, per_cu = 0;
        hipGetDevice(&dev); hipDeviceGetAttribute(&cus, hipDeviceAttributeMultiprocessorCount, dev);
        if (hipFuncSetAttribute((const void*)fwd_megakernel, hipFuncAttributeMaxDynamicSharedMemorySize, LDS_BYTES) != hipSuccess) { fprintf(stderr, "kernel_launch: hipFuncSetAttribute failed\n"); grid = -1; return; }
        if (hipOccupancyMaxActiveBlocksPerMultiprocessor(&per_cu, (const void*)fwd_megakernel, NWAVES * 64, LDS_BYTES) != hipSuccess || per_cu < 1) per_cu = 1;
        (void)hipGetLastError();
        grid = cus * per_cu;
    }
    if (grid < 0) return;
    if (hipMemsetAsync((char*)d_ws + WS_CTL, 0, CTL_ZERO_BYTES, stream) != hipSuccess) { fprintf(stderr, "kernel_launch: hipMemsetAsync failed\n"); return; }
    Args a{};
    for (int i = 0; i < 21; ++i) a.in[i] = (const float*)d_in[i];
    a.out = (float*)d_out; a.ws = (unsigned char*)d_ws;
    void* kargs[] = {&a};
    hipError_t e = hipLaunchCooperativeKernel((const void*)fwd_megakernel, dim3(grid), dim3(NWAVES * 64), kargs, LDS_BYTES, stream);
    if (e != hipSuccess) fprintf(stderr, "cooperative launch failed: %s (grid %d)\n", hipGetErrorString(e), grid);
}
```

```cpp
#include <hip/hip_runtime.h>
#include <hip/hip_cooperative_groups.h>
#include <cstdio>
#include <cstdint>
namespace pg8 {
#define PG8_LAS __attribute__((address_space(3)))
typedef unsigned short bf16_t;
typedef short bf16x8 __attribute__((ext_vector_type(8)));
typedef float f32x4 __attribute__((ext_vector_type(4)));
typedef unsigned u32x4 __attribute__((ext_vector_type(4)));
constexpr int BM = 256, BK = 64, HALF = 128, HTB = HALF * BK * 2  , STAGE_BYTES = 8 * HTB, NXCD = 8, WGM = 8;

__host__ __device__ __forceinline__ int lds_byte(int r, int c) { const int st = (r >> 4) * 2 + (c >> 5), rr = r & 15, cc = c & 31, ob = rr * 64 + cc * 2; return st * 1024 + (ob ^ (((ob >> 9) & 1) << 5)); }
__host__ __device__ __forceinline__ void stage_rc(int b, int& R, int& C) { const int st = b / 1024, sb = b % 1024, swz = sb ^ (((sb >> 9) & 1) << 5); R = (st >> 1) * 16 + swz / 64; C = (st & 1) * 32 + (swz % 64) / 2; }
__host__ __device__ __forceinline__ int perm32(int rho) { const int n = rho >> 4, i = rho & 15; return 8 * (i >> 2) + 4 * n + (i & 3); }

struct Unit { int pm, pn; };
struct Gemm { const bf16_t* A; const bf16_t* Bt; int M, N, K; };

struct StaticOrder {
    int nM, nN, nwg, G, c;
    __host__ __device__ void init(int M, int N, int G_, int c_) { nM = M / BM; nN = N / BM; nwg = nM * nN; G = G_; c = c_; }
    __host__ __device__ bool next(int i, Unit& u) const {
        const long L = (long)i * G + c; if (L >= nwg) return false;
        int wgid = (int)L; { const int q = nwg / NXCD, r = nwg % NXCD, xcd = wgid % NXCD, off = wgid / NXCD; wgid = (xcd < r ? xcd * (q + 1) : r * (q + 1) + (xcd - r) * q) + off; }
        const int nig = WGM * nN, gid = wgid / nig, fm = gid * WGM, gsz = (nM - fm) < WGM ? (nM - fm) : WGM;
        u.pm = fm + ((wgid % nig) % gsz); u.pn = (wgid % nig) / gsz; return true;
    }
    __device__ __forceinline__ void a_ready(const Unit&) const {}
    __device__ __forceinline__ void done(const Unit&) const {}
};

typedef float f32x2c_t __attribute__((ext_vector_type(2))); typedef __bf16 bf16x2c_t __attribute__((ext_vector_type(2)));
__device__ __forceinline__ unsigned cvt_pk_bf16(float lo, float hi) { f32x2c_t v = {lo, hi}; bf16x2c_t b = __builtin_convertvector(v, bf16x2c_t); return __builtin_bit_cast(unsigned, b); }
typedef float f32x2 __attribute__((ext_vector_type(2)));
__device__ __forceinline__ f32x2 gelu_pk(f32x2 v) {
    const f32x2 av = __builtin_elementwise_abs(v), d = av * 0.2316418882f + 1.0f;
    f32x2 t; t.x = __builtin_amdgcn_rcpf(d.x); t.y = __builtin_amdgcn_rcpf(d.y);
    f32x2 q = t * 0.5307027145f + (-0.7265760135f); q = q * t + 0.7107068705f; q = q * t + (-0.142248368f); q = q * t + 0.127414796f; q = q * t;
    const f32x2 s = (v * v) * (-0.72134752044f);
    f32x2 e; e.x = __builtin_amdgcn_exp2f(s.x); e.y = __builtin_amdgcn_exp2f(s.y);
    const f32x2 m = v * (q * e), r = v - m;
    f32x2 o; o.x = v.x < 0.f ? m.x : r.x; o.y = v.y < 0.f ? m.y : r.y; return o;
}

constexpr float LOG2E = 1.4426950408889634f;
constexpr float QC2 = 0.125f * 1.4426950408889634f;
__device__ __forceinline__ float sigm(float x) { return __builtin_amdgcn_rcpf(1.0f + __builtin_amdgcn_exp2f(-x * LOG2E)); }
__device__ __forceinline__ float gelu_tanh(float x) { const float z = 1.5957691216057308f * (x + 0.044715f * x * x * x); return x * sigm(z); }
__device__ __forceinline__ u32x4 pack8(const f32x4 v0, const f32x4 v1) { u32x4 w; w.x = cvt_pk_bf16(v0[0], v0[1]); w.y = cvt_pk_bf16(v0[2], v0[3]); w.z = cvt_pk_bf16(v1[0], v1[1]); w.w = cvt_pk_bf16(v1[2], v1[3]); return w; }
__device__ __forceinline__ float bf_lo(unsigned w) { return __uint_as_float(w << 16); }
__device__ __forceinline__ float bf_hi(unsigned w) { return __uint_as_float(w & 0xffff0000u); }
#define EPI_LOOP_BEGIN \
    _Pragma("unroll") for (int ai = 0; ai < 2; ++ai) _Pragma("unroll") for (int m = 0; m < 4; ++m) { const int row = u.pm * BM + ai * HALF + wr * 64 + m * 16 + fr; \
    _Pragma("unroll") for (int bj = 0; bj < 2; ++bj) { const int ct = bj * HALF + wc * 32 + 8 * fq; f32x4 v0 = acc[ai][bj][m][0], v1 = acc[ai][bj][m][1];
#define EPI_LOOP_END } }
#define EPI_SIG(v0, v1) do { _Pragma("unroll") for (int e_ = 0; e_ < 4; ++e_) { v0[e_] = sigm(v0[e_]); v1[e_] = sigm(v1[e_]); } } while (0)

struct EpiInProj {
    static constexpr bool PERM = true, AFTER_DRAIN = false;
    bf16_t *Q, *AS, *GA; size_t qkv_stride, gate_stride;
    __device__ __forceinline__ void operator()(const f32x4 (&acc)[2][2][4][2], const Unit& u, int wr, int wc, int fr, int fq) const {
        const int pn = u.pn;
        if (pn < 6) {
            bf16_t* base = Q + (size_t)(pn >> 1) * qkv_stride; const float sc = pn < 2 ? QC2 : 1.0f; const int cb = (pn & 1) * 256;
            EPI_LOOP_BEGIN v0 = v0 * sc; v1 = v1 * sc; *(u32x4*)(base + (size_t)row * 512 + cb + ct) = pack8(v0, v1); EPI_LOOP_END
        } else if (pn < 8) {
            const int cb = (pn - 6) * 256;
            EPI_LOOP_BEGIN const int j = cb + ct; const int g = j >> 4;
                *(u32x4*)(AS + ((size_t)(g * 4096 + (row >> 4))) * 384 + (row & 15) * 16 + (j & 15)) = pack8(v0, v1); EPI_LOOP_END
        } else {
            bf16_t* base = GA + (size_t)((pn - 8) >> 2) * gate_stride; const int cb = ((pn - 8) & 3) * 256;
            EPI_LOOP_BEGIN EPI_SIG(v0, v1); *(u32x4*)(base + (size_t)row * 1024 + cb + ct) = pack8(v0, v1); EPI_LOOP_END
        }
    }
};
struct EpiSsmState {
    static constexpr bool PERM = true, AFTER_DRAIN = false;
    float* SLOC;
    __device__ __forceinline__ void operator()(const f32x4 (&acc)[2][2][4][2], const Unit& u, int wr, int wc, int fr, int fq) const {
        EPI_LOOP_BEGIN if (bj == 0) { float* d = SLOC + (size_t)row * 128 + ct; *(f32x4*)d = v0; *(f32x4*)(d + 4) = v1; } EPI_LOOP_END
    }
};
struct EpiSsmY {
    static constexpr bool PERM = true, AFTER_DRAIN = false;
    bf16_t* YB;
    __device__ __forceinline__ void operator()(const f32x4 (&acc)[2][2][4][2], const Unit& u, int wr, int wc, int fr, int fq) const {
        EPI_LOOP_BEGIN const int g = row >> 12, cr = row & 4095, tl = ct >> 4, c0 = ct & 15;
            _Pragma("unroll") for (int e = 0; e < 4; ++e) { v0[e] = gelu_tanh(v0[e]); v1[e] = gelu_tanh(v1[e]); }
            *(u32x4*)(YB + ((size_t)(cr * 16 + tl)) * 512 + g * 16 + c0) = pack8(v0, v1); EPI_LOOP_END
    }
};
#define EPI_ROW(ai, m) (u.pm * BM + (ai) * HALF + wr * 64 + (m) * 16 + fr)
#define EPI_CT(bj) ((bj) * HALF + wc * 32 + 8 * fq)
struct EpiGlu {
    static constexpr bool PERM = true, AFTER_DRAIN = false;
    const bf16_t* YB; bf16_t* O; const float* bias;
    __device__ __forceinline__ void operator()(const f32x4 (&acc)[2][2][4][2], const Unit& u, int wr, int wc, int fr, int fq) const {
        u32x4 y[2][4][2]; f32x4 bb[2][2];
        _Pragma("unroll") for (int bj = 0; bj < 2; ++bj) { const int col = u.pn * BM + EPI_CT(bj); bb[bj][0] = *(const f32x4*)(bias + col); bb[bj][1] = *(const f32x4*)(bias + col + 4); }
        _Pragma("unroll") for (int ai = 0; ai < 2; ++ai) _Pragma("unroll") for (int m = 0; m < 4; ++m) _Pragma("unroll") for (int bj = 0; bj < 2; ++bj)
            y[ai][m][bj] = *(const u32x4*)(YB + (size_t)EPI_ROW(ai, m) * 512 + u.pn * BM + EPI_CT(bj));
        _Pragma("unroll") for (int ai = 0; ai < 2; ++ai) _Pragma("unroll") for (int m = 0; m < 4; ++m) _Pragma("unroll") for (int bj = 0; bj < 2; ++bj) {
            f32x4 v0 = acc[ai][bj][m][0] + bb[bj][0], v1 = acc[ai][bj][m][1] + bb[bj][1]; const u32x4 yy = y[ai][m][bj]; EPI_SIG(v0, v1);
            v0[0] *= bf_lo(yy.x); v0[1] *= bf_hi(yy.x); v0[2] *= bf_lo(yy.y); v0[3] *= bf_hi(yy.y); v1[0] *= bf_lo(yy.z); v1[1] *= bf_hi(yy.z); v1[2] *= bf_lo(yy.w); v1[3] *= bf_hi(yy.w);
            *(u32x4*)(O + (size_t)EPI_ROW(ai, m) * 512 + u.pn * BM + EPI_CT(bj)) = pack8(v0, v1); }
    }
};
template <bool ADD> struct EpiGate {
    static constexpr bool PERM = true, AFTER_DRAIN = false;
    const bf16_t* G; bf16_t* O;
    __device__ __forceinline__ void operator()(const f32x4 (&acc)[2][2][4][2], const Unit& u, int wr, int wc, int fr, int fq) const {
        _Pragma("unroll") for (int ai = 0; ai < 2; ++ai) {
            u32x4 gt[4][2], oo[4][2];
            _Pragma("unroll") for (int m = 0; m < 4; ++m) _Pragma("unroll") for (int bj = 0; bj < 2; ++bj) { const size_t off = (size_t)EPI_ROW(ai, m) * 1024 + u.pn * BM + EPI_CT(bj);
                gt[m][bj] = *(const u32x4*)(G + off); if (ADD) oo[m][bj] = *(const u32x4*)(O + off); }
            _Pragma("unroll") for (int m = 0; m < 4; ++m) _Pragma("unroll") for (int bj = 0; bj < 2; ++bj) { const size_t off = (size_t)EPI_ROW(ai, m) * 1024 + u.pn * BM + EPI_CT(bj);
                f32x4 v0 = acc[ai][bj][m][0], v1 = acc[ai][bj][m][1]; const u32x4 g4 = gt[m][bj];
                v0[0] *= bf_lo(g4.x); v0[1] *= bf_hi(g4.x); v0[2] *= bf_lo(g4.y); v0[3] *= bf_hi(g4.y); v1[0] *= bf_lo(g4.z); v1[1] *= bf_hi(g4.z); v1[2] *= bf_lo(g4.w); v1[3] *= bf_hi(g4.w);
                if (ADD) { const u32x4 o = oo[m][bj];
                    v0[0] += bf_lo(o.x); v0[1] += bf_hi(o.x); v0[2] += bf_lo(o.y); v0[3] += bf_hi(o.y); v1[0] += bf_lo(o.z); v1[1] += bf_hi(o.z); v1[2] += bf_lo(o.w); v1[3] += bf_hi(o.w); }
                *(u32x4*)(O + off) = pack8(v0, v1); }
            asm volatile("" ::: "memory");
        }
    }
};
struct EpiResid {
    static constexpr bool PERM = true, AFTER_DRAIN = false;
    bf16_t* X;
    __device__ __forceinline__ void operator()(const f32x4 (&acc)[2][2][4][2], const Unit& u, int wr, int wc, int fr, int fq) const {
        u32x4 xo[2][4][2];
        _Pragma("unroll") for (int ai = 0; ai < 2; ++ai) _Pragma("unroll") for (int m = 0; m < 4; ++m) _Pragma("unroll") for (int bj = 0; bj < 2; ++bj)
            xo[ai][m][bj] = *(const u32x4*)(X + (size_t)EPI_ROW(ai, m) * 1024 + u.pn * BM + EPI_CT(bj));
        _Pragma("unroll") for (int ai = 0; ai < 2; ++ai) _Pragma("unroll") for (int m = 0; m < 4; ++m) _Pragma("unroll") for (int bj = 0; bj < 2; ++bj) {
            f32x4 v0 = acc[ai][bj][m][0], v1 = acc[ai][bj][m][1]; const u32x4 o = xo[ai][m][bj];
            v0[0] += bf_lo(o.x); v0[1] += bf_hi(o.x); v0[2] += bf_lo(o.y); v0[3] += bf_hi(o.y); v1[0] += bf_lo(o.z); v1[1] += bf_hi(o.z); v1[2] += bf_lo(o.w); v1[3] += bf_hi(o.w);
            *(u32x4*)(X + (size_t)EPI_ROW(ai, m) * 1024 + u.pn * BM + EPI_CT(bj)) = pack8(v0, v1); }
    }
};
struct EpiRelu2 {
    static constexpr bool PERM = true, AFTER_DRAIN = false;
    bf16_t* O;
    __device__ __forceinline__ void operator()(const f32x4 (&acc)[2][2][4][2], const Unit& u, int wr, int wc, int fr, int fq) const {
        EPI_LOOP_BEGIN _Pragma("unroll") for (int e = 0; e < 4; ++e) { const float a = fmaxf(v0[e], 0.f), b = fmaxf(v1[e], 0.f); v0[e] = a * a; v1[e] = b * b; }
            *(u32x4*)(O + (size_t)row * 4096 + u.pn * BM + ct) = pack8(v0, v1); EPI_LOOP_END
    }
};
struct SsmOrder {
    int G, c;
    __device__ __forceinline__ bool next(int i, Unit& u) const { const int L = i * G + c; if (L >= 512) return false; u.pm = L; u.pn = L >> 4; return true; }
    __device__ __forceinline__ void a_ready(const Unit&) const {}
    __device__ __forceinline__ void done(const Unit&) const {}
};

template <class Epi, class Sched, bool ALIGN_EPI = false, bool SP2 = false>
__device__ __forceinline__ void gemm_phase(PG8_LAS unsigned char* lds, const Gemm g, const Sched& S, const Epi& E) {
    int tid_ = threadIdx.x; asm volatile("" : "+v"(tid_));
    const int tid = tid_, wid = __builtin_amdgcn_readfirstlane(tid >> 6), lane = tid & 63, wr = wid >> 2, wc = wid & 3, fr = lane & 15, fq = lane >> 4;
    const int K = g.K, nt = K / BK;
    unsigned voffA[2], voffB[2];
#pragma unroll
    for (int i = 0; i < 2; ++i) { int R, C; stage_rc(tid * 16 + i * 8192, R, C); const int Rb = Epi::PERM ? ((R & ~31) + perm32(R & 31)) : R;
        voffA[i] = (unsigned)(R * K + C) * 2u; voffB[i] = (unsigned)(Rb * K + C) * 2u; }
    const size_t kstep = (size_t)(BK * 2);
    const size_t hstep = (size_t)HALF * K * 2;
    const size_t tstep = 2 * hstep;
    const unsigned ldsw = (unsigned)wid * 1024u;
    const int aoff = lds_byte(wr * 64 + fr, fq * 8), boff = lds_byte(wc * 32 + fr, fq * 8);
#define PG8_SA(b, h) (((b) * 2 + (h)) * HTB)
#define PG8_SB(b, h) ((4 + (b) * 2 + (h)) * HTB)
#define PG8_STAGE(bufoff, gbase, voff) do { _Pragma("unroll") for (int _i = 0; _i < 2; ++_i) \
        __builtin_amdgcn_global_load_lds((const unsigned*)((const char*)(gbase) + (voff)[_i]), (PG8_LAS unsigned*)(lds + (bufoff) + ldsw + _i * 8192), 16, 0, 0); } while (0)
#define PG8_LDA(dst, b, h) do { _Pragma("unroll") for (int m = 0; m < 4; ++m) _Pragma("unroll") for (int k = 0; k < 2; ++k) dst[m][k] = *(const PG8_LAS bf16x8*)(lds + PG8_SA(b, h) + aoff + m * 2048 + k * 1024); } while (0)
#define PG8_LDB(dst, b, h) do { _Pragma("unroll") for (int n = 0; n < 2; ++n) _Pragma("unroll") for (int k = 0; k < 2; ++k) dst[n][k] = *(const PG8_LAS bf16x8*)(lds + PG8_SB(b, h) + boff + n * 2048 + k * 1024); } while (0)
#define PG8_MMA(ai, bj, At, Bt) do { __builtin_amdgcn_s_setprio(1); _Pragma("unroll") for (int m = 0; m < 4; ++m) _Pragma("unroll") for (int n = 0; n < 2; ++n) _Pragma("unroll") for (int k = 0; k < 2; ++k) \
        acc[ai][bj][m][n] = __builtin_amdgcn_mfma_f32_16x16x32_bf16(Bt[n][k], At[m][k], acc[ai][bj][m][n], 0, 0, 0); __builtin_amdgcn_s_setprio(0); } while (0)
#define PG8_WAIT_V(n) asm volatile("s_waitcnt vmcnt(" #n ")" ::: "memory")
#define PG8_WAIT_L(n) asm volatile("s_waitcnt lgkmcnt(" #n ")" ::: "memory")
#define PG8_BAR __builtin_amdgcn_s_barrier()
#define PG8_SCHED __builtin_amdgcn_sched_barrier(0)
    Unit cur, nxt; int ui = 0;
    if (!S.next(0, cur)) return;
    f32x4 acc[2][2][4][2];
#pragma unroll
    for (int a = 0; a < 2; ++a)
#pragma unroll
        for (int b = 0; b < 2; ++b)
#pragma unroll
            for (int m = 0; m < 4; ++m)
#pragma unroll
                for (int n = 0; n < 2; ++n) acc[a][b][m][n] = (f32x4){0.f, 0.f, 0.f, 0.f};
    bf16x8 At[4][2], B0[2][2], B1[2][2];
    const char* cA = (const char*)g.A + (size_t)cur.pm * tstep; const char* cB = (const char*)g.Bt + (size_t)cur.pn * tstep;
    S.a_ready(cur);
    if constexpr (SP2) {
        PG8_STAGE(PG8_SB(0, 0), cB, voffB); PG8_STAGE(PG8_SB(0, 1), cB + hstep, voffB); PG8_STAGE(PG8_SA(0, 0), cA, voffA); PG8_STAGE(PG8_SA(0, 1), cA + hstep, voffA);
        if (wr == 1) PG8_BAR;
        PG8_WAIT_V(2); PG8_BAR;
        PG8_STAGE(PG8_SB(1, 0), cB + kstep, voffB); PG8_STAGE(PG8_SA(1, 0), cA + kstep, voffA); PG8_STAGE(PG8_SB(1, 1), cB + hstep + kstep, voffB);
        PG8_WAIT_V(6); PG8_BAR;
    } else {
        PG8_STAGE(PG8_SB(0, 0), cB, voffB); PG8_STAGE(PG8_SA(0, 0), cA, voffA); PG8_STAGE(PG8_SB(0, 1), cB + hstep, voffB); PG8_STAGE(PG8_SA(0, 1), cA + hstep, voffA);
        if (wr == 1) PG8_BAR;
        PG8_WAIT_V(4); PG8_BAR;
        PG8_STAGE(PG8_SB(1, 0), cB + kstep, voffB); PG8_STAGE(PG8_SA(1, 0), cA + kstep, voffA); PG8_STAGE(PG8_SB(1, 1), cB + hstep + kstep, voffB);
        PG8_WAIT_V(6); PG8_BAR;
    }
    for (;;) {
        const bool has_next = S.next(ui + 1, nxt);
        const char* nA = has_next ? (const char*)g.A + (size_t)nxt.pm * tstep : cA; const char* nB = has_next ? (const char*)g.Bt + (size_t)nxt.pn * tstep : cB;
        for (int t = 0; t < nt; t += 2) {
            const bool last = (t == nt - 2);
            const char* a1 = cA + (size_t)(t + 1) * kstep;
            const char* a2 = last ? nA : cA + (size_t)(t + 2) * kstep; const char* b2 = last ? nB : cB + (size_t)(t + 2) * kstep;
            const char* a3 = a2 + kstep; const char* b3 = b2 + kstep;
            if (last && has_next) S.a_ready(nxt);
            if constexpr (SP2) {
            PG8_LDB(B0, 0, 0); PG8_LDB(B1, 0, 1); PG8_SCHED; PG8_LDA(At, 0, 0); PG8_STAGE(PG8_SA(1, 1), a1 + hstep, voffA);
            PG8_WAIT_V(8); PG8_WAIT_L(0); PG8_BAR; PG8_MMA(0, 0, At, B0); PG8_MMA(0, 1, At, B1); PG8_BAR; PG8_SCHED;
            PG8_LDA(At, 0, 1); PG8_STAGE(PG8_SB(0, 0), b2, voffB); PG8_STAGE(PG8_SB(0, 1), b2 + hstep, voffB); PG8_STAGE(PG8_SA(0, 0), a2, voffA);
            PG8_WAIT_V(8); PG8_WAIT_L(0); PG8_BAR; PG8_MMA(1, 0, At, B0); PG8_MMA(1, 1, At, B1); PG8_BAR; PG8_SCHED;
            PG8_LDB(B0, 1, 0); PG8_LDB(B1, 1, 1); PG8_SCHED; PG8_LDA(At, 1, 0); PG8_STAGE(PG8_SA(0, 1), a2 + hstep, voffA);
            PG8_WAIT_V(8); PG8_WAIT_L(0); PG8_BAR; PG8_MMA(0, 0, At, B0); PG8_MMA(0, 1, At, B1); PG8_BAR; PG8_SCHED;
            PG8_LDA(At, 1, 1); PG8_STAGE(PG8_SB(1, 0), b3, voffB); PG8_STAGE(PG8_SB(1, 1), b3 + hstep, voffB); PG8_STAGE(PG8_SA(1, 0), a3, voffA);
            PG8_WAIT_V(8); PG8_WAIT_L(0); PG8_BAR; PG8_MMA(1, 0, At, B0); PG8_MMA(1, 1, At, B1); PG8_BAR; PG8_SCHED;
            } else {
            PG8_LDB(B0, 0, 0); PG8_SCHED; PG8_LDA(At, 0, 0); PG8_STAGE(PG8_SA(1, 1), a1 + hstep, voffA);
            PG8_WAIT_L(8); PG8_BAR; PG8_WAIT_L(0); PG8_MMA(0, 0, At, B0); PG8_BAR; PG8_SCHED;
            PG8_LDB(B1, 0, 1); PG8_STAGE(PG8_SB(0, 0), b2, voffB);
            PG8_BAR; PG8_WAIT_L(0); PG8_MMA(0, 1, At, B1); PG8_BAR;
            PG8_LDA(At, 0, 1); PG8_STAGE(PG8_SA(0, 0), a2, voffA);
            PG8_BAR; PG8_WAIT_L(0); PG8_MMA(1, 0, At, B0); PG8_BAR; PG8_SCHED;
            PG8_STAGE(PG8_SB(0, 1), b2 + hstep, voffB);
            PG8_WAIT_V(6); PG8_BAR; PG8_MMA(1, 1, At, B1); PG8_BAR;
            PG8_LDB(B0, 1, 0); PG8_SCHED; PG8_LDA(At, 1, 0); PG8_STAGE(PG8_SA(0, 1), a2 + hstep, voffA);
            PG8_WAIT_L(8); PG8_BAR; PG8_WAIT_L(0); PG8_MMA(0, 0, At, B0); PG8_BAR; PG8_SCHED;
            PG8_LDB(B1, 1, 1); PG8_STAGE(PG8_SB(1, 0), b3, voffB);
            PG8_BAR; PG8_WAIT_L(0); PG8_MMA(0, 1, At, B1); PG8_BAR;
            PG8_LDA(At, 1, 1); PG8_STAGE(PG8_SA(1, 0), a3, voffA);
            PG8_BAR; PG8_WAIT_L(0); PG8_MMA(1, 0, At, B0); PG8_BAR; PG8_SCHED;
            PG8_STAGE(PG8_SB(1, 1), b3 + hstep, voffB);
            PG8_WAIT_V(6); PG8_BAR; PG8_MMA(1, 1, At, B1); PG8_BAR;
            }
        }
        if constexpr (ALIGN_EPI) { if (wr == 0) PG8_BAR; }
        if constexpr (!Epi::AFTER_DRAIN) { E(acc, cur, wr, wc, fr, fq); S.done(cur); }
        if (!has_next) break;
#pragma unroll
        for (int a = 0; a < 2; ++a)
#pragma unroll
            for (int b = 0; b < 2; ++b)
#pragma unroll
                for (int m = 0; m < 4; ++m)
#pragma unroll
                    for (int n = 0; n < 2; ++n) acc[a][b][m][n] = (f32x4){0.f, 0.f, 0.f, 0.f};
        cur = nxt; cA = nA; cB = nB; ++ui;
        if constexpr (ALIGN_EPI) { if (wr == 1) PG8_BAR; }
    }
    PG8_WAIT_V(0);
    if constexpr (!ALIGN_EPI) { if (wr == 0) PG8_BAR; }
    PG8_BAR;
    if constexpr (Epi::AFTER_DRAIN) { E.fused(acc, cur, wr, wc, fr, fq, lds, wid, lane); S.done(cur); }
#undef PG8_SA
#undef PG8_SB
#undef PG8_STAGE
#undef PG8_LDA
#undef PG8_LDB
#undef PG8_MMA
#undef PG8_WAIT_V
#undef PG8_WAIT_L
#undef PG8_BAR
#undef PG8_SCHED
}
}
#include <hip/hip_bf16.h>
#include <cmath>
namespace attn_body {
using bf16=__hip_bfloat16;
using bf16x8=__attribute__((ext_vector_type(8)))short;
using s16x4=__attribute__((ext_vector_type(4)))short;
using f32x16=__attribute__((ext_vector_type(16)))float;
using u32x4=__attribute__((ext_vector_type(4)))unsigned;
constexpr int BATCH=16,NHEAD=8,SEQ=4096,D=64,DM=NHEAD*D;
constexpr int NW=8,QBLK=32,QB=QBLK*NW,KVBLK=64,NQB=SEQ/QB;
constexpr int ATTN_PITCH=DM, ATTN_UNIT_ROWS=QB;
__device__ __forceinline__ int crow(int r,int hi){return (r&3)+8*(r>>2)+4*hi;}
#define SBAR() __builtin_amdgcn_sched_barrier(0)
__device__ __forceinline__ void cmask(f32x16&p0,f32x16&p1,int jb,int qrel,int hi){
  const float NEG=-INFINITY; int kb=64*jb+4*hi;
  #pragma unroll
  for(int r=0;r<16;++r){int kv=kb+(r&3)+8*(r>>2); if(kv>qrel)p0[r]=NEG; if(kv+32>qrel)p1[r]=NEG;}
}

constexpr int NSLOT=3, SLOTB=8192;
constexpr int LDS_K=0, LDS_V=NSLOT*SLOTB, LDS_WS=2*NSLOT*SLOTB, LDS_OST=LDS_WS+NW*64*4, LDS_BIAS=LDS_OST+NW*4096, LDS_BYTES=LDS_BIAS+SEQ*4;
constexpr float C2=0.125f*1.4426950408889634f;
__device__ __forceinline__ void glds16(const void*gsrc,unsigned lds_dst){unsigned keep;
  asm volatile("s_mov_b32 %0, m0\n\ts_mov_b32 m0, %2\n\ts_nop 0\n\tglobal_load_lds_dwordx4 %1, off\n\ts_mov_b32 m0, %0":"=&s"(keep):"v"(gsrc),"s"(lds_dst):"memory");}
__device__ __forceinline__ float max3f(float a,float b,float c){float r;asm("v_max3_f32 %0, %1, %2, %3":"=v"(r):"v"(a),"v"(b),"v"(c));return r;}
__device__ __forceinline__ float max2f(float a,float b){float r;asm("v_max_f32_e32 %0, %1, %2":"=v"(r):"v"(a),"v"(b));return r;}
__device__ __forceinline__ float fadd_s(float a,float b){float r;asm("v_add_f32_e32 %0, %1, %2":"=v"(r):"v"(a),"v"(b));return r;}
__device__ __forceinline__ float fsub_s(float a,float b){float r;asm("v_sub_f32_e32 %0, %1, %2":"=v"(r):"v"(a),"v"(b));return r;}
typedef float f32x4_t __attribute__((ext_vector_type(4))); typedef float f32x2_t __attribute__((ext_vector_type(2))); typedef __bf16 bf16x2_t __attribute__((ext_vector_type(2)));
__device__ __forceinline__ unsigned cvtpk_s(float lo,float hi){f32x2_t v={lo,hi};bf16x2_t b=__builtin_convertvector(v,bf16x2_t);return __builtin_bit_cast(unsigned,b);}
#define WAIT_BAR(N) asm volatile("s_waitcnt vmcnt(" #N ") lgkmcnt(0)\n\ts_barrier":::"memory")

__device__ __forceinline__ void qkt(f32x16&p0,f32x16&p1,const char*Kslot,const bf16x8*qr,const f32x16&negm,int r32,int hi){
  const char*kb=Kslot+hi*1024+r32*16;
  #pragma unroll
  for(int d0=0;d0<4;++d0){
    const bf16x8 b0=*reinterpret_cast<const bf16x8*>(kb+d0*2048);
    const bf16x8 b1=*reinterpret_cast<const bf16x8*>(kb+d0*2048+512);
    if(d0==0){p0=__builtin_amdgcn_mfma_f32_32x32x16_bf16(b0,qr[0],negm,0,0,0);p1=__builtin_amdgcn_mfma_f32_32x32x16_bf16(b1,qr[0],negm,0,0,0);}
    else{p0=__builtin_amdgcn_mfma_f32_32x32x16_bf16(b0,qr[d0],p0,0,0,0);p1=__builtin_amdgcn_mfma_f32_32x32x16_bf16(b1,qr[d0],p1,0,0,0);}}
}
typedef __attribute__((address_space(3))) const char* lds_cptr;
typedef short v4i16_t __attribute__((ext_vector_type(4)));
__device__ __forceinline__ void kload8(bf16x8*kf,lds_cptr kp){
  kf[0]=*(const __attribute__((address_space(3))) bf16x8*)(kp);      kf[1]=*(const __attribute__((address_space(3))) bf16x8*)(kp+512);
  kf[2]=*(const __attribute__((address_space(3))) bf16x8*)(kp+2048); kf[3]=*(const __attribute__((address_space(3))) bf16x8*)(kp+2560);
  kf[4]=*(const __attribute__((address_space(3))) bf16x8*)(kp+4096); kf[5]=*(const __attribute__((address_space(3))) bf16x8*)(kp+4608);
  kf[6]=*(const __attribute__((address_space(3))) bf16x8*)(kp+6144); kf[7]=*(const __attribute__((address_space(3))) bf16x8*)(kp+6656);
}
__device__ __forceinline__ void kload2(bf16x8*kf,lds_cptr kp,int j){ kf[2*j]=*(const __attribute__((address_space(3))) bf16x8*)(kp+j*2048); kf[2*j+1]=*(const __attribute__((address_space(3))) bf16x8*)(kp+j*2048+512); }
__device__ __forceinline__ s16x4 vtr(lds_cptr p){ return __builtin_bit_cast(s16x4,__builtin_amdgcn_ds_read_tr16_b64_v4i16((__attribute__((address_space(3))) v4i16_t*)p)); }
__device__ __forceinline__ float rowmax(const f32x16&p0,const f32x16&p1){
  float a=max3f(p0[0],p0[1],p1[0]),b=max3f(p0[2],p0[3],p1[1]);a=max3f(a,p1[2],p1[3]);
  #pragma unroll
  for(int r=4;r<16;r+=4){a=max3f(a,p0[r],p0[r+1]);b=max3f(b,p0[r+2],p0[r+3]);a=max3f(a,p1[r],p1[r+1]);b=max3f(b,p1[r+2],p1[r+3]);}
  const float m=max2f(a,b);
  auto rr=__builtin_amdgcn_permlane32_swap(__float_as_uint(m),__float_as_uint(m),false,false);
  return max2f(__uint_as_float(rr[0]),__uint_as_float(rr[1]));
}
__device__ __forceinline__ void pv(f32x16*o,int vb,bf16x8 pa0,bf16x8 pa1,bf16x8 pa2,bf16x8 pa3){
  #pragma unroll
  for(int d0=0;d0<2;++d0){s16x4 lo[4],hi[4];
    #pragma unroll
    for(int ks=0;ks<4;++ks){
      asm volatile("ds_read_b64_tr_b16 %0,%1 offset:%c2":"=&v"(lo[ks]):"v"(vb),"i"(d0*4096+ks*1024):"memory");
      asm volatile("ds_read_b64_tr_b16 %0,%1 offset:%c2":"=&v"(hi[ks]):"v"(vb),"i"(d0*4096+ks*1024+512):"memory");}
    asm volatile("s_waitcnt lgkmcnt(0)":::"memory");SBAR();
    #define PK(k) (bf16x8){lo[k][0],lo[k][1],lo[k][2],lo[k][3],hi[k][0],hi[k][1],hi[k][2],hi[k][3]}
    o[d0]=__builtin_amdgcn_mfma_f32_32x32x16_bf16(pa0,PK(0),o[d0],0,0,0);
    o[d0]=__builtin_amdgcn_mfma_f32_32x32x16_bf16(pa1,PK(1),o[d0],0,0,0);
    o[d0]=__builtin_amdgcn_mfma_f32_32x32x16_bf16(pa2,PK(2),o[d0],0,0,0);
    o[d0]=__builtin_amdgcn_mfma_f32_32x32x16_bf16(pa3,PK(3),o[d0],0,0,0);
    #undef PK
  }
}

#ifndef ATTN_STORE16
#define ATTN_STORE16(p,v) (*(u32x4*)(p)=(v))
#endif
template<int THRL> __device__ __forceinline__ void attn_unit(int b,int h,int qb,const bf16*Q,const bf16*__restrict__ K,const bf16*__restrict__ V,bf16*O,const float*__restrict__ BIASG,char*shm){
  int tid_=threadIdx.x; asm volatile("":"+v"(tid_)); const int tid=tid_,lane=tid&63,r32=lane&31,hi=lane>>5; const int wid=__builtin_amdgcn_readfirstlane(tid>>6);
  const long rowbase=(long)b*SEQ; const int q0=qb*QB;
  const bf16*Qw=Q+(rowbase+q0+wid*QBLK)*DM+h*D;
  const bf16*Kh=K+rowbase*DM+h*D,*Vh=V+rowbase*DM+h*D;
  const lds_cptr shm3=(lds_cptr)shm;
  const unsigned lds0=(unsigned)(uintptr_t)shm;
  float*wsf=(float*)(shm+LDS_WS)+wid*64;
  const bf16*ksrc=Kh+(long)lane*DM+wid*8;
  const bf16*vsrc=Vh+(long)(16*(wid&3)+(lane>>2))*DM+(wid>>2)*32+(lane&3)*8;
  const unsigned kdst=lds0+LDS_K+wid*1024, vdst=lds0+LDS_V+wid*1024;
  #define DMA_K(t,slot) glds16(ksrc+(long)(t)*KVBLK*DM,(unsigned)__builtin_amdgcn_readfirstlane(kdst+(slot)))
  #define DMA_V(t,slot) glds16(vsrc+(long)(t)*KVBLK*DM,(unsigned)__builtin_amdgcn_readfirstlane(vdst+(slot)))
  const int vb0=(int)(lds0+LDS_V)+((lane>>4)&1)*32+(lane&3)*8+(4*hi+((lane&15)>>2))*64;
  const char*Kbase=shm+LDS_K; bf16x8 kf[8];
  const lds_cptr kp0=shm3+LDS_K+hi*1024+r32*16; const lds_cptr vp0=shm3+LDS_V+((lane>>4)&1)*32+(lane&3)*8+(4*hi+((lane&15)>>2))*64;
  const int NT=(q0+QB)/KVBLK;
  const __attribute__((address_space(3))) float*biasl=(const __attribute__((address_space(3))) float*)(shm3+LDS_BIAS)+4*hi;
  #define ADDB(P0,P1,t) do{ const __attribute__((address_space(3))) float*bp_=biasl+64*(t); \
    _Pragma("unroll") for(int j_=0;j_<4;++j_){ const f32x4_t b0_=*(const __attribute__((address_space(3))) f32x4_t*)(bp_+8*j_), b1_=*(const __attribute__((address_space(3))) f32x4_t*)(bp_+32+8*j_); \
      _Pragma("unroll") for(int e_=0;e_<4;++e_){ P0[4*j_+e_]+=b0_[e_]; P1[4*j_+e_]+=b1_[e_]; } } }while(0)
  DMA_K(0,0);DMA_V(0,0);DMA_K(1,SLOTB);
  bf16x8 qr[4];
  #pragma unroll
  for(int d0=0;d0<4;++d0)qr[d0]=*reinterpret_cast<const bf16x8*>(&Qw[(long)r32*DM+d0*16+hi*8]);
  float mhat=0.f,l_reg=0.f;f32x16 o[2];o[0]=f32x16{};o[1]=f32x16{};f32x16 negm=f32x16{};asm volatile("":"+v"(negm));
  const int qrel=wid*QBLK+r32;
  #define CMASK(P0,P1,t) do{int jb_=(t)-(NT-4); if(jb_>=0)cmask(P0,P1,jb_,qrel,hi);}while(0)
  bool resc=false;
  #define START(P0,P1) do{ const float rm=rowmax(P0,P1); resc=false; \
    { const float dl=rm; mhat=fadd_s(mhat,dl); \
      _Pragma("unroll") for(int r=0;r<16;++r){P0[r]=fsub_s(P0[r],dl);P1[r]=fsub_s(P1[r],dl);} \
      _Pragma("unroll") for(int r=0;r<16;++r)negm[r]=-mhat; asm volatile("":"+v"(negm)); } \
    _Pragma("unroll") for(int r=0;r<16;++r)P0[r]=__builtin_amdgcn_exp2f(P0[r]); }while(0)
  #define RESC() do{ if(resc){ asm volatile("s_waitcnt lgkmcnt(0)":::"memory"); \
      _Pragma("unroll") for(int d_=0;d_<2;++d_) _Pragma("unroll") for(int r=0;r<16;++r)o[d_][r]*=wsf[crow(r,hi)]; } }while(0)
  f32x16 pA0,pA1,pB0,pB1;
  int sl_prev=0,sl_cur=0,sl_next=SLOTB;
  #define ROT() do{sl_prev=sl_cur;sl_cur=sl_next;sl_next=(sl_next==(NSLOT-1)*SLOTB)?0:sl_next+SLOTB;}while(0)
  DMA_K(2,2*SLOTB);
  { const float*gb=BIASG+(long)(b*NHEAD+h)*SEQ; __attribute__((address_space(3))) float*bl=(__attribute__((address_space(3))) float*)(shm3+LDS_BIAS);
    static_assert(SEQ==2*NW*64*4,"two 16-byte pieces per thread cover the sequence");
    const int i0_=tid*4,i1_=tid*4+NW*64*4; const bool p0_=i0_<q0+QB,p1_=i1_<q0+QB;
    f32x4_t v0_={0.f,0.f,0.f,0.f},v1_={0.f,0.f,0.f,0.f}; if(p0_)v0_=*(const f32x4_t*)(gb+i0_); if(p1_)v1_=*(const f32x4_t*)(gb+i1_);
    if(p0_)*(__attribute__((address_space(3))) f32x4_t*)(bl+i0_)=v0_; if(p1_)*(__attribute__((address_space(3))) f32x4_t*)(bl+i1_)=v1_; }
  WAIT_BAR(3);
  qkt(pA0,pA1,Kbase,qr,negm,r32,hi);asm volatile("s_nop 15\n\ts_nop 7":"+v"(pA0),"+v"(pA1));ADDB(pA0,pA1,0);CMASK(pA0,pA1,0);
  START(pA0,pA1);
  _Pragma("unroll") for(int r=0;r<16;++r)pA1[r]=__builtin_amdgcn_exp2f(pA1[r]);
  WAIT_BAR(0);
  DMA_K(3,0);DMA_V(1,SLOTB);
  ROT();
  kload8(kf,kp0+sl_cur);
  WAIT_BAR(2);
  s16x4 vlo[8],vhi[8]; u32x4 pw0,pw1,pw2,pw3;
  #define PKW(P,B) cvtpk_s(P[B],P[B+1])
  #define PAF(k) __builtin_bit_cast(bf16x8,pw##k)
  #define VFR(i) (bf16x8){vlo[i][0],vlo[i][1],vlo[i][2],vlo[i][3],vhi[i][0],vhi[i][1],vhi[i][2],vhi[i][3]}
  #define PIN(x) asm volatile("":"+v"(x))
  #define MX3(a,b,c) __builtin_fmaxf(__builtin_fmaxf((a),(b)),(c))
  #define GAPA(MF,A0,A1,A2,A3,W0,W1,PW) do{ MF; sacc+=A0; sacc+=A1; sacc+=A2; sacc+=A3; PIN(sacc); W0; W1; PIN(PW); SBAR(); }while(0)
  #define EX(v) __builtin_amdgcn_exp2f(v)
  #define GAPB(MF,X,B) do{ MF; X[B]=EX(X[B]); X[B+1]=EX(X[B+1]); X[B+2]=EX(X[B+2]); X[B+3]=EX(X[B+3]); PIN(X); SBAR(); }while(0)
  #define VRD(i) do{ vlo[i]=vtr(vp_+(((i)>>2)*4096+((i)&3)*1024)); vhi[i]=vtr(vp_+(((i)>>2)*4096+((i)&3)*1024+512)); }while(0)
  #define KRD(G,j) do{ if(G){ kload2(kf,kp0+sl_next,j); SBAR(); } }while(0)
  #define LDB4(off) (*(const __attribute__((address_space(3))) f32x4_t*)(bp_+(off)))
  #define BL0(t) do{ const __attribute__((address_space(3))) float*bp_=biasl+64*(t); bA0=LDB4(0); bA1=LDB4(8); bA2=LDB4(16); bA3=LDB4(24); }while(0)
  #define BL1(t) do{ const __attribute__((address_space(3))) float*bp_=biasl+64*(t); bB0=LDB4(32); bB1=LDB4(40); bB2=LDB4(48); bB3=LDB4(56); }while(0)
  #define BADD(C0,C1) do{ _Pragma("unroll") for(int e_=0;e_<4;++e_){ C0[e_]+=bA0[e_]; C0[4+e_]+=bA1[e_]; C0[8+e_]+=bA2[e_]; C0[12+e_]+=bA3[e_]; C1[e_]+=bB0[e_]; C1[4+e_]+=bB1[e_]; C1[8+e_]+=bB2[e_]; C1[12+e_]+=bB3[e_]; } }while(0)
  #define STEP(C0,C1,P0,P1,t,GK,GV,GL) do{ SBAR(); f32x4_t bA0,bA1,bA2,bA3,bB0,bB1,bB2,bB3; \
    const lds_cptr vp_=vp0+sl_prev; \
    VRD(0); SBAR(); float sacc=(P0[0]+P0[1]); \
    GAPA(C0=__builtin_amdgcn_mfma_f32_32x32x16_bf16(kf[0],qr[0],negm,0,0,0), P0[2],P0[3],P0[4],P0[5],     pw0[0]=PKW(P0,0), pw0[1]=PKW(P0,2), pw0); \
    VRD(4); SBAR(); GAPA(C1=__builtin_amdgcn_mfma_f32_32x32x16_bf16(kf[1],qr[0],negm,0,0,0), P0[6],P0[7],P0[8],P0[9],     pw0[2]=PKW(P0,4), pw0[3]=PKW(P0,6), pw0); \
    VRD(1); SBAR(); GAPA(C0=__builtin_amdgcn_mfma_f32_32x32x16_bf16(kf[2],qr[1],C0,0,0,0),   P0[10],P0[11],P0[12],P0[13], pw1[0]=PKW(P0,8), pw1[1]=PKW(P0,10), pw1); \
    VRD(5); SBAR(); GAPA(C1=__builtin_amdgcn_mfma_f32_32x32x16_bf16(kf[3],qr[1],C1,0,0,0),   P0[14],P0[15],P1[0],P1[1],   pw1[2]=PKW(P0,12),pw1[3]=PKW(P0,14), pw1); \
    VRD(2); SBAR(); GAPA(C0=__builtin_amdgcn_mfma_f32_32x32x16_bf16(kf[4],qr[2],C0,0,0,0),   P1[2],P1[3],P1[4],P1[5],     pw2[0]=PKW(P1,0), pw2[1]=PKW(P1,2), pw2); \
    VRD(6); SBAR(); GAPA(C1=__builtin_amdgcn_mfma_f32_32x32x16_bf16(kf[5],qr[2],C1,0,0,0),   P1[6],P1[7],P1[8],P1[9],     pw2[2]=PKW(P1,4), pw2[3]=PKW(P1,6), pw2); \
    VRD(3); SBAR(); GAPA(C0=__builtin_amdgcn_mfma_f32_32x32x16_bf16(kf[6],qr[3],C0,0,0,0),   P1[10],P1[11],P1[12],P1[13], pw3[0]=PKW(P1,8), pw3[1]=PKW(P1,10), pw3); \
    BL0(t); SBAR(); \
    VRD(7); SBAR(); GAPA(C1=__builtin_amdgcn_mfma_f32_32x32x16_bf16(kf[7],qr[3],C1,0,0,0),   P1[14],P1[15],0.f,0.f,       pw3[2]=PKW(P1,12),pw3[3]=PKW(P1,14), pw3); \
    BL1(t); SBAR(); \
    l_reg+=sacc; \
    if(GK){DMA_K((t)+3,sl_cur);} if(GV){DMA_V((t)+1,sl_next);} \
    BADD(C0,C1); CMASK(C0,C1,t); \
    { float a=MX3(C0[0],C0[1],C1[0]),b=MX3(C0[2],C0[3],C1[1]); a=MX3(a,C1[2],C1[3]); \
      _Pragma("unroll") for(int r=4;r<16;r+=4){a=MX3(a,C0[r],C0[r+1]);b=MX3(b,C0[r+2],C0[r+3]);a=MX3(a,C1[r],C1[r+1]);b=MX3(b,C1[r+2],C1[r+3]);} \
      float rm=__builtin_fmaxf(a,b); { auto rr=__builtin_amdgcn_permlane32_swap(__float_as_uint(rm),__float_as_uint(rm),false,false); rm=__builtin_fmaxf(__uint_as_float(rr[0]),__uint_as_float(rr[1])); } \
      resc=false; \
      if(__builtin_expect(__any(rm>(float)THRL),0)){ const float dl=__builtin_fmaxf(rm,0.f); mhat+=dl; \
        _Pragma("unroll") for(int r=0;r<16;++r){C0[r]-=dl;C1[r]-=dl;} \
        _Pragma("unroll") for(int r=0;r<16;++r)negm[r]=-mhat; asm volatile("":"+v"(negm)); \
        const float f=__builtin_amdgcn_exp2f(-dl); l_reg*=f; if(hi==0)wsf[r32]=f; resc=true; } } \
    SBAR(); \
    GAPB(o[0]=__builtin_amdgcn_mfma_f32_32x32x16_bf16(PAF(0),VFR(0),o[0],0,0,0), C0,0); \
    GAPB(o[1]=__builtin_amdgcn_mfma_f32_32x32x16_bf16(PAF(0),VFR(4),o[1],0,0,0), C0,4); \
    KRD(GL,0); GAPB(o[0]=__builtin_amdgcn_mfma_f32_32x32x16_bf16(PAF(1),VFR(1),o[0],0,0,0), C0,8); \
    KRD(GL,1); GAPB(o[1]=__builtin_amdgcn_mfma_f32_32x32x16_bf16(PAF(1),VFR(5),o[1],0,0,0), C0,12); \
    KRD(GL,2); GAPB(o[0]=__builtin_amdgcn_mfma_f32_32x32x16_bf16(PAF(2),VFR(2),o[0],0,0,0), C1,0); \
    KRD(GL,3); GAPB(o[1]=__builtin_amdgcn_mfma_f32_32x32x16_bf16(PAF(2),VFR(6),o[1],0,0,0), C1,4); \
    GAPB(o[0]=__builtin_amdgcn_mfma_f32_32x32x16_bf16(PAF(3),VFR(3),o[0],0,0,0), C1,8); \
    GAPB(o[1]=__builtin_amdgcn_mfma_f32_32x32x16_bf16(PAF(3),VFR(7),o[1],0,0,0), C1,12); \
    }while(0)
  int t=1;
  #undef CMASK
  #define CMASK(P0,P1,t) do{}while(0)
  for(;t+5<NT;t+=2){
    STEP(pB0,pB1,pA0,pA1,t,true,true,true);     WAIT_BAR(2); RESC(); ROT();
    STEP(pA0,pA1,pB0,pB1,t+1,true,true,true);   WAIT_BAR(2); RESC(); ROT();
  }
  #undef CMASK
  #define CMASK(P0,P1,t) do{int jb_=(t)-(NT-4); if(jb_>=0)cmask(P0,P1,jb_,qrel,hi);}while(0)
  #define ENDW(tt) do{ if((tt)+3<NT){WAIT_BAR(2);} else if((tt)+2<NT){WAIT_BAR(1);} else {WAIT_BAR(0);} }while(0)
  for(;t+1<NT;t+=2){
    STEP(pB0,pB1,pA0,pA1,t,(t+3<NT),(t+1<NT),(t+1<NT));       ENDW(t);   RESC(); ROT();
    STEP(pA0,pA1,pB0,pB1,t+1,(t+4<NT),(t+2<NT),(t+2<NT));     ENDW(t+1); RESC(); ROT();
  }
  STEP(pB0,pB1,pA0,pA1,NT-1,false,false,false); RESC();
  { float sacc=pB0[0]+pB0[1]; _Pragma("unroll") for(int r=2;r<16;++r)sacc+=pB0[r]; _Pragma("unroll") for(int r=0;r<16;++r)sacc+=pB1[r]; l_reg+=sacc;
    pw0=(u32x4){PKW(pB0,0),PKW(pB0,2),PKW(pB0,4),PKW(pB0,6)};pw1=(u32x4){PKW(pB0,8),PKW(pB0,10),PKW(pB0,12),PKW(pB0,14)};pw2=(u32x4){PKW(pB1,0),PKW(pB1,2),PKW(pB1,4),PKW(pB1,6)};pw3=(u32x4){PKW(pB1,8),PKW(pB1,10),PKW(pB1,12),PKW(pB1,14)};
    SBAR(); pv(o,vb0+sl_cur,PAF(0),PAF(1),PAF(2),PAF(3)); }
  #undef PKW
  #undef PAF
  #undef VFR
  #undef PIN
  #undef MX3
  #undef GAPA
  #undef GAPB
  #undef EX
  #undef VRD
  #undef KRD
  #undef STEP
  #undef ENDW
  {auto rr=__builtin_amdgcn_permlane32_swap(__float_as_uint(l_reg),__float_as_uint(l_reg),false,false);l_reg=__uint_as_float(rr[0])+__uint_as_float(rr[1]);}
  if(hi==0)wsf[32+r32]=l_reg;asm volatile("s_waitcnt lgkmcnt(0)":::"memory");
  float rli[16];
  #pragma unroll
  for(int r=0;r<16;++r)rli[r]=__builtin_amdgcn_rcpf(wsf[32+crow(r,hi)]);
  bf16*Ow=O+(rowbase+q0+wid*QBLK)*DM+h*D;
  { bf16*stg=(bf16*)(shm+LDS_OST)+wid*2048;
    #pragma unroll
    for(int r=0;r<16;++r){const int orow=crow(r,hi);
      #pragma unroll
      for(int d0=0;d0<2;++d0)stg[orow*64+d0*32+r32]=__float2bfloat16(o[d0][r]*rli[r]);}
    asm volatile("s_waitcnt lgkmcnt(0)":::"memory");
    #pragma unroll
    for(int i=0;i<4;++i){const int row=i*8+(lane>>3),ch=lane&7; const u32x4 v=*(const u32x4*)(stg+row*64+ch*8); ATTN_STORE16(Ow+(long)row*DM+ch*8,v);} }
  asm volatile("s_waitcnt lgkmcnt(0)\n\ts_barrier":::"memory");
  #undef ADDB
  #undef LDB4
  #undef BL0
  #undef BL1
  #undef BADD
  #undef DMA_K
  #undef DMA_V
  #undef CMASK
  #undef START
  #undef RESC
  #undef ROT
}
constexpr int ATTN_LDS_BYTES=LDS_BYTES;
struct AttnTensors { const bf16* Q; const bf16* K; const bf16* V; bf16* O; const float* BIAS; };
struct AttnUnit { int bh; int qb; };
struct StaticOrder {
  int vcu, grid;
  __device__ __forceinline__ explicit StaticOrder(int grid_,int block):vcu((grid_%8==0)?(block%8)*(grid_/8)+block/8:block),grid(grid_){}
  __device__ __forceinline__ bool next(int i,AttnUnit&u)const{ const int I=vcu+(i>>1)*grid; if(I>=BATCH*NHEAD*(NQB/2))return false; const int j=I%(NQB/2); u.bh=I/(NQB/2); u.qb=(i&1)?(NQB-1-j):j; return true; }
  __device__ __forceinline__ void a_ready(const AttnUnit&)const{}
  __device__ __forceinline__ void done(const AttnUnit&)const{}
};
template<class Sched,int THRL=64> __device__ __forceinline__ void attn_phase(char*lds,const AttnTensors&T,const Sched&S){
  AttnUnit u;
  for(int i=0;S.next(i,u);++i){ S.a_ready(u); attn_unit<THRL>(u.bh/NHEAD,u.bh%NHEAD,u.qb,T.Q,T.K,T.V,T.O,T.BIAS,lds); S.done(u); }
}
#undef SBAR
#undef WAIT_BAR
}
namespace cg = cooperative_groups;
constexpr int NWAVES = 8;
constexpr int BATCH = 16, SEQ = 4096, DMOD = 1024, DEPTH = 4, NHEADS = 8, AW = 512, SW = 512, NGRP = 32, GCH = 16, NST = 64, FF = 4096, NIN = 4104;
constexpr int M = BATCH * SEQ;
constexpr int CL = 16;
constexpr int NCR = M / CL;
constexpr int ASK = 384;
constexpr float RMS_EPS = 1e-6f;

constexpr size_t MiB = 1u << 20;
constexpr size_t WS_CTL = 0, CTL_ZERO_BYTES = 65536, WS_BARW = 16384;
constexpr int MISC_OFF = 131072 + 320;
constexpr size_t WS_WIN = 1 * MiB, WS_WUP = 9 * MiB, WS_WDN = 17 * MiB, WS_WOUT = 25 * MiB, WS_WA = 27 * MiB, WS_WB = 28 * MiB, WS_WGLU = 29 * MiB;
constexpr size_t WS_WSB = 30 * MiB, WS_WSY = 54 * MiB, WS_LPOW = 78 * MiB, SSM_W_LAYER = 6 * MiB;
constexpr size_t WS_LOGF = 79 * MiB, WS_BIAS = 81 * MiB;
constexpr size_t WS_H = 84 * MiB;
constexpr size_t WS_Q = 212 * MiB, WS_K = 276 * MiB, WS_V = 340 * MiB;
constexpr size_t WS_AS = 404 * MiB, WS_SLOC = 500 * MiB;
constexpr size_t WS_GA = 564 * MiB, WS_GB = 692 * MiB;
constexpr size_t WS_HID = 212 * MiB;
constexpr size_t WS_YB = WS_SLOC, WS_YB2 = WS_Q;
constexpr size_t WS_XB = 820 * MiB, WS_END = 948 * MiB;

constexpr int LDS_BYTES = 147456;
#define LAS __attribute__((address_space(3)))
typedef unsigned short bf16;
typedef unsigned v4u __attribute__((ext_vector_type(4)));
typedef float f32x4 __attribute__((ext_vector_type(4)));

__device__ __forceinline__ unsigned f2bf(float f) { unsigned u = __builtin_bit_cast(unsigned, f); return (u + 0x7fffu + ((u >> 16) & 1u)) >> 16; }
__device__ __forceinline__ unsigned pk2(float lo, float hi) { return f2bf(lo) | (f2bf(hi) << 16); }
__device__ __forceinline__ float wave_sum(float v, int lane) {
#pragma unroll
    for (int o = 1; o < 64; o <<= 1) v += __int_as_float(__builtin_amdgcn_ds_bpermute((lane ^ o) << 2, __float_as_int(v)));
    return v;
}
__device__ __forceinline__ void transpose_item(const float* W, int ldw, int K, int nblk, bf16* WT, int dst_row0, int src_col0, LAS float* scr, int item, int lane) {
    const int kb = item / nblk, nb = item % nblk, k0 = 64 * kb, n0 = 32 * nb;
    float vals[32];
#pragma unroll
    for (int i = 0; i < 32; ++i) { const int kk = 2 * i + (lane >> 5); vals[i] = W[(size_t)(k0 + kk) * ldw + src_col0 + n0 + (lane & 31)]; }
#pragma unroll
    for (int i = 0; i < 32; ++i) { const int kk = 2 * i + (lane >> 5); scr[kk * 33 + (lane & 31)] = vals[i]; }
    asm volatile("s_waitcnt lgkmcnt(0)" ::: "memory");
    const int c = lane & 7;
#pragma unroll
    for (int j = 0; j < 4; ++j) { const int n = (lane >> 3) + 8 * j; const LAS float* s = scr + (8 * c) * 33 + n;
        v4u o; o.x = pk2(s[0 * 33], s[1 * 33]); o.y = pk2(s[2 * 33], s[3 * 33]); o.z = pk2(s[4 * 33], s[5 * 33]); o.w = pk2(s[6 * 33], s[7 * 33]);
        *(v4u*)(WT + (size_t)(dst_row0 + n0 + n) * K + k0 + 8 * c) = o; }
    asm volatile("s_waitcnt lgkmcnt(0)" ::: "memory");
}

struct Args { const float* in[21]; float* out; unsigned char* ws; };

__device__ __forceinline__ void ssm_tables(const Args& a, int l, int g, unsigned char* ws, LAS unsigned char* lds, int tid) {
    typedef float f2 __attribute__((ext_vector_type(2)));
    LAS f2* P = (LAS f2*)lds;
    LAS f2* Qv = P + 17 * 64;
    LAS f2* Bb = Qv + 64;
    LAS f2* Cc = Bb + 64 * 16;
    LAS float* Km = (LAS float*)(Cc + 16 * 64);
    const float* lam_re = a.in[4] + (size_t)(l * NGRP + g) * NST; const float* lam_im = a.in[5] + (size_t)(l * NGRP + g) * NST;
    const float logdt = a.in[6][l * NGRP + g];
    const float* b_re = a.in[7] + (size_t)(l * NGRP + g) * NST * GCH; const float* b_im = a.in[8] + (size_t)(l * NGRP + g) * NST * GCH;
    const float* c_re = a.in[9] + (size_t)(l * NGRP + g) * GCH * NST; const float* c_im = a.in[10] + (size_t)(l * NGRP + g) * GCH * NST;
    const float* dsk = a.in[11] + (size_t)l * SW + g * GCH;
    const double dt = exp((double)logdt);
    for (int it = tid; it < 17 * 64; it += NWAVES * 64) { const int j = it >> 6, p = it & 63;
        const double ar = (double)lam_re[p] * dt, ai = (double)lam_im[p] * dt; const double mg = exp(ar * j), an = ai * j;
        const double pr = mg * cos(an), pi = mg * sin(an); P[it] = (f2){(float)pr, (float)pi};
        if (j == 1) { const double lr = lam_re[p], li = lam_im[p], nr = pr - 1.0, ni = pi, den = lr * lr + li * li;
            Qv[p] = (f2){(float)((nr * lr + ni * li) / den), (float)((ni * lr - nr * li) / den)}; } }
    __syncthreads();
    for (int it = tid; it < 1024; it += NWAVES * 64) { const int p = it >> 4; const f2 q = Qv[p]; const float br = b_re[it], bi = b_im[it];
        Bb[it] = (f2){q.x * br - q.y * bi, q.x * bi + q.y * br}; Cc[it] = (f2){c_re[it], c_im[it]}; }
    __syncthreads();
    for (int e = tid; e < 4096; e += NWAVES * 64) { const int ck = e & 15, c = (e >> 4) & 15, j = e >> 8; float s = 0.f;
        for (int p = 0; p < 64; ++p) { const f2 cc = Cc[c * 64 + p], pp = P[j * 64 + p], bb = Bb[p * 16 + ck];
            const float xr = cc.x * pp.x - cc.y * pp.y, xi = cc.x * pp.y + cc.y * pp.x; s += xr * bb.x - xi * bb.y; }
        Km[e] = s; }
    __syncthreads();
    bf16* WSB = (bf16*)(ws + WS_WSB + (size_t)l * SSM_W_LAYER) + (size_t)g * 256 * ASK; bf16* WSY = (bf16*)(ws + WS_WSY + (size_t)l * SSM_W_LAYER) + (size_t)g * 256 * ASK;
    for (int q = tid; q < 256 * 48; q += NWAVES * 64) { const int n = q / 48, k0 = (q % 48) * 8; float vy[8], vb[8];
        const int tl = n >> 4, c = n & 15;
        if (k0 < 256) { const int tk = k0 >> 4, ck0 = k0 & 15;
#pragma unroll
            for (int e = 0; e < 8; ++e) { float v = 0.f; if (tk <= tl) { v = Km[((tl - tk) * 16 + c) * 16 + ck0 + e]; if (tk == tl && ck0 + e == c) v += dsk[c]; } vy[e] = v; }
            if (n < 128) { const int p = n & 63; const f2 pw = P[(15 - tk) * 64 + p];
#pragma unroll
                for (int e = 0; e < 8; ++e) { const f2 bb = Bb[p * 16 + ck0 + e]; vb[e] = (n < 64) ? (pw.x * bb.x - pw.y * bb.y) : (pw.x * bb.y + pw.y * bb.x); } }
            else {
#pragma unroll
                for (int e = 0; e < 8; ++e) vb[e] = 0.f; }
        } else { const int p0 = (k0 - 256) & 63; const bool im = k0 >= 320;
#pragma unroll
            for (int e = 0; e < 8; ++e) { const f2 L = P[(tl + 1) * 64 + p0 + e], cc = Cc[c * 64 + p0 + e]; vy[e] = im ? -(cc.x * L.y + cc.y * L.x) : (cc.x * L.x - cc.y * L.y); vb[e] = 0.f; } }
        v4u oy, ob; oy.x = pk2(vy[0], vy[1]); oy.y = pk2(vy[2], vy[3]); oy.z = pk2(vy[4], vy[5]); oy.w = pk2(vy[6], vy[7]);
        ob.x = pk2(vb[0], vb[1]); ob.y = pk2(vb[2], vb[3]); ob.z = pk2(vb[4], vb[5]); ob.w = pk2(vb[6], vb[7]);
        *(v4u*)(WSY + (size_t)n * ASK + k0) = oy; *(v4u*)(WSB + (size_t)n * ASK + k0) = ob; }
    if (tid < 64) ((f2*)(ws + WS_LPOW))[(l * NGRP + g) * 64 + tid] = P[16 * 64 + tid];
    __syncthreads();
}

__device__ __forceinline__ float bperm(int lanesel, float v) { return __int_as_float(__builtin_amdgcn_ds_bpermute(lanesel << 2, __float_as_int(v))); }
template <bool FORGET, int R, bool F32IN>
__device__ __forceinline__ void norm_rows(const float* X, const bf16* XBr, bf16* XBw, const float* gvec, bf16* H, const float* win  , const float* bfg, float* LOGF, int gw, int NGW, int lane) {
    f32x4 gv[4];
#pragma unroll
    for (int j = 0; j < 4; ++j) gv[j] = *((const f32x4*)gvec + lane + 64 * j);
    f32x4 wf[4][4][2];
    if (FORGET) {
#pragma unroll
        for (int j = 0; j < 4; ++j)
#pragma unroll
            for (int e = 0; e < 4; ++e) { const int k = 256 * j + 4 * lane + e; const float* wp = win + (size_t)k * NIN + 1536;
                wf[j][e][0] = *(const f32x4*)wp * gv[j][e]; wf[j][e][1] = *(const f32x4*)(wp + 4) * gv[j][e]; }
    }
    const int hsel = 4 * (lane & 1) + 2 * ((lane >> 1) & 1) + ((lane >> 2) & 1);
    const float bfv = FORGET ? bfg[hsel] : 0.f;
    const bool b0 = lane & 1, b1 = lane & 2, b2 = lane & 4;
    for (int m0 = gw; m0 < M; m0 += NGW * R) {
        f32x4 v[R][4]; float s[R]; size_t mr[R]; bool ok[R];
#pragma unroll
        for (int r = 0; r < R; ++r) { const int m = m0 + r * NGW; ok[r] = m < M; mr[r] = (size_t)(ok[r] ? m : m0); }
        if constexpr (F32IN) {
#pragma unroll
            for (int r = 0; r < R; ++r) { const f32x4* xr = (const f32x4*)(X + mr[r] * DMOD) + lane;
#pragma unroll
                for (int j = 0; j < 4; ++j) v[r][j] = xr[64 * j]; }
#pragma unroll
            for (int r = 0; r < R; ++r) { unsigned long long* xw = (unsigned long long*)(XBw + mr[r] * DMOD) + lane;
#pragma unroll
                for (int j = 0; j < 4; ++j) { const unsigned lo = pk2(v[r][j].x, v[r][j].y), hi = pk2(v[r][j].z, v[r][j].w); if (ok[r]) xw[64 * j] = (unsigned long long)lo | ((unsigned long long)hi << 32);
                    v[r][j] = (f32x4){__uint_as_float(lo << 16), __uint_as_float(lo & 0xffff0000u), __uint_as_float(hi << 16), __uint_as_float(hi & 0xffff0000u)}; } }
        } else {
            unsigned long long w8[R][4];
#pragma unroll
            for (int r = 0; r < R; ++r) { const unsigned long long* xr = (const unsigned long long*)(XBr + mr[r] * DMOD) + lane;
#pragma unroll
                for (int j = 0; j < 4; ++j) w8[r][j] = xr[64 * j]; }
#pragma unroll
            for (int r = 0; r < R; ++r)
#pragma unroll
                for (int j = 0; j < 4; ++j) { const unsigned lo = (unsigned)w8[r][j], hi = (unsigned)(w8[r][j] >> 32);
                    v[r][j] = (f32x4){__uint_as_float(lo << 16), __uint_as_float(lo & 0xffff0000u), __uint_as_float(hi << 16), __uint_as_float(hi & 0xffff0000u)}; }
        }
#pragma unroll
        for (int r = 0; r < R; ++r) { float t = 0.f;
#pragma unroll
            for (int j = 0; j < 4; ++j) t += (v[r][j].x * v[r][j].x + v[r][j].y * v[r][j].y) + (v[r][j].z * v[r][j].z + v[r][j].w * v[r][j].w);
            s[r] = t; }
        f32x4 a0[R], a1[R];
        if (FORGET) {
#pragma unroll
            for (int r = 0; r < R; ++r) { a0[r] = (f32x4){0.f, 0.f, 0.f, 0.f}; a1[r] = (f32x4){0.f, 0.f, 0.f, 0.f};
#pragma unroll
                for (int j = 0; j < 4; ++j)
#pragma unroll
                    for (int e = 0; e < 4; ++e) { a0[r] += wf[j][e][0] * v[r][j][e]; a1[r] += wf[j][e][1] * v[r][j][e]; } }
        }
#pragma unroll
        for (int o = 1; o < 64; o <<= 1)
#pragma unroll
            for (int r = 0; r < R; ++r) s[r] += bperm(lane ^ o, s[r]);
        float rstd[R];
#pragma unroll
        for (int r = 0; r < R; ++r) { rstd[r] = 1.0f / sqrtf(s[r] * (1.f / DMOD) + RMS_EPS);
            unsigned long long* o8 = (unsigned long long*)(H + mr[r] * DMOD) + lane;
#pragma unroll
            for (int j = 0; j < 4; ++j) { const f32x4 h = v[r][j] * rstd[r] * gv[j]; if (ok[r]) o8[64 * j] = (unsigned long long)pk2(h.x, h.y) | ((unsigned long long)pk2(h.z, h.w) << 32); } }
        if (FORGET) {
            float t4[R][4], t2[R][2], w[R];
#pragma unroll
            for (int i = 0; i < 4; ++i)
#pragma unroll
                for (int r = 0; r < R; ++r) { const float snd = b0 ? a0[r][i] : a1[r][i], kp = b0 ? a1[r][i] : a0[r][i]; t4[r][i] = kp + bperm(lane ^ 1, snd); }
#pragma unroll
            for (int i = 0; i < 2; ++i)
#pragma unroll
                for (int r = 0; r < R; ++r) { const float snd = b1 ? t4[r][i] : t4[r][2 + i], kp = b1 ? t4[r][2 + i] : t4[r][i]; t2[r][i] = kp + bperm(lane ^ 2, snd); }
#pragma unroll
            for (int r = 0; r < R; ++r) w[r] = (b2 ? t2[r][1] : t2[r][0]) + bperm(lane ^ 4, b2 ? t2[r][0] : t2[r][1]);
#pragma unroll
            for (int o = 8; o < 64; o <<= 1)
#pragma unroll
                for (int r = 0; r < R; ++r) w[r] += bperm(lane ^ o, w[r]);
#pragma unroll
            for (int r = 0; r < R; ++r) if (lane < 8 && ok[r]) { const float z = w[r] * rstd[r] + bfv;
                const float ls = fminf(z, 0.f) - 0.6931471805599453f * __builtin_amdgcn_logf(1.0f + __builtin_amdgcn_exp2f(-fabsf(z) * 1.4426950408889634f));
                LOGF[mr[r] * 8 + hsel] = ls; }
        }
    }
}
template <int R>
__device__ __forceinline__ void norm_rows_final(const bf16* XBr, float* OUT, const float* gvec, int gw, int NGW, int lane) {
    f32x4 gv[4];
#pragma unroll
    for (int j = 0; j < 4; ++j) gv[j] = *((const f32x4*)gvec + lane + 64 * j);
    for (int m0 = gw; m0 < M; m0 += NGW * R) {
        f32x4 v[R][4]; float s[R];
#pragma unroll
        for (int r = 0; r < R; ++r) { const int m = m0 + r * NGW; const unsigned long long* xr = (const unsigned long long*)(XBr + (size_t)(m < M ? m : m0) * DMOD) + lane;
#pragma unroll
            for (int j = 0; j < 4; ++j) { const unsigned long long w = xr[64 * j]; const unsigned lo = (unsigned)w, hi = (unsigned)(w >> 32);
                v[r][j] = (f32x4){__uint_as_float(lo << 16), __uint_as_float(lo & 0xffff0000u), __uint_as_float(hi << 16), __uint_as_float(hi & 0xffff0000u)}; } }
#pragma unroll
        for (int r = 0; r < R; ++r) { float t = 0.f;
#pragma unroll
            for (int j = 0; j < 4; ++j) t += (v[r][j].x * v[r][j].x + v[r][j].y * v[r][j].y) + (v[r][j].z * v[r][j].z + v[r][j].w * v[r][j].w);
            s[r] = t; }
#pragma unroll
        for (int o = 1; o < 64; o <<= 1)
#pragma unroll
            for (int r = 0; r < R; ++r) s[r] += bperm(lane ^ o, s[r]);
#pragma unroll
        for (int r = 0; r < R; ++r) { const int m = m0 + r * NGW; if (m >= M) break;
            const float rstd = 1.0f / sqrtf(s[r] * (1.f / DMOD) + RMS_EPS); f32x4* xw = (f32x4*)(OUT + (size_t)m * DMOD) + lane;
#pragma unroll
            for (int j = 0; j < 4; ++j) xw[64 * j] = v[r][j] * rstd * gv[j]; }
    }
}

#define XB_TMO      128
#define XB_XCNT(j)  (256  + 64 * (j))
#define XB_XSUB(j)  (1280 + 64 * (j))
#define XB_XGEN(j)  (2304 + 64 * (j))
#define XB_TOP      3328
#define XB_TOPGEN   3392
#define XCD_BAR_WORDS 3456
#define XB_SPIN_CAP (1u << 18)

__device__ __forceinline__ unsigned xb_ld(unsigned* p)              { return __hip_atomic_load(p, __ATOMIC_RELAXED, __HIP_MEMORY_SCOPE_AGENT); }
__device__ __forceinline__ unsigned xb_add(unsigned* p, unsigned v) { return __hip_atomic_fetch_add(p, v, __ATOMIC_RELAXED, __HIP_MEMORY_SCOPE_AGENT); }
__device__ __forceinline__ unsigned xb_xcc_id() { return (unsigned)__builtin_amdgcn_s_getreg((3 << 11) | 20) & 0xFu; }
#define XB_SPIN(cond, bar) do { unsigned _sp = 0; while (cond) { __builtin_amdgcn_s_sleep(1); \
    if ((++_sp & 255u) == 0u) { if (xb_ld(&(bar)[XB_TMO])) break; if (_sp > XB_SPIN_CAP) { atomicAdd(&(bar)[XB_TMO], 1u); break; } } } } while (0)

struct XcdBarrier {
    unsigned* bar; unsigned x;
    volatile LAS unsigned* st;
};

__device__ __forceinline__ XcdBarrier xcd_barrier_post(unsigned* bar, volatile LAS unsigned* st) {
    XcdBarrier b; b.bar = bar; b.x = xb_xcc_id(); b.st = st;
    if (threadIdx.x == 0) (void)xb_add(&bar[XB_XCNT(b.x)], 1u);
    return b;
}
__device__ __forceinline__ void xcd_barrier_complete(unsigned* bar, unsigned x, unsigned& nloc, unsigned& nx) {
    const unsigned G = gridDim.x * gridDim.y * gridDim.z;
    unsigned sum, cnt, mine, sp = 0u;
    for (;;) {
        sum = 0u; cnt = 0u; mine = 0u;
#pragma unroll
        for (unsigned j = 0; j < 16; ++j) { const unsigned c = xb_ld(&bar[XB_XCNT(j)]); sum += c; cnt += (c > 0u) ? 1u : 0u; mine = (j == x) ? c : mine; }
        if (sum == G) break;
        __builtin_amdgcn_s_sleep(1);
        if ((++sp & 255u) == 0u) { if (xb_ld(&bar[XB_TMO])) break; if (sp > XB_SPIN_CAP) { atomicAdd(&bar[XB_TMO], 1u); break; } }
    }
    nloc = mine > 0u ? mine : 1u; nx = cnt > 0u ? cnt : 1u;
}

__device__ __forceinline__ void xcd_barrier(const XcdBarrier& b) {
    asm volatile("s_waitcnt vmcnt(0)" ::: "memory");
    __syncthreads();
    if (threadIdx.x == 0) {
        unsigned* bar = b.bar;
        __builtin_amdgcn_s_waitcnt(0);
        unsigned nloc = b.st[0], nx = b.st[1];
        if (nloc == 0u) { xcd_barrier_complete(bar, b.x, nloc, nx); b.st[0] = nloc; b.st[1] = nx; }
        const unsigned old = xb_add(&bar[XB_XSUB(b.x)], 1u);
        const unsigned gen = old / nloc;
        if (old + 1u == (gen + 1u) * nloc) {
            __builtin_amdgcn_fence(__ATOMIC_RELEASE, "agent");
            asm volatile("s_waitcnt vmcnt(0)" ::: "memory");
            const unsigned og = xb_add(&bar[XB_TOP], 1u);
            const unsigned tg = og / nx;
            if (og + 1u == (tg + 1u) * nx) xb_add(&bar[XB_TOPGEN], 1u);
            else XB_SPIN(xb_ld(&bar[XB_TOPGEN]) == tg, bar);
            __builtin_amdgcn_fence(__ATOMIC_ACQUIRE, "agent");
            xb_add(&bar[XB_XGEN(b.x)], 1u);
            asm volatile("s_waitcnt vmcnt(0)" ::: "memory");
        } else {
            XB_SPIN(xb_ld(&bar[XB_XGEN(b.x)]) == gen, bar);
            __builtin_amdgcn_fence(__ATOMIC_ACQUIRE, "agent");
            asm volatile("s_waitcnt vmcnt(0)" ::: "memory");
        }
    }
    __syncthreads();
}
#ifndef PHMASK
#define PHMASK 0xFFFF
#endif
#ifndef SMALLK_ALIGN
#define SMALLK_ALIGN true
#endif
#ifndef BIGK_ALIGN
#define BIGK_ALIGN true
#endif
#ifndef DUPMASK
#define DUPMASK 0
#endif
__global__ void __launch_bounds__(NWAVES * 64, 2) fwd_megakernel(Args args) {
    extern __shared__ __attribute__((aligned(16))) unsigned char lds[];
    cg::grid_group grid = cg::this_grid();
    {
        volatile LAS unsigned* misc = (volatile LAS unsigned*)((LAS unsigned char*)lds + MISC_OFF);
        if (threadIdx.x < 32) misc[threadIdx.x] = 0u;
        __syncthreads();
    }
    XcdBarrier xbar = xcd_barrier_post((unsigned*)(args.ws + WS_CTL + WS_BARW), (volatile LAS unsigned*)((LAS unsigned char*)lds + MISC_OFF) + 8);
    if (args.ws == nullptr) grid.sync();
    LAS unsigned char* L = (LAS unsigned char*)lds;
    const int G = gridDim.x, bx = blockIdx.x, NGW = G * NWAVES;
#define TID_OPAQUE() int tid_ = threadIdx.x; asm volatile("" : "+v"(tid_)); const int tid = tid_, lane = tid & 63, wave = __builtin_amdgcn_readfirstlane(tid >> 6), gw = bx * NWAVES + wave; (void)tid; (void)lane; (void)gw
    float* out = args.out;
#define GASP __attribute__((address_space(1)))
#define WS_OPAQUE() GASP unsigned char* ws = (GASP unsigned char*)args.ws; asm volatile("" : "+s"(ws))
#define WSP(T, off) ((T*)(GASP T*)(ws + (off)))
#define GRID_SYNC1() xcd_barrier(xbar)
#ifdef DUPSYNC
#define GRID_SYNC() do { GRID_SYNC1(); GRID_SYNC1(); } while (0)
#else
#define GRID_SYNC() GRID_SYNC1()
#endif
    { TID_OPAQUE(); WS_OPAQUE(); for (int it = bx; it < DEPTH * NGRP; it += G) ssm_tables(args, it >> 5, it & 31, (unsigned char*)ws, L, tid); }
    for (int l_ = 0; l_ < DEPTH; ++l_) {
        int l = l_; asm volatile("" : "+s"(l));
#if (PHMASK >> 0) & 1
        for (int rep_ = 0; rep_ < (int)((DUPMASK >> 0) & 1) + 1; ++rep_) {
        {
            TID_OPAQUE(); WS_OPAQUE(); bf16* Win_t = WSP(bf16, WS_WIN); bf16* Wup_t = WSP(bf16, WS_WUP); bf16* Wdn_t = WSP(bf16, WS_WDN); bf16* Wout_t = WSP(bf16, WS_WOUT);
            bf16* Wa_t = WSP(bf16, WS_WA); bf16* Wb_t = WSP(bf16, WS_WB); bf16* Wglu_t = WSP(bf16, WS_WGLU); bf16* H = WSP(bf16, WS_H); float* LOGF = WSP(float, WS_LOGF);
            LAS float* scr = (LAS float*)(L + wave * 16384);
            const float* w_in = args.in[2] + (size_t)l * DMOD * NIN; const float* w_glu = args.in[12] + (size_t)l * SW * SW;
            const float* w_a = args.in[14] + (size_t)l * AW * DMOD; const float* w_b = args.in[15] + (size_t)l * SW * DMOD; const float* w_out = args.in[16] + (size_t)l * DMOD * DMOD;
            const float* w_up = args.in[18] + (size_t)l * DMOD * FF; const float* w_dn = args.in[19] + (size_t)l * FF * DMOD;
            constexpr int I_IN = 16 * 128, I_GLU = 8 * 16, I_A = 8 * 32, I_B = 8 * 32, I_OUT = 16 * 32, I_UP = 16 * 128, I_DN = 64 * 32;
            constexpr int NITEMS = I_IN + I_GLU + I_A + I_B + I_OUT + I_UP + I_DN;
            for (int it = gw; it < NITEMS; it += NGW) {
                int r = it;
                if (r < I_IN) { const int nb = r % 128; const int sc0 = (nb >= 48) ? 8 : 0;
                    transpose_item(w_in, NIN, DMOD, 128, Win_t, 0, sc0, scr, r, lane); continue; } r -= I_IN;
                if (r < I_GLU) { transpose_item(w_glu, SW, SW, 16, Wglu_t, 0, 0, scr, r, lane); continue; } r -= I_GLU;
                if (r < I_A) { transpose_item(w_a, DMOD, AW, 32, Wa_t, 0, 0, scr, r, lane); continue; } r -= I_A;
                if (r < I_B) { transpose_item(w_b, DMOD, SW, 32, Wb_t, 0, 0, scr, r, lane); continue; } r -= I_B;
                if (r < I_OUT) { transpose_item(w_out, DMOD, DMOD, 32, Wout_t, 0, 0, scr, r, lane); continue; } r -= I_OUT;
                if (r < I_UP) { transpose_item(w_up, FF, DMOD, 128, Wup_t, 0, 0, scr, r, lane); continue; } r -= I_UP;
                transpose_item(w_dn, DMOD, FF, 32, Wdn_t, 0, 0, scr, r, lane);
            }
            if (l == 0) norm_rows<true, 2, true>(args.in[0], nullptr, WSP(bf16, WS_XB), args.in[1] + (size_t)l * DMOD, H, w_in, args.in[3] + (size_t)l * NHEADS, LOGF, gw, NGW, lane);
            else norm_rows<true, 2, false>(nullptr, WSP(bf16, WS_XB), nullptr, args.in[1] + (size_t)l * DMOD, H, w_in, args.in[3] + (size_t)l * NHEADS, LOGF, gw, NGW, lane);
        }
        }
#endif
        GRID_SYNC();
#if (PHMASK >> 1) & 1
        for (int rep_ = 0; rep_ < (int)((DUPMASK >> 1) & 1) + 1; ++rep_) {
        {
            WS_OPAQUE(); bf16* H = WSP(bf16, WS_H); bf16* Win_t = WSP(bf16, WS_WIN); bf16* Qb = WSP(bf16, WS_Q); bf16* AS = WSP(bf16, WS_AS); bf16* GA = WSP(bf16, WS_GA);
            static_assert(WS_V - WS_K == WS_K - WS_Q, "Q|K|V equally spaced");
            pg8::Gemm g{H, Win_t, M, 4096, DMOD}; pg8::StaticOrder S; S.init(M, 4096, G, bx);
            pg8::EpiInProj E{Qb, AS, GA, (size_t)(WS_K - WS_Q) / 2, (size_t)(WS_GB - WS_GA) / 2};
            pg8::gemm_phase<pg8::EpiInProj, pg8::StaticOrder, BIGK_ALIGN, true>(L, g, S, E);
        }
        }
#endif
        GRID_SYNC();
#if (PHMASK >> 2) & 1
        for (int rep_ = 0; rep_ < (int)((DUPMASK >> 2) & 1) + 1; ++rep_) {
        {
            WS_OPAQUE(); bf16* AS = WSP(bf16, WS_AS); bf16* WSB_t = WSP(bf16, WS_WSB + (size_t)l * SSM_W_LAYER); float* SLOC = WSP(float, WS_SLOC);
            pg8::Gemm g{AS, WSB_t, NGRP * NCR, NGRP * 256, ASK}; pg8::SsmOrder S{G, bx};
            pg8::EpiSsmState E{SLOC};
            pg8::gemm_phase<pg8::EpiSsmState, pg8::SsmOrder, SMALLK_ALIGN, true>(L, g, S, E);
        }
        }
#endif
#if (PHMASK >> 3) & 1
        for (int rep_ = 0; rep_ < (int)((DUPMASK >> 3) & 1) + 1; ++rep_) {
        {
            typedef float f2 __attribute__((ext_vector_type(2)));
            TID_OPAQUE(); WS_OPAQUE(); bf16* AS = WSP(bf16, WS_AS); float* SLOC = WSP(float, WS_SLOC); float* LOGF = WSP(float, WS_LOGF); float* BIAS = WSP(float, WS_BIAS);
            if ((wave & 1) == 0) {
                for (int i = 0; i * G + bx < NGRP * BATCH; ++i) { if (wave != ((2 * i) & 7)) continue; const int it = i * G + bx; const int g = it >> 4, b = it & 15;
                    const f2 l16 = WSP(const f2, WS_LPOW)[(l * NGRP + g) * 64 + lane];
                    const float* sl = SLOC + ((size_t)(g * NCR + b * 256)) * 128 + lane; bf16* as = AS + ((size_t)(g * NCR + b * 256)) * ASK + 256 + lane;
                    float sr = 0.f, si = 0.f;
                    for (int ch0 = 0; ch0 < 256; ch0 += 32) {
                        float ar[32], ai[32];
#pragma unroll
                        for (int i = 0; i < 32; ++i) { ar[i] = sl[(size_t)(ch0 + i) * 128]; ai[i] = sl[(size_t)(ch0 + i) * 128 + 64]; }
#pragma unroll
                        for (int i = 0; i < 32; ++i) { as[(size_t)(ch0 + i) * ASK] = (bf16)f2bf(sr); as[(size_t)(ch0 + i) * ASK + 64] = (bf16)f2bf(si);
                            const float nr = l16.x * sr - l16.y * si + ar[i], ni = l16.x * si + l16.y * sr + ai[i]; sr = nr; si = ni; } } }
            } else if ((gw & 3) == 1) {
                for (int sq = gw >> 2; sq < BATCH * NHEADS; sq += NGW >> 2) { const int b = sq >> 3, h = sq & 7;
                    const float* lf = LOGF + ((size_t)b * SEQ + lane * 64) * 8 + h; float tot = 0.f; float vals[64];
#pragma unroll
                    for (int i = 0; i < 64; ++i) vals[i] = lf[i * 8];
#pragma unroll
                    for (int i = 0; i < 64; ++i) tot += vals[i];
                    float incl = tot;
#pragma unroll
                    for (int o = 1; o < 64; o <<= 1) { const float t = __int_as_float(__builtin_amdgcn_ds_bpermute((lane - o) << 2, __float_as_int(incl))); if (lane >= o) incl += t; }
                    float run = incl - tot; float* bo = BIAS + (size_t)sq * SEQ + lane * 64;
#pragma unroll
                    for (int i = 0; i < 64; ++i) { run += vals[i]; bo[i] = -run * 1.4426950408889634f; } }
            }
        }
        }
#endif
        GRID_SYNC();
#if (PHMASK >> 4) & 1
        for (int rep_ = 0; rep_ < (int)((DUPMASK >> 4) & 1) + 1; ++rep_) {
        {
            WS_OPAQUE(); bf16* AS = WSP(bf16, WS_AS); bf16* WSY_t = WSP(bf16, WS_WSY + (size_t)l * SSM_W_LAYER); bf16* YB = WSP(bf16, WS_YB);
            pg8::Gemm g{AS, WSY_t, NGRP * NCR, NGRP * 256, ASK}; pg8::SsmOrder S{G, bx};
            pg8::EpiSsmY E{YB};
            pg8::gemm_phase<pg8::EpiSsmY, pg8::SsmOrder, SMALLK_ALIGN, true>(L, g, S, E);
        }
        {
            WS_OPAQUE(); bf16* Qb = WSP(bf16, WS_Q); bf16* Kb = WSP(bf16, WS_K); bf16* Vb = WSP(bf16, WS_V); float* BIAS = WSP(float, WS_BIAS);
            const attn_body::AttnTensors AT{(const attn_body::bf16*)Qb, (const attn_body::bf16*)Kb, (const attn_body::bf16*)Vb, (attn_body::bf16*)WSP(bf16, WS_H), BIAS};
            const attn_body::StaticOrder S(G, bx);
#ifndef NO_ATTN
            attn_body::attn_phase<attn_body::StaticOrder>((char*)lds, AT, S);
        }
#endif
        }
#endif
        GRID_SYNC();
#if (PHMASK >> 5) & 1
        for (int rep_ = 0; rep_ < (int)((DUPMASK >> 5) & 1) + 1; ++rep_) {
        {
            WS_OPAQUE(); bf16* YB = WSP(bf16, WS_YB); bf16* YB2 = WSP(bf16, WS_YB2); bf16* Wglu_t = WSP(bf16, WS_WGLU);
            pg8::Gemm g{YB, Wglu_t, M, SW, SW}; pg8::StaticOrder S; S.init(M, SW, G, bx);
            pg8::EpiGlu E{YB, YB2, args.in[13] + (size_t)l * SW};
            pg8::gemm_phase<pg8::EpiGlu, pg8::StaticOrder, SMALLK_ALIGN, true>(L, g, S, E);
        }
        }
#endif
#if (PHMASK >> 6) & 1
        for (int rep_ = 0; rep_ < (int)((DUPMASK >> 6) & 1) + 1; ++rep_) {
        {
            WS_OPAQUE(); bf16* Qb = WSP(bf16, WS_H)  ; bf16* Wa_t = WSP(bf16, WS_WA); bf16* GA = WSP(bf16, WS_GA); bf16* MIXED = WSP(bf16, WS_K)  ;
            pg8::Gemm g{Qb, Wa_t, M, DMOD, AW}; pg8::StaticOrder S; S.init(M, DMOD, G, bx);
            pg8::EpiGate<false> E{GA, MIXED};
            pg8::gemm_phase<pg8::EpiGate<false>, pg8::StaticOrder, SMALLK_ALIGN, true>(L, g, S, E);
        }
        }
#endif
        GRID_SYNC();
#if (PHMASK >> 7) & 1
        for (int rep_ = 0; rep_ < (int)((DUPMASK >> 7) & 1) + 1; ++rep_) {
        {
            WS_OPAQUE(); bf16* YB2 = WSP(bf16, WS_YB2); bf16* Wb_t = WSP(bf16, WS_WB); bf16* GB = WSP(bf16, WS_GB); bf16* MIXED = WSP(bf16, WS_K);
            pg8::Gemm g{YB2, Wb_t, M, DMOD, SW}; pg8::StaticOrder S; S.init(M, DMOD, G, bx);
            pg8::EpiGate<true> E{GB, rep_ ? WSP(bf16, WS_H) : MIXED};
            pg8::gemm_phase<pg8::EpiGate<true>, pg8::StaticOrder, SMALLK_ALIGN, true>(L, g, S, E);
        }
        }
#endif
        GRID_SYNC();
#if (PHMASK >> 8) & 1
        for (int rep_ = 0; rep_ < (int)((DUPMASK >> 8) & 1) + 1; ++rep_) {
        {
            WS_OPAQUE(); bf16* MIXED = WSP(bf16, WS_K); bf16* Wout_t = WSP(bf16, WS_WOUT);
            pg8::Gemm g{MIXED, Wout_t, M, DMOD, DMOD}; pg8::StaticOrder S; S.init(M, DMOD, G, bx);
            pg8::EpiResid E{rep_ ? WSP(bf16, WS_H) : WSP(bf16, WS_XB)};
            pg8::gemm_phase<pg8::EpiResid, pg8::StaticOrder, BIGK_ALIGN, true>(L, g, S, E);
        }
        }
#endif
        GRID_SYNC();
#if (PHMASK >> 9) & 1
        for (int rep_ = 0; rep_ < (int)((DUPMASK >> 9) & 1) + 1; ++rep_) {
        { TID_OPAQUE(); WS_OPAQUE(); norm_rows<false, 4, false>(nullptr, WSP(bf16, WS_XB), nullptr, args.in[17] + (size_t)l * DMOD, WSP(bf16, WS_H), nullptr, nullptr, nullptr, gw, NGW, lane); }
        }
#endif
        GRID_SYNC();
#if (PHMASK >> 10) & 1
        for (int rep_ = 0; rep_ < (int)((DUPMASK >> 10) & 1) + 1; ++rep_) {
        {
            WS_OPAQUE(); bf16* H = WSP(bf16, WS_H); bf16* Wup_t = WSP(bf16, WS_WUP); bf16* HID = WSP(bf16, WS_HID);
            pg8::Gemm g{H, Wup_t, M, FF, DMOD}; pg8::StaticOrder S; S.init(M, FF, G, bx);
            pg8::EpiRelu2 E{HID};
            pg8::gemm_phase<pg8::EpiRelu2, pg8::StaticOrder, BIGK_ALIGN, true>(L, g, S, E);
        }
        }
#endif
        GRID_SYNC();
#if (PHMASK >> 11) & 1
        for (int rep_ = 0; rep_ < (int)((DUPMASK >> 11) & 1) + 1; ++rep_) {
        {
            WS_OPAQUE(); bf16* HID = WSP(bf16, WS_HID); bf16* Wdn_t = WSP(bf16, WS_WDN);
            pg8::Gemm g{HID, Wdn_t, M, DMOD, FF}; pg8::StaticOrder S; S.init(M, DMOD, G, bx);
            pg8::EpiResid E{rep_ ? WSP(bf16, WS_H) : WSP(bf16, WS_XB)};
            pg8::gemm_phase<pg8::EpiResid, pg8::StaticOrder, BIGK_ALIGN, true>(L, g, S, E);
        }
        }
#endif
        GRID_SYNC();
    }
    { TID_OPAQUE(); WS_OPAQUE(); norm_rows_final<4>(WSP(bf16, WS_XB), out, args.in[20], gw, NGW, lane); }
}

extern "C" void kernel_launch(void* const* d_in, const int* in_sizes, int n_in, void* d_out, int out_size, void* d_ws, size_t ws_size, hipStream_t stream) {
    static int grid = 0;
    if (grid == 0) {
        if (n_in != 21 || in_sizes[0] != M * DMOD || out_size != M * DMOD || ws_size < WS_END) {
            fprintf(stderr, "kernel_launch: unexpected shapes: n_in %d in0 %d out %d ws %zu (need %zu)\n", n_in, n_in > 0 ? in_sizes[0] : -1, out_size, ws_size, (size_t)WS_END); grid = -1; return; }
        int dev = 0, cus = 0, per_cu = 0;
        hipGetDevice(&dev); hipDeviceGetAttribute(&cus, hipDeviceAttributeMultiprocessorCount, dev);
        if (hipFuncSetAttribute((const void*)fwd_megakernel, hipFuncAttributeMaxDynamicSharedMemorySize, LDS_BYTES) != hipSuccess) { fprintf(stderr, "kernel_launch: hipFuncSetAttribute failed\n"); grid = -1; return; }
        if (hipOccupancyMaxActiveBlocksPerMultiprocessor(&per_cu, (const void*)fwd_megakernel, NWAVES * 64, LDS_BYTES) != hipSuccess || per_cu < 1) per_cu = 1;
        (void)hipGetLastError();
        grid = cus * per_cu;
    }
    if (grid < 0) return;
    if (hipMemsetAsync((char*)d_ws + WS_CTL, 0, CTL_ZERO_BYTES, stream) != hipSuccess) { fprintf(stderr, "kernel_launch: hipMemsetAsync failed\n"); return; }
    Args a{};
    for (int i = 0; i < 21; ++i) a.in[i] = (const float*)d_in[i];
    a.out = (float*)d_out; a.ws = (unsigned char*)d_ws;
    void* kargs[] = {&a};
    hipError_t e = hipLaunchCooperativeKernel((const void*)fwd_megakernel, dim3(grid), dim3(NWAVES * 64), kargs, LDS_BYTES, stream);
    if (e != hipSuccess) fprintf(stderr, "cooperative launch failed: %s (grid %d)\n", hipGetErrorString(e), grid);
}
```

```cpp
#include <hip/hip_runtime.h>
#include <hip/hip_cooperative_groups.h>
#include <cstdio>
#include <cstdint>
namespace pg8 {
#define PG8_LAS __attribute__((address_space(3)))
typedef unsigned short bf16_t;
typedef short bf16x8 __attribute__((ext_vector_type(8)));
typedef float f32x4 __attribute__((ext_vector_type(4)));
typedef unsigned u32x4 __attribute__((ext_vector_type(4)));
constexpr int BM = 256, BK = 64, HALF = 128, HTB = HALF * BK * 2  , STAGE_BYTES = 8 * HTB, NXCD = 8, WGM = 8;

__host__ __device__ __forceinline__ int lds_byte(int r, int c) { const int st = (r >> 4) * 2 + (c >> 5), rr = r & 15, cc = c & 31, ob = rr * 64 + cc * 2; return st * 1024 + (ob ^ (((ob >> 9) & 1) << 5)); }
__host__ __device__ __forceinline__ void stage_rc(int b, int& R, int& C) { const int st = b / 1024, sb = b % 1024, swz = sb ^ (((sb >> 9) & 1) << 5); R = (st >> 1) * 16 + swz / 64; C = (st & 1) * 32 + (swz % 64) / 2; }
__host__ __device__ __forceinline__ int perm32(int rho) { const int n = rho >> 4, i = rho & 15; return 8 * (i >> 2) + 4 * n + (i & 3); }

struct Unit { int pm, pn; };
struct Gemm { const bf16_t* A; const bf16_t* Bt; int M, N, K; int ld = 0; };

struct StaticOrder {
    int nM, nN, nwg, G, c;
    __host__ __device__ void init(int M, int N, int G_, int c_) { nM = M / BM; nN = N / BM; nwg = nM * nN; G = G_; c = c_; }
    __host__ __device__ bool next(int i, Unit& u) const {
        const long L = (long)i * G + c; if (L >= nwg) return false;
        int wgid = (int)L; { const int q = nwg / NXCD, r = nwg % NXCD, xcd = wgid % NXCD, off = wgid / NXCD; wgid = (xcd < r ? xcd * (q + 1) : r * (q + 1) + (xcd - r) * q) + off; }
        const int nig = WGM * nN, gid = wgid / nig, fm = gid * WGM, gsz = (nM - fm) < WGM ? (nM - fm) : WGM;
        u.pm = fm + ((wgid % nig) % gsz); u.pn = (wgid % nig) / gsz; return true;
    }
    __device__ __forceinline__ void a_ready(const Unit&) const {}
    __device__ __forceinline__ void done(const Unit&) const {}
};

typedef float f32x2c_t __attribute__((ext_vector_type(2))); typedef __bf16 bf16x2c_t __attribute__((ext_vector_type(2)));
__device__ __forceinline__ unsigned cvt_pk_bf16(float lo, float hi) { f32x2c_t v = {lo, hi}; bf16x2c_t b = __builtin_convertvector(v, bf16x2c_t); return __builtin_bit_cast(unsigned, b); }
typedef float f32x2 __attribute__((ext_vector_type(2)));
__device__ __forceinline__ f32x2 gelu_pk(f32x2 v) {
    const f32x2 av = __builtin_elementwise_abs(v), d = av * 0.2316418882f + 1.0f;
    f32x2 t; t.x = __builtin_amdgcn_rcpf(d.x); t.y = __builtin_amdgcn_rcpf(d.y);
    f32x2 q = t * 0.5307027145f + (-0.7265760135f); q = q * t + 0.7107068705f; q = q * t + (-0.142248368f); q = q * t + 0.127414796f; q = q * t;
    const f32x2 s = (v * v) * (-0.72134752044f);
    f32x2 e; e.x = __builtin_amdgcn_exp2f(s.x); e.y = __builtin_amdgcn_exp2f(s.y);
    const f32x2 m = v * (q * e), r = v - m;
    f32x2 o; o.x = v.x < 0.f ? m.x : r.x; o.y = v.y < 0.f ? m.y : r.y; return o;
}

constexpr float LOG2E = 1.4426950408889634f;
constexpr float QC2 = 0.125f * 1.4426950408889634f;
__device__ __forceinline__ float sigm(float x) { return __builtin_amdgcn_rcpf(1.0f + __builtin_amdgcn_exp2f(-x * LOG2E)); }
__device__ __forceinline__ float gelu_tanh(float x) { const float z = 1.5957691216057308f * (x + 0.044715f * x * x * x); return x * sigm(z); }
__device__ __forceinline__ u32x4 pack8(const f32x4 v0, const f32x4 v1) { u32x4 w; w.x = cvt_pk_bf16(v0[0], v0[1]); w.y = cvt_pk_bf16(v0[2], v0[3]); w.z = cvt_pk_bf16(v1[0], v1[1]); w.w = cvt_pk_bf16(v1[2], v1[3]); return w; }
__device__ __forceinline__ float bf_lo(unsigned w) { return __uint_as_float(w << 16); }
__device__ __forceinline__ float bf_hi(unsigned w) { return __uint_as_float(w & 0xffff0000u); }
#define EPI_LOOP_BEGIN \
    _Pragma("unroll") for (int ai = 0; ai < 2; ++ai) _Pragma("unroll") for (int m = 0; m < 4; ++m) { const int row = u.pm * BM + ai * HALF + wr * 64 + m * 16 + fr; \
    _Pragma("unroll") for (int bj = 0; bj < 2; ++bj) { const int ct = bj * HALF + wc * 32 + 8 * fq; f32x4 v0 = acc[ai][bj][m][0], v1 = acc[ai][bj][m][1];
#define EPI_LOOP_END } }
#define EPI_SIG(v0, v1) do { _Pragma("unroll") for (int e_ = 0; e_ < 4; ++e_) { v0[e_] = sigm(v0[e_]); v1[e_] = sigm(v1[e_]); } } while (0)

struct EpiInProj {
    static constexpr bool PERM = true, AFTER_DRAIN = false;
    bf16_t *Q, *AS, *GA; size_t qkv_stride, gate_stride;
    __device__ __forceinline__ void operator()(const f32x4 (&acc)[2][2][4][2], const Unit& u, int wr, int wc, int fr, int fq) const {
        const int pn = u.pn;
        if (pn < 6) {
            bf16_t* base = Q + (size_t)(pn >> 1) * qkv_stride; const float sc = pn < 2 ? QC2 : 1.0f; const int cb = (pn & 1) * 256;
            EPI_LOOP_BEGIN v0 = v0 * sc; v1 = v1 * sc; *(u32x4*)(base + (size_t)row * 512 + cb + ct) = pack8(v0, v1); EPI_LOOP_END
        } else if (pn < 8) {
            const int cb = (pn - 6) * 256;
            EPI_LOOP_BEGIN const int j = cb + ct; const int g = j >> 4;
                *(u32x4*)(AS + ((size_t)(g * 4096 + (row >> 4))) * 384 + (row & 15) * 16 + (j & 15)) = pack8(v0, v1); EPI_LOOP_END
        } else {
            bf16_t* base = GA + (size_t)((pn - 8) >> 2) * gate_stride; const int cb = ((pn - 8) & 3) * 256;
            EPI_LOOP_BEGIN EPI_SIG(v0, v1); *(u32x4*)(base + (size_t)row * 1024 + cb + ct) = pack8(v0, v1); EPI_LOOP_END
        }
    }
};
struct EpiSsmState {
    static constexpr bool PERM = true, AFTER_DRAIN = false;
    float* SLOC;
    __device__ __forceinline__ void operator()(const f32x4 (&acc)[2][2][4][2], const Unit& u, int wr, int wc, int fr, int fq) const {
        EPI_LOOP_BEGIN if (bj == 0) { float* d = SLOC + (size_t)row * 128 + ct; *(f32x4*)d = v0; *(f32x4*)(d + 4) = v1; } EPI_LOOP_END
    }
};
struct EpiSsmY {
    static constexpr bool PERM = true, AFTER_DRAIN = false;
    bf16_t* YB;
    __device__ __forceinline__ void operator()(const f32x4 (&acc)[2][2][4][2], const Unit& u, int wr, int wc, int fr, int fq) const {
        EPI_LOOP_BEGIN const int g = row >> 12, cr = row & 4095, tl = ct >> 4, c0 = ct & 15;
            _Pragma("unroll") for (int e = 0; e < 4; ++e) { v0[e] = gelu_tanh(v0[e]); v1[e] = gelu_tanh(v1[e]); }
            *(u32x4*)(YB + ((size_t)(cr * 16 + tl)) * 512 + g * 16 + c0) = pack8(v0, v1); EPI_LOOP_END
    }
};
#define EPI_ROW(ai, m) (u.pm * BM + (ai) * HALF + wr * 64 + (m) * 16 + fr)
#define EPI_CT(bj) ((bj) * HALF + wc * 32 + 8 * fq)
struct EpiGlu {
    static constexpr bool PERM = true, AFTER_DRAIN = false;
    const bf16_t* YB; bf16_t* O; const float* bias;
    __device__ __forceinline__ void operator()(const f32x4 (&acc)[2][2][4][2], const Unit& u, int wr, int wc, int fr, int fq) const {
        u32x4 y[2][4][2]; f32x4 bb[2][2];
        _Pragma("unroll") for (int bj = 0; bj < 2; ++bj) { const int col = u.pn * BM + EPI_CT(bj); bb[bj][0] = *(const f32x4*)(bias + col); bb[bj][1] = *(const f32x4*)(bias + col + 4); }
        _Pragma("unroll") for (int ai = 0; ai < 2; ++ai) _Pragma("unroll") for (int m = 0; m < 4; ++m) _Pragma("unroll") for (int bj = 0; bj < 2; ++bj)
            y[ai][m][bj] = *(const u32x4*)(YB + (size_t)EPI_ROW(ai, m) * 512 + u.pn * BM + EPI_CT(bj));
        _Pragma("unroll") for (int ai = 0; ai < 2; ++ai) _Pragma("unroll") for (int m = 0; m < 4; ++m) _Pragma("unroll") for (int bj = 0; bj < 2; ++bj) {
            f32x4 v0 = acc[ai][bj][m][0] + bb[bj][0], v1 = acc[ai][bj][m][1] + bb[bj][1]; const u32x4 yy = y[ai][m][bj]; EPI_SIG(v0, v1);
            v0[0] *= bf_lo(yy.x); v0[1] *= bf_hi(yy.x); v0[2] *= bf_lo(yy.y); v0[3] *= bf_hi(yy.y); v1[0] *= bf_lo(yy.z); v1[1] *= bf_hi(yy.z); v1[2] *= bf_lo(yy.w); v1[3] *= bf_hi(yy.w);
            *(u32x4*)(O + (size_t)EPI_ROW(ai, m) * 512 + u.pn * BM + EPI_CT(bj)) = pack8(v0, v1); }
    }
};
template <bool ADD> struct EpiGate {
    static constexpr bool PERM = true, AFTER_DRAIN = false;
    const bf16_t* G; bf16_t* O;
    __device__ __forceinline__ void operator()(const f32x4 (&acc)[2][2][4][2], const Unit& u, int wr, int wc, int fr, int fq) const {
        _Pragma("unroll") for (int ai = 0; ai < 2; ++ai) {
            u32x4 gt[4][2], oo[4][2];
            _Pragma("unroll") for (int m = 0; m < 4; ++m) _Pragma("unroll") for (int bj = 0; bj < 2; ++bj) { const size_t off = (size_t)EPI_ROW(ai, m) * 1024 + u.pn * BM + EPI_CT(bj);
                gt[m][bj] = *(const u32x4*)(G + off); if (ADD) oo[m][bj] = *(const u32x4*)(O + off); }
            _Pragma("unroll") for (int m = 0; m < 4; ++m) _Pragma("unroll") for (int bj = 0; bj < 2; ++bj) { const size_t off = (size_t)EPI_ROW(ai, m) * 1024 + u.pn * BM + EPI_CT(bj);
                f32x4 v0 = acc[ai][bj][m][0], v1 = acc[ai][bj][m][1]; const u32x4 g4 = gt[m][bj];
                v0[0] *= bf_lo(g4.x); v0[1] *= bf_hi(g4.x); v0[2] *= bf_lo(g4.y); v0[3] *= bf_hi(g4.y); v1[0] *= bf_lo(g4.z); v1[1] *= bf_hi(g4.z); v1[2] *= bf_lo(g4.w); v1[3] *= bf_hi(g4.w);
                if (ADD) { const u32x4 o = oo[m][bj];
                    v0[0] += bf_lo(o.x); v0[1] += bf_hi(o.x); v0[2] += bf_lo(o.y); v0[3] += bf_hi(o.y); v1[0] += bf_lo(o.z); v1[1] += bf_hi(o.z); v1[2] += bf_lo(o.w); v1[3] += bf_hi(o.w); }
                *(u32x4*)(O + off) = pack8(v0, v1); }
            asm volatile("" ::: "memory");
        }
    }
};
struct EpiResid {
    static constexpr bool PERM = true, AFTER_DRAIN = false;
    bf16_t* X;
    __device__ __forceinline__ void operator()(const f32x4 (&acc)[2][2][4][2], const Unit& u, int wr, int wc, int fr, int fq) const {
        u32x4 xo[2][4][2];
        _Pragma("unroll") for (int ai = 0; ai < 2; ++ai) _Pragma("unroll") for (int m = 0; m < 4; ++m) _Pragma("unroll") for (int bj = 0; bj < 2; ++bj)
            xo[ai][m][bj] = *(const u32x4*)(X + (size_t)EPI_ROW(ai, m) * 1024 + u.pn * BM + EPI_CT(bj));
        _Pragma("unroll") for (int ai = 0; ai < 2; ++ai) _Pragma("unroll") for (int m = 0; m < 4; ++m) _Pragma("unroll") for (int bj = 0; bj < 2; ++bj) {
            f32x4 v0 = acc[ai][bj][m][0], v1 = acc[ai][bj][m][1]; const u32x4 o = xo[ai][m][bj];
            v0[0] += bf_lo(o.x); v0[1] += bf_hi(o.x); v0[2] += bf_lo(o.y); v0[3] += bf_hi(o.y); v1[0] += bf_lo(o.z); v1[1] += bf_hi(o.z); v1[2] += bf_lo(o.w); v1[3] += bf_hi(o.w);
            *(u32x4*)(X + (size_t)EPI_ROW(ai, m) * 1024 + u.pn * BM + EPI_CT(bj)) = pack8(v0, v1); }
    }
};
struct EpiRelu2 {
    static constexpr bool PERM = true, AFTER_DRAIN = false;
    bf16_t* O;
    __device__ __forceinline__ void operator()(const f32x4 (&acc)[2][2][4][2], const Unit& u, int wr, int wc, int fr, int fq) const {
        EPI_LOOP_BEGIN _Pragma("unroll") for (int e = 0; e < 4; ++e) { const float a = fmaxf(v0[e], 0.f), b = fmaxf(v1[e], 0.f); v0[e] = a * a; v1[e] = b * b; }
            *(u32x4*)(O + (size_t)row * 4096 + u.pn * BM + ct) = pack8(v0, v1); EPI_LOOP_END
    }
};
struct SsmOrder {
    int G, c;
    __device__ __forceinline__ bool next(int i, Unit& u) const { const int L = i * G + c; if (L >= 512) return false; u.pm = L; u.pn = L >> 4; return true; }
    __device__ __forceinline__ void a_ready(const Unit&) const {}
    __device__ __forceinline__ void done(const Unit&) const {}
};

template <class Epi, class Sched, bool ALIGN_EPI = false, bool SP2 = false>
__device__ __forceinline__ void gemm_phase(PG8_LAS unsigned char* lds, const Gemm g, const Sched& S, const Epi& E) {
    int tid_ = threadIdx.x; asm volatile("" : "+v"(tid_));
    const int tid = tid_, wid = __builtin_amdgcn_readfirstlane(tid >> 6), lane = tid & 63, wr = wid >> 2, wc = wid & 3, fr = lane & 15, fq = lane >> 4;
    const int K = g.K, nt = K / BK, LD = g.ld ? g.ld : g.K;
    unsigned voffA[2], voffB[2];
#pragma unroll
    for (int i = 0; i < 2; ++i) { int R, C; stage_rc(tid * 16 + i * 8192, R, C); const int Rb = Epi::PERM ? ((R & ~31) + perm32(R & 31)) : R;
        voffA[i] = (unsigned)(R * LD + C) * 2u; voffB[i] = (unsigned)(Rb * LD + C) * 2u; }
    const size_t kstep = (size_t)(BK * 2);
    const size_t hstep = (size_t)HALF * LD * 2;
    const size_t tstep = 2 * hstep;
    const unsigned ldsw = (unsigned)wid * 1024u;
    const int aoff = lds_byte(wr * 64 + fr, fq * 8), boff = lds_byte(wc * 32 + fr, fq * 8);
#define PG8_SA(b, h) (((b) * 2 + (h)) * HTB)
#define PG8_SB(b, h) ((4 + (b) * 2 + (h)) * HTB)
#define PG8_STAGE(bufoff, gbase, voff) do { _Pragma("unroll") for (int _i = 0; _i < 2; ++_i) \
        __builtin_amdgcn_global_load_lds((const unsigned*)((const char*)(gbase) + (voff)[_i]), (PG8_LAS unsigned*)(lds + (bufoff) + ldsw + _i * 8192), 16, 0, 0); } while (0)
#define PG8_LDA(dst, b, h) do { _Pragma("unroll") for (int m = 0; m < 4; ++m) _Pragma("unroll") for (int k = 0; k < 2; ++k) dst[m][k] = *(const PG8_LAS bf16x8*)(lds + PG8_SA(b, h) + aoff + m * 2048 + k * 1024); } while (0)
#define PG8_LDB(dst, b, h) do { _Pragma("unroll") for (int n = 0; n < 2; ++n) _Pragma("unroll") for (int k = 0; k < 2; ++k) dst[n][k] = *(const PG8_LAS bf16x8*)(lds + PG8_SB(b, h) + boff + n * 2048 + k * 1024); } while (0)
#define PG8_MMA(ai, bj, At, Bt) do { __builtin_amdgcn_s_setprio(1); _Pragma("unroll") for (int m = 0; m < 4; ++m) _Pragma("unroll") for (int n = 0; n < 2; ++n) _Pragma("unroll") for (int k = 0; k < 2; ++k) \
        acc[ai][bj][m][n] = __builtin_amdgcn_mfma_f32_16x16x32_bf16(Bt[n][k], At[m][k], acc[ai][bj][m][n], 0, 0, 0); __builtin_amdgcn_s_setprio(0); } while (0)
#define PG8_WAIT_V(n) asm volatile("s_waitcnt vmcnt(" #n ")" ::: "memory")
#define PG8_WAIT_L(n) asm volatile("s_waitcnt lgkmcnt(" #n ")" ::: "memory")
#define PG8_BAR __builtin_amdgcn_s_barrier()
#define PG8_SCHED __builtin_amdgcn_sched_barrier(0)
    Unit cur, nxt; int ui = 0;
    if (!S.next(0, cur)) return;
    f32x4 acc[2][2][4][2];
#pragma unroll
    for (int a = 0; a < 2; ++a)
#pragma unroll
        for (int b = 0; b < 2; ++b)
#pragma unroll
            for (int m = 0; m < 4; ++m)
#pragma unroll
                for (int n = 0; n < 2; ++n) acc[a][b][m][n] = (f32x4){0.f, 0.f, 0.f, 0.f};
    bf16x8 At[4][2], B0[2][2], B1[2][2];
    const char* cA = (const char*)g.A + (size_t)cur.pm * tstep; const char* cB = (const char*)g.Bt + (size_t)cur.pn * tstep;
    S.a_ready(cur);
    if constexpr (SP2) {
        PG8_STAGE(PG8_SB(0, 0), cB, voffB); PG8_STAGE(PG8_SB(0, 1), cB + hstep, voffB); PG8_STAGE(PG8_SA(0, 0), cA, voffA); PG8_STAGE(PG8_SA(0, 1), cA + hstep, voffA);
        if (wr == 1) PG8_BAR;
        PG8_WAIT_V(2); PG8_BAR;
        PG8_STAGE(PG8_SB(1, 0), cB + kstep, voffB); PG8_STAGE(PG8_SA(1, 0), cA + kstep, voffA); PG8_STAGE(PG8_SB(1, 1), cB + hstep + kstep, voffB);
        PG8_WAIT_V(6); PG8_BAR;
    } else {
        PG8_STAGE(PG8_SB(0, 0), cB, voffB); PG8_STAGE(PG8_SA(0, 0), cA, voffA); PG8_STAGE(PG8_SB(0, 1), cB + hstep, voffB); PG8_STAGE(PG8_SA(0, 1), cA + hstep, voffA);
        if (wr == 1) PG8_BAR;
        PG8_WAIT_V(4); PG8_BAR;
        PG8_STAGE(PG8_SB(1, 0), cB + kstep, voffB); PG8_STAGE(PG8_SA(1, 0), cA + kstep, voffA); PG8_STAGE(PG8_SB(1, 1), cB + hstep + kstep, voffB);
        PG8_WAIT_V(6); PG8_BAR;
    }
    for (;;) {
        const bool has_next = S.next(ui + 1, nxt);
        const char* nA = has_next ? (const char*)g.A + (size_t)nxt.pm * tstep : cA; const char* nB = has_next ? (const char*)g.Bt + (size_t)nxt.pn * tstep : cB;
        for (int t = 0; t < nt; t += 2) {
            const bool last = (t == nt - 2);
            const char* a1 = cA + (size_t)(t + 1) * kstep;
            const char* a2 = last ? nA : cA + (size_t)(t + 2) * kstep; const char* b2 = last ? nB : cB + (size_t)(t + 2) * kstep;
            const char* a3 = a2 + kstep; const char* b3 = b2 + kstep;
            if (last && has_next) S.a_ready(nxt);
            if constexpr (SP2) {
            PG8_LDB(B0, 0, 0); PG8_LDB(B1, 0, 1); PG8_SCHED; PG8_LDA(At, 0, 0); PG8_STAGE(PG8_SA(1, 1), a1 + hstep, voffA);
            PG8_WAIT_V(8); PG8_WAIT_L(0); PG8_BAR; PG8_MMA(0, 0, At, B0); PG8_MMA(0, 1, At, B1); PG8_BAR; PG8_SCHED;
            PG8_LDA(At, 0, 1); PG8_STAGE(PG8_SB(0, 0), b2, voffB); PG8_STAGE(PG8_SB(0, 1), b2 + hstep, voffB); PG8_STAGE(PG8_SA(0, 0), a2, voffA);
            PG8_WAIT_V(8); PG8_WAIT_L(0); PG8_BAR; PG8_MMA(1, 0, At, B0); PG8_MMA(1, 1, At, B1); PG8_BAR; PG8_SCHED;
            PG8_LDB(B0, 1, 0); PG8_LDB(B1, 1, 1); PG8_SCHED; PG8_LDA(At, 1, 0); PG8_STAGE(PG8_SA(0, 1), a2 + hstep, voffA);
            PG8_WAIT_V(8); PG8_WAIT_L(0); PG8_BAR; PG8_MMA(0, 0, At, B0); PG8_MMA(0, 1, At, B1); PG8_BAR; PG8_SCHED;
            PG8_LDA(At, 1, 1); PG8_STAGE(PG8_SB(1, 0), b3, voffB); PG8_STAGE(PG8_SB(1, 1), b3 + hstep, voffB); PG8_STAGE(PG8_SA(1, 0), a3, voffA);
            PG8_WAIT_V(8); PG8_WAIT_L(0); PG8_BAR; PG8_MMA(1, 0, At, B0); PG8_MMA(1, 1, At, B1); PG8_BAR; PG8_SCHED;
            } else {
            PG8_LDB(B0, 0, 0); PG8_SCHED; PG8_LDA(At, 0, 0); PG8_STAGE(PG8_SA(1, 1), a1 + hstep, voffA);
            PG8_WAIT_L(8); PG8_BAR; PG8_WAIT_L(0); PG8_MMA(0, 0, At, B0); PG8_BAR; PG8_SCHED;
            PG8_LDB(B1, 0, 1); PG8_STAGE(PG8_SB(0, 0), b2, voffB);
            PG8_BAR; PG8_WAIT_L(0); PG8_MMA(0, 1, At, B1); PG8_BAR;
            PG8_LDA(At, 0, 1); PG8_STAGE(PG8_SA(0, 0), a2, voffA);
            PG8_BAR; PG8_WAIT_L(0); PG8_MMA(1, 0, At, B0); PG8_BAR; PG8_SCHED;
            PG8_STAGE(PG8_SB(0, 1), b2 + hstep, voffB);
            PG8_WAIT_V(6); PG8_BAR; PG8_MMA(1, 1, At, B1); PG8_BAR;
            PG8_LDB(B0, 1, 0); PG8_SCHED; PG8_LDA(At, 1, 0); PG8_STAGE(PG8_SA(0, 1), a2 + hstep, voffA);
            PG8_WAIT_L(8); PG8_BAR; PG8_WAIT_L(0); PG8_MMA(0, 0, At, B0); PG8_BAR; PG8_SCHED;
            PG8_LDB(B1, 1, 1); PG8_STAGE(PG8_SB(1, 0), b3, voffB);
            PG8_BAR; PG8_WAIT_L(0); PG8_MMA(0, 1, At, B1); PG8_BAR;
            PG8_LDA(At, 1, 1); PG8_STAGE(PG8_SA(1, 0), a3, voffA);
            PG8_BAR; PG8_WAIT_L(0); PG8_MMA(1, 0, At, B0); PG8_BAR; PG8_SCHED;
            PG8_STAGE(PG8_SB(1, 1), b3 + hstep, voffB);
            PG8_WAIT_V(6); PG8_BAR; PG8_MMA(1, 1, At, B1); PG8_BAR;
            }
        }
        if constexpr (ALIGN_EPI) { if (wr == 0) PG8_BAR; }
        if constexpr (!Epi::AFTER_DRAIN) { E(acc, cur, wr, wc, fr, fq); S.done(cur); }
        if (!has_next) break;
#pragma unroll
        for (int a = 0; a < 2; ++a)
#pragma unroll
            for (int b = 0; b < 2; ++b)
#pragma unroll
                for (int m = 0; m < 4; ++m)
#pragma unroll
                    for (int n = 0; n < 2; ++n) acc[a][b][m][n] = (f32x4){0.f, 0.f, 0.f, 0.f};
        cur = nxt; cA = nA; cB = nB; ++ui;
        if constexpr (ALIGN_EPI) { if (wr == 1) PG8_BAR; }
    }
    PG8_WAIT_V(0);
    if constexpr (!ALIGN_EPI) { if (wr == 0) PG8_BAR; }
    PG8_BAR;
    if constexpr (Epi::AFTER_DRAIN) { E.fused(acc, cur, wr, wc, fr, fq, lds, wid, lane); S.done(cur); }
#undef PG8_SA
#undef PG8_SB
#undef PG8_STAGE
#undef PG8_LDA
#undef PG8_LDB
#undef PG8_MMA
#undef PG8_WAIT_V
#undef PG8_WAIT_L
#undef PG8_BAR
#undef PG8_SCHED
}
}
#include <hip/hip_bf16.h>
#include <cmath>
namespace attn_body {
using bf16=__hip_bfloat16;
using bf16x8=__attribute__((ext_vector_type(8)))short;
using s16x4=__attribute__((ext_vector_type(4)))short;
using f32x16=__attribute__((ext_vector_type(16)))float;
using u32x4=__attribute__((ext_vector_type(4)))unsigned;
constexpr int BATCH=16,NHEAD=8,SEQ=4096,D=64,DM=NHEAD*D;
constexpr int NW=8,QBLK=32,QB=QBLK*NW,KVBLK=64,NQB=SEQ/QB;
constexpr int ATTN_PITCH=DM, ATTN_UNIT_ROWS=QB;
__device__ __forceinline__ int crow(int r,int hi){return (r&3)+8*(r>>2)+4*hi;}
#define SBAR() __builtin_amdgcn_sched_barrier(0)
__device__ __forceinline__ void cmask(f32x16&p0,f32x16&p1,int jb,int qrel,int hi){
  const float NEG=-INFINITY; int kb=64*jb+4*hi;
  #pragma unroll
  for(int r=0;r<16;++r){int kv=kb+(r&3)+8*(r>>2); if(kv>qrel)p0[r]=NEG; if(kv+32>qrel)p1[r]=NEG;}
}

constexpr int NSLOT=3, SLOTB=8192;
constexpr int LDS_K=0, LDS_V=NSLOT*SLOTB, LDS_WS=2*NSLOT*SLOTB, LDS_OST=LDS_WS+NW*64*4, LDS_BIAS=LDS_OST+NW*4096, LDS_BYTES=LDS_BIAS+SEQ*4;
constexpr float C2=0.125f*1.4426950408889634f;
__device__ __forceinline__ void glds16(const void*gsrc,unsigned lds_dst){unsigned keep;
  asm volatile("s_mov_b32 %0, m0\n\ts_mov_b32 m0, %2\n\ts_nop 0\n\tglobal_load_lds_dwordx4 %1, off\n\ts_mov_b32 m0, %0":"=&s"(keep):"v"(gsrc),"s"(lds_dst):"memory");}
__device__ __forceinline__ float max3f(float a,float b,float c){float r;asm("v_max3_f32 %0, %1, %2, %3":"=v"(r):"v"(a),"v"(b),"v"(c));return r;}
__device__ __forceinline__ float max2f(float a,float b){float r;asm("v_max_f32_e32 %0, %1, %2":"=v"(r):"v"(a),"v"(b));return r;}
__device__ __forceinline__ float fadd_s(float a,float b){float r;asm("v_add_f32_e32 %0, %1, %2":"=v"(r):"v"(a),"v"(b));return r;}
__device__ __forceinline__ float fsub_s(float a,float b){float r;asm("v_sub_f32_e32 %0, %1, %2":"=v"(r):"v"(a),"v"(b));return r;}
typedef float f32x4_t __attribute__((ext_vector_type(4))); typedef float f32x2_t __attribute__((ext_vector_type(2))); typedef __bf16 bf16x2_t __attribute__((ext_vector_type(2)));
__device__ __forceinline__ unsigned cvtpk_s(float lo,float hi){f32x2_t v={lo,hi};bf16x2_t b=__builtin_convertvector(v,bf16x2_t);return __builtin_bit_cast(unsigned,b);}
#define WAIT_BAR(N) asm volatile("s_waitcnt vmcnt(" #N ") lgkmcnt(0)\n\ts_barrier":::"memory")

__device__ __forceinline__ void qkt(f32x16&p0,f32x16&p1,const char*Kslot,const bf16x8*qr,const f32x16&negm,int r32,int hi){
  const char*kb=Kslot+hi*1024+r32*16;
  #pragma unroll
  for(int d0=0;d0<4;++d0){
    const bf16x8 b0=*reinterpret_cast<const bf16x8*>(kb+d0*2048);
    const bf16x8 b1=*reinterpret_cast<const bf16x8*>(kb+d0*2048+512);
    if(d0==0){p0=__builtin_amdgcn_mfma_f32_32x32x16_bf16(b0,qr[0],negm,0,0,0);p1=__builtin_amdgcn_mfma_f32_32x32x16_bf16(b1,qr[0],negm,0,0,0);}
    else{p0=__builtin_amdgcn_mfma_f32_32x32x16_bf16(b0,qr[d0],p0,0,0,0);p1=__builtin_amdgcn_mfma_f32_32x32x16_bf16(b1,qr[d0],p1,0,0,0);}}
}
typedef __attribute__((address_space(3))) const char* lds_cptr;
typedef short v4i16_t __attribute__((ext_vector_type(4)));
__device__ __forceinline__ void kload8(bf16x8*kf,lds_cptr kp){
  kf[0]=*(const __attribute__((address_space(3))) bf16x8*)(kp);      kf[1]=*(const __attribute__((address_space(3))) bf16x8*)(kp+512);
  kf[2]=*(const __attribute__((address_space(3))) bf16x8*)(kp+2048); kf[3]=*(const __attribute__((address_space(3))) bf16x8*)(kp+2560);
  kf[4]=*(const __attribute__((address_space(3))) bf16x8*)(kp+4096); kf[5]=*(const __attribute__((address_space(3))) bf16x8*)(kp+4608);
  kf[6]=*(const __attribute__((address_space(3))) bf16x8*)(kp+6144); kf[7]=*(const __attribute__((address_space(3))) bf16x8*)(kp+6656);
}
__device__ __forceinline__ void kload2(bf16x8*kf,lds_cptr kp,int j){ kf[2*j]=*(const __attribute__((address_space(3))) bf16x8*)(kp+j*2048); kf[2*j+1]=*(const __attribute__((address_space(3))) bf16x8*)(kp+j*2048+512); }
__device__ __forceinline__ s16x4 vtr(lds_cptr p){ return __builtin_bit_cast(s16x4,__builtin_amdgcn_ds_read_tr16_b64_v4i16((__attribute__((address_space(3))) v4i16_t*)p)); }
__device__ __forceinline__ float rowmax(const f32x16&p0,const f32x16&p1){
  float a=max3f(p0[0],p0[1],p1[0]),b=max3f(p0[2],p0[3],p1[1]);a=max3f(a,p1[2],p1[3]);
  #pragma unroll
  for(int r=4;r<16;r+=4){a=max3f(a,p0[r],p0[r+1]);b=max3f(b,p0[r+2],p0[r+3]);a=max3f(a,p1[r],p1[r+1]);b=max3f(b,p1[r+2],p1[r+3]);}
  const float m=max2f(a,b);
  auto rr=__builtin_amdgcn_permlane32_swap(__float_as_uint(m),__float_as_uint(m),false,false);
  return max2f(__uint_as_float(rr[0]),__uint_as_float(rr[1]));
}
__device__ __forceinline__ void pv(f32x16*o,int vb,bf16x8 pa0,bf16x8 pa1,bf16x8 pa2,bf16x8 pa3){
  #pragma unroll
  for(int d0=0;d0<2;++d0){s16x4 lo[4],hi[4];
    #pragma unroll
    for(int ks=0;ks<4;++ks){
      asm volatile("ds_read_b64_tr_b16 %0,%1 offset:%c2":"=&v"(lo[ks]):"v"(vb),"i"(d0*4096+ks*1024):"memory");
      asm volatile("ds_read_b64_tr_b16 %0,%1 offset:%c2":"=&v"(hi[ks]):"v"(vb),"i"(d0*4096+ks*1024+512):"memory");}
    asm volatile("s_waitcnt lgkmcnt(0)":::"memory");SBAR();
    #define PK(k) (bf16x8){lo[k][0],lo[k][1],lo[k][2],lo[k][3],hi[k][0],hi[k][1],hi[k][2],hi[k][3]}
    o[d0]=__builtin_amdgcn_mfma_f32_32x32x16_bf16(pa0,PK(0),o[d0],0,0,0);
    o[d0]=__builtin_amdgcn_mfma_f32_32x32x16_bf16(pa1,PK(1),o[d0],0,0,0);
    o[d0]=__builtin_amdgcn_mfma_f32_32x32x16_bf16(pa2,PK(2),o[d0],0,0,0);
    o[d0]=__builtin_amdgcn_mfma_f32_32x32x16_bf16(pa3,PK(3),o[d0],0,0,0);
    #undef PK
  }
}

#ifndef ATTN_STORE16
#define ATTN_STORE16(p,v) (*(u32x4*)(p)=(v))
#endif
template<int THRL> __device__ __forceinline__ void attn_unit(int b,int h,int qb,const bf16*Q,const bf16*__restrict__ K,const bf16*__restrict__ V,bf16*O,const float*__restrict__ BIASG,char*shm){
  int tid_=threadIdx.x; asm volatile("":"+v"(tid_)); const int tid=tid_,lane=tid&63,r32=lane&31,hi=lane>>5; const int wid=__builtin_amdgcn_readfirstlane(tid>>6);
  const long rowbase=(long)b*SEQ; const int q0=qb*QB;
  const bf16*Qw=Q+(rowbase+q0+wid*QBLK)*DM+h*D;
  const bf16*Kh=K+rowbase*DM+h*D,*Vh=V+rowbase*DM+h*D;
  const lds_cptr shm3=(lds_cptr)shm;
  const unsigned lds0=(unsigned)(uintptr_t)shm;
  float*wsf=(float*)(shm+LDS_WS)+wid*64;
  const bf16*ksrc=Kh+(long)lane*DM+wid*8;
  const bf16*vsrc=Vh+(long)(16*(wid&3)+(lane>>2))*DM+(wid>>2)*32+(lane&3)*8;
  const unsigned kdst=lds0+LDS_K+wid*1024, vdst=lds0+LDS_V+wid*1024;
  #define DMA_K(t,slot) glds16(ksrc+(long)(t)*KVBLK*DM,(unsigned)__builtin_amdgcn_readfirstlane(kdst+(slot)))
  #define DMA_V(t,slot) glds16(vsrc+(long)(t)*KVBLK*DM,(unsigned)__builtin_amdgcn_readfirstlane(vdst+(slot)))
  const int vb0=(int)(lds0+LDS_V)+((lane>>4)&1)*32+(lane&3)*8+(4*hi+((lane&15)>>2))*64;
  const char*Kbase=shm+LDS_K; bf16x8 kf[8];
  const lds_cptr kp0=shm3+LDS_K+hi*1024+r32*16; const lds_cptr vp0=shm3+LDS_V+((lane>>4)&1)*32+(lane&3)*8+(4*hi+((lane&15)>>2))*64;
  const int NT=(q0+QB)/KVBLK;
  const __attribute__((address_space(3))) float*biasl=(const __attribute__((address_space(3))) float*)(shm3+LDS_BIAS)+4*hi;
  #define ADDB(P0,P1,t) do{ const __attribute__((address_space(3))) float*bp_=biasl+64*(t); \
    _Pragma("unroll") for(int j_=0;j_<4;++j_){ const f32x4_t b0_=*(const __attribute__((address_space(3))) f32x4_t*)(bp_+8*j_), b1_=*(const __attribute__((address_space(3))) f32x4_t*)(bp_+32+8*j_); \
      _Pragma("unroll") for(int e_=0;e_<4;++e_){ P0[4*j_+e_]+=b0_[e_]; P1[4*j_+e_]+=b1_[e_]; } } }while(0)
  DMA_K(0,0);DMA_V(0,0);DMA_K(1,SLOTB);
  bf16x8 qr[4];
  #pragma unroll
  for(int d0=0;d0<4;++d0)qr[d0]=*reinterpret_cast<const bf16x8*>(&Qw[(long)r32*DM+d0*16+hi*8]);
  float mhat=0.f,l_reg=0.f;f32x16 o[2];o[0]=f32x16{};o[1]=f32x16{};f32x16 negm=f32x16{};asm volatile("":"+v"(negm));
  const int qrel=wid*QBLK+r32;
  #define CMASK(P0,P1,t) do{int jb_=(t)-(NT-4); if(jb_>=0)cmask(P0,P1,jb_,qrel,hi);}while(0)
  bool resc=false;
  #define START(P0,P1) do{ const float rm=rowmax(P0,P1); resc=false; \
    { const float dl=rm; mhat=fadd_s(mhat,dl); \
      _Pragma("unroll") for(int r=0;r<16;++r){P0[r]=fsub_s(P0[r],dl);P1[r]=fsub_s(P1[r],dl);} \
      _Pragma("unroll") for(int r=0;r<16;++r)negm[r]=-mhat; asm volatile("":"+v"(negm)); } \
    _Pragma("unroll") for(int r=0;r<16;++r)P0[r]=__builtin_amdgcn_exp2f(P0[r]); }while(0)
  #define RESC() do{ if(resc){ asm volatile("s_waitcnt lgkmcnt(0)":::"memory"); \
      _Pragma("unroll") for(int d_=0;d_<2;++d_) _Pragma("unroll") for(int r=0;r<16;++r)o[d_][r]*=wsf[crow(r,hi)]; } }while(0)
  f32x16 pA0,pA1,pB0,pB1;
  int sl_prev=0,sl_cur=0,sl_next=SLOTB;
  #define ROT() do{sl_prev=sl_cur;sl_cur=sl_next;sl_next=(sl_next==(NSLOT-1)*SLOTB)?0:sl_next+SLOTB;}while(0)
  DMA_K(2,2*SLOTB);
  { const float*gb=BIASG+(long)(b*NHEAD+h)*SEQ; __attribute__((address_space(3))) float*bl=(__attribute__((address_space(3))) float*)(shm3+LDS_BIAS);
    static_assert(SEQ==2*NW*64*4,"two 16-byte pieces per thread cover the sequence");
    const int i0_=tid*4,i1_=tid*4+NW*64*4; const bool p0_=i0_<q0+QB,p1_=i1_<q0+QB;
    f32x4_t v0_={0.f,0.f,0.f,0.f},v1_={0.f,0.f,0.f,0.f}; if(p0_)v0_=*(const f32x4_t*)(gb+i0_); if(p1_)v1_=*(const f32x4_t*)(gb+i1_);
    if(p0_)*(__attribute__((address_space(3))) f32x4_t*)(bl+i0_)=v0_; if(p1_)*(__attribute__((address_space(3))) f32x4_t*)(bl+i1_)=v1_; }
  WAIT_BAR(3);
  qkt(pA0,pA1,Kbase,qr,negm,r32,hi);asm volatile("s_nop 15\n\ts_nop 7":"+v"(pA0),"+v"(pA1));ADDB(pA0,pA1,0);CMASK(pA0,pA1,0);
  START(pA0,pA1);
  _Pragma("unroll") for(int r=0;r<16;++r)pA1[r]=__builtin_amdgcn_exp2f(pA1[r]);
  WAIT_BAR(0);
  DMA_K(3,0);DMA_V(1,SLOTB);
  ROT();
  kload8(kf,kp0+sl_cur);
  WAIT_BAR(2);
  s16x4 vlo[8],vhi[8]; u32x4 pw0,pw1,pw2,pw3;
  #define PKW(P,B) cvtpk_s(P[B],P[B+1])
  #define PAF(k) __builtin_bit_cast(bf16x8,pw##k)
  #define VFR(i) (bf16x8){vlo[i][0],vlo[i][1],vlo[i][2],vlo[i][3],vhi[i][0],vhi[i][1],vhi[i][2],vhi[i][3]}
  #define PIN(x) asm volatile("":"+v"(x))
  #define MX3(a,b,c) __builtin_fmaxf(__builtin_fmaxf((a),(b)),(c))
  #define GAPA(MF,A0,A1,A2,A3,W0,W1,PW) do{ MF; sacc+=A0; sacc+=A1; sacc+=A2; sacc+=A3; PIN(sacc); W0; W1; PIN(PW); SBAR(); }while(0)
  #define EX(v) __builtin_amdgcn_exp2f(v)
  #define GAPB(MF,X,B) do{ MF; X[B]=EX(X[B]); X[B+1]=EX(X[B+1]); X[B+2]=EX(X[B+2]); X[B+3]=EX(X[B+3]); PIN(X); SBAR(); }while(0)
  #define VRD(i) do{ vlo[i]=vtr(vp_+(((i)>>2)*4096+((i)&3)*1024)); vhi[i]=vtr(vp_+(((i)>>2)*4096+((i)&3)*1024+512)); }while(0)
  #define KRD(G,j) do{ if(G){ kload2(kf,kp0+sl_next,j); SBAR(); } }while(0)
  #define LDB4(off) (*(const __attribute__((address_space(3))) f32x4_t*)(bp_+(off)))
  #define BL0(t) do{ const __attribute__((address_space(3))) float*bp_=biasl+64*(t); bA0=LDB4(0); bA1=LDB4(8); bA2=LDB4(16); bA3=LDB4(24); }while(0)
  #define BL1(t) do{ const __attribute__((address_space(3))) float*bp_=biasl+64*(t); bB0=LDB4(32); bB1=LDB4(40); bB2=LDB4(48); bB3=LDB4(56); }while(0)
  #define BADD(C0,C1) do{ _Pragma("unroll") for(int e_=0;e_<4;++e_){ C0[e_]+=bA0[e_]; C0[4+e_]+=bA1[e_]; C0[8+e_]+=bA2[e_]; C0[12+e_]+=bA3[e_]; C1[e_]+=bB0[e_]; C1[4+e_]+=bB1[e_]; C1[8+e_]+=bB2[e_]; C1[12+e_]+=bB3[e_]; } }while(0)
  #define STEP(C0,C1,P0,P1,t,GK,GV,GL) do{ SBAR(); f32x4_t bA0,bA1,bA2,bA3,bB0,bB1,bB2,bB3; \
    const lds_cptr vp_=vp0+sl_prev; \
    VRD(0); SBAR(); float sacc=(P0[0]+P0[1]); \
    GAPA(C0=__builtin_amdgcn_mfma_f32_32x32x16_bf16(kf[0],qr[0],negm,0,0,0), P0[2],P0[3],P0[4],P0[5],     pw0[0]=PKW(P0,0), pw0[1]=PKW(P0,2), pw0); \
    VRD(4); SBAR(); GAPA(C1=__builtin_amdgcn_mfma_f32_32x32x16_bf16(kf[1],qr[0],negm,0,0,0), P0[6],P0[7],P0[8],P0[9],     pw0[2]=PKW(P0,4), pw0[3]=PKW(P0,6), pw0); \
    VRD(1); SBAR(); GAPA(C0=__builtin_amdgcn_mfma_f32_32x32x16_bf16(kf[2],qr[1],C0,0,0,0),   P0[10],P0[11],P0[12],P0[13], pw1[0]=PKW(P0,8), pw1[1]=PKW(P0,10), pw1); \
    VRD(5); SBAR(); GAPA(C1=__builtin_amdgcn_mfma_f32_32x32x16_bf16(kf[3],qr[1],C1,0,0,0),   P0[14],P0[15],P1[0],P1[1],   pw1[2]=PKW(P0,12),pw1[3]=PKW(P0,14), pw1); \
    VRD(2); SBAR(); GAPA(C0=__builtin_amdgcn_mfma_f32_32x32x16_bf16(kf[4],qr[2],C0,0,0,0),   P1[2],P1[3],P1[4],P1[5],     pw2[0]=PKW(P1,0), pw2[1]=PKW(P1,2), pw2); \
    VRD(6); SBAR(); GAPA(C1=__builtin_amdgcn_mfma_f32_32x32x16_bf16(kf[5],qr[2],C1,0,0,0),   P1[6],P1[7],P1[8],P1[9],     pw2[2]=PKW(P1,4), pw2[3]=PKW(P1,6), pw2); \
    VRD(3); SBAR(); GAPA(C0=__builtin_amdgcn_mfma_f32_32x32x16_bf16(kf[6],qr[3],C0,0,0,0),   P1[10],P1[11],P1[12],P1[13], pw3[0]=PKW(P1,8), pw3[1]=PKW(P1,10), pw3); \
    BL0(t); SBAR(); \
    VRD(7); SBAR(); GAPA(C1=__builtin_amdgcn_mfma_f32_32x32x16_bf16(kf[7],qr[3],C1,0,0,0),   P1[14],P1[15],0.f,0.f,       pw3[2]=PKW(P1,12),pw3[3]=PKW(P1,14), pw3); \
    BL1(t); SBAR(); \
    l_reg+=sacc; \
    if(GK){DMA_K((t)+3,sl_cur);} if(GV){DMA_V((t)+1,sl_next);} \
    BADD(C0,C1); CMASK(C0,C1,t); \
    { float a=MX3(C0[0],C0[1],C1[0]),b=MX3(C0[2],C0[3],C1[1]); a=MX3(a,C1[2],C1[3]); \
      _Pragma("unroll") for(int r=4;r<16;r+=4){a=MX3(a,C0[r],C0[r+1]);b=MX3(b,C0[r+2],C0[r+3]);a=MX3(a,C1[r],C1[r+1]);b=MX3(b,C1[r+2],C1[r+3]);} \
      float rm=__builtin_fmaxf(a,b); { auto rr=__builtin_amdgcn_permlane32_swap(__float_as_uint(rm),__float_as_uint(rm),false,false); rm=__builtin_fmaxf(__uint_as_float(rr[0]),__uint_as_float(rr[1])); } \
      resc=false; \
      if(__builtin_expect(__any(rm>(float)THRL),0)){ const float dl=__builtin_fmaxf(rm,0.f); mhat+=dl; \
        _Pragma("unroll") for(int r=0;r<16;++r){C0[r]-=dl;C1[r]-=dl;} \
        _Pragma("unroll") for(int r=0;r<16;++r)negm[r]=-mhat; asm volatile("":"+v"(negm)); \
        const float f=__builtin_amdgcn_exp2f(-dl); l_reg*=f; if(hi==0)wsf[r32]=f; resc=true; } } \
    SBAR(); \
    GAPB(o[0]=__builtin_amdgcn_mfma_f32_32x32x16_bf16(PAF(0),VFR(0),o[0],0,0,0), C0,0); \
    GAPB(o[1]=__builtin_amdgcn_mfma_f32_32x32x16_bf16(PAF(0),VFR(4),o[1],0,0,0), C0,4); \
    KRD(GL,0); GAPB(o[0]=__builtin_amdgcn_mfma_f32_32x32x16_bf16(PAF(1),VFR(1),o[0],0,0,0), C0,8); \
    KRD(GL,1); GAPB(o[1]=__builtin_amdgcn_mfma_f32_32x32x16_bf16(PAF(1),VFR(5),o[1],0,0,0), C0,12); \
    KRD(GL,2); GAPB(o[0]=__builtin_amdgcn_mfma_f32_32x32x16_bf16(PAF(2),VFR(2),o[0],0,0,0), C1,0); \
    KRD(GL,3); GAPB(o[1]=__builtin_amdgcn_mfma_f32_32x32x16_bf16(PAF(2),VFR(6),o[1],0,0,0), C1,4); \
    GAPB(o[0]=__builtin_amdgcn_mfma_f32_32x32x16_bf16(PAF(3),VFR(3),o[0],0,0,0), C1,8); \
    GAPB(o[1]=__builtin_amdgcn_mfma_f32_32x32x16_bf16(PAF(3),VFR(7),o[1],0,0,0), C1,12); \
    }while(0)
  int t=1;
  #undef CMASK
  #define CMASK(P0,P1,t) do{}while(0)
  for(;t+5<NT;t+=2){
    STEP(pB0,pB1,pA0,pA1,t,true,true,true);     WAIT_BAR(2); RESC(); ROT();
    STEP(pA0,pA1,pB0,pB1,t+1,true,true,true);   WAIT_BAR(2); RESC(); ROT();
  }
  #undef CMASK
  #define CMASK(P0,P1,t) do{int jb_=(t)-(NT-4); if(jb_>=0)cmask(P0,P1,jb_,qrel,hi);}while(0)
  #define ENDW(tt) do{ if((tt)+3<NT){WAIT_BAR(2);} else if((tt)+2<NT){WAIT_BAR(1);} else {WAIT_BAR(0);} }while(0)
  for(;t+1<NT;t+=2){
    STEP(pB0,pB1,pA0,pA1,t,(t+3<NT),(t+1<NT),(t+1<NT));       ENDW(t);   RESC(); ROT();
    STEP(pA0,pA1,pB0,pB1,t+1,(t+4<NT),(t+2<NT),(t+2<NT));     ENDW(t+1); RESC(); ROT();
  }
  STEP(pB0,pB1,pA0,pA1,NT-1,false,false,false); RESC();
  { float sacc=pB0[0]+pB0[1]; _Pragma("unroll") for(int r=2;r<16;++r)sacc+=pB0[r]; _Pragma("unroll") for(int r=0;r<16;++r)sacc+=pB1[r]; l_reg+=sacc;
    pw0=(u32x4){PKW(pB0,0),PKW(pB0,2),PKW(pB0,4),PKW(pB0,6)};pw1=(u32x4){PKW(pB0,8),PKW(pB0,10),PKW(pB0,12),PKW(pB0,14)};pw2=(u32x4){PKW(pB1,0),PKW(pB1,2),PKW(pB1,4),PKW(pB1,6)};pw3=(u32x4){PKW(pB1,8),PKW(pB1,10),PKW(pB1,12),PKW(pB1,14)};
    SBAR(); pv(o,vb0+sl_cur,PAF(0),PAF(1),PAF(2),PAF(3)); }
  #undef PKW
  #undef PAF
  #undef VFR
  #undef PIN
  #undef MX3
  #undef GAPA
  #undef GAPB
  #undef EX
  #undef VRD
  #undef KRD
  #undef STEP
  #undef ENDW
  {auto rr=__builtin_amdgcn_permlane32_swap(__float_as_uint(l_reg),__float_as_uint(l_reg),false,false);l_reg=__uint_as_float(rr[0])+__uint_as_float(rr[1]);}
  if(hi==0)wsf[32+r32]=l_reg;asm volatile("s_waitcnt lgkmcnt(0)":::"memory");
  float rli[16];
  #pragma unroll
  for(int r=0;r<16;++r)rli[r]=__builtin_amdgcn_rcpf(wsf[32+crow(r,hi)]);
  bf16*Ow=O+(rowbase+q0+wid*QBLK)*DM+h*D;
  { bf16*stg=(bf16*)(shm+LDS_OST)+wid*2048;
    #pragma unroll
    for(int r=0;r<16;++r){const int orow=crow(r,hi);
      #pragma unroll
      for(int d0=0;d0<2;++d0)stg[orow*64+d0*32+r32]=__float2bfloat16(o[d0][r]*rli[r]);}
    asm volatile("s_waitcnt lgkmcnt(0)":::"memory");
    #pragma unroll
    for(int i=0;i<4;++i){const int row=i*8+(lane>>3),ch=lane&7; const u32x4 v=*(const u32x4*)(stg+row*64+ch*8); ATTN_STORE16(Ow+(long)row*DM+ch*8,v);} }
  asm volatile("s_waitcnt lgkmcnt(0)\n\ts_barrier":::"memory");
  #undef ADDB
  #undef LDB4
  #undef BL0
  #undef BL1
  #undef BADD
  #undef DMA_K
  #undef DMA_V
  #undef CMASK
  #undef START
  #undef RESC
  #undef ROT
}
constexpr int ATTN_LDS_BYTES=LDS_BYTES;
struct AttnTensors { const bf16* Q; const bf16* K; const bf16* V; bf16* O; const float* BIAS; };
struct AttnUnit { int bh; int qb; };
struct StaticOrder {
  int vcu, grid;
  __device__ __forceinline__ explicit StaticOrder(int grid_,int block):vcu((grid_%8==0)?(block%8)*(grid_/8)+block/8:block),grid(grid_){}
  __device__ __forceinline__ bool next(int i,AttnUnit&u)const{ const int I=vcu+(i>>1)*grid; if(I>=BATCH*NHEAD*(NQB/2))return false; const int j=I%(NQB/2); u.bh=I/(NQB/2); u.qb=(i&1)?(NQB-1-j):j; return true; }
  __device__ __forceinline__ void a_ready(const AttnUnit&)const{}
  __device__ __forceinline__ void done(const AttnUnit&)const{}
};
template<class Sched,int THRL=64> __device__ __forceinline__ void attn_phase(char*lds,const AttnTensors&T,const Sched&S){
  AttnUnit u;
  for(int i=0;S.next(i,u);++i){ S.a_ready(u); attn_unit<THRL>(u.bh/NHEAD,u.bh%NHEAD,u.qb,T.Q,T.K,T.V,T.O,T.BIAS,lds); S.done(u); }
}
#undef SBAR
#undef WAIT_BAR
}
namespace cg = cooperative_groups;
constexpr int NWAVES = 8;
constexpr int BATCH = 16, SEQ = 4096, DMOD = 1024, DEPTH = 4, NHEADS = 8, AW = 512, SW = 512, NGRP = 32, GCH = 16, NST = 64, FF = 4096, NIN = 4104;
constexpr int M = BATCH * SEQ;
constexpr int CL = 16;
constexpr int NCR = M / CL;
constexpr int ASK = 384;
constexpr float RMS_EPS = 1e-6f;

constexpr size_t MiB = 1u << 20;
constexpr size_t WS_CTL = 0, CTL_ZERO_BYTES = 65536, WS_BARW = 16384;
constexpr int MISC_OFF = 131072 + 320;
constexpr size_t WS_WIN = 1 * MiB, WS_WUP = 9 * MiB, WS_WDN = 17 * MiB, WS_WOUT = 25 * MiB, WS_WA = 27 * MiB, WS_WB = 28 * MiB, WS_WGLU = 29 * MiB;
constexpr size_t WS_WSB = 30 * MiB, WS_WSY = 54 * MiB, WS_LPOW = 78 * MiB, SSM_W_LAYER = 6 * MiB;
constexpr size_t WS_LOGF = 79 * MiB, WS_BIAS = 81 * MiB;
constexpr size_t WS_H = 84 * MiB;
constexpr size_t WS_Q = 212 * MiB, WS_K = 276 * MiB, WS_V = 340 * MiB;
constexpr size_t WS_AS = 404 * MiB, WS_SLOC = 500 * MiB;
constexpr size_t WS_GA = 564 * MiB, WS_GB = 692 * MiB;
constexpr size_t WS_HID = 212 * MiB;
constexpr size_t WS_YB = WS_SLOC, WS_YB2 = WS_Q;
constexpr size_t WS_XB = 820 * MiB, WS_END = 948 * MiB;

constexpr int LDS_BYTES = 147456;
#define LAS __attribute__((address_space(3)))
typedef unsigned short bf16;
typedef unsigned v4u __attribute__((ext_vector_type(4)));
typedef float f32x4 __attribute__((ext_vector_type(4)));

__device__ __forceinline__ unsigned f2bf(float f) { unsigned u = __builtin_bit_cast(unsigned, f); return (u + 0x7fffu + ((u >> 16) & 1u)) >> 16; }
__device__ __forceinline__ unsigned pk2(float lo, float hi) { return f2bf(lo) | (f2bf(hi) << 16); }
__device__ __forceinline__ float wave_sum(float v, int lane) {
#pragma unroll
    for (int o = 1; o < 64; o <<= 1) v += __int_as_float(__builtin_amdgcn_ds_bpermute((lane ^ o) << 2, __float_as_int(v)));
    return v;
}
__device__ __forceinline__ void transpose_item(const float* W, int ldw, int K, int nblk, bf16* WT, int dst_row0, int src_col0, LAS float* scr, int item, int lane) {
    const int kb = item / nblk, nb = item % nblk, k0 = 64 * kb, n0 = 32 * nb;
    float vals[32];
#pragma unroll
    for (int i = 0; i < 32; ++i) { const int kk = 2 * i + (lane >> 5); vals[i] = W[(size_t)(k0 + kk) * ldw + src_col0 + n0 + (lane & 31)]; }
#pragma unroll
    for (int i = 0; i < 32; ++i) { const int kk = 2 * i + (lane >> 5); scr[kk * 33 + (lane & 31)] = vals[i]; }
    asm volatile("s_waitcnt lgkmcnt(0)" ::: "memory");
    const int c = lane & 7;
#pragma unroll
    for (int j = 0; j < 4; ++j) { const int n = (lane >> 3) + 8 * j; const LAS float* s = scr + (8 * c) * 33 + n;
        v4u o; o.x = pk2(s[0 * 33], s[1 * 33]); o.y = pk2(s[2 * 33], s[3 * 33]); o.z = pk2(s[4 * 33], s[5 * 33]); o.w = pk2(s[6 * 33], s[7 * 33]);
        *(v4u*)(WT + (size_t)(dst_row0 + n0 + n) * K + k0 + 8 * c) = o; }
    asm volatile("s_waitcnt lgkmcnt(0)" ::: "memory");
}

struct Args { const float* in[21]; float* out; unsigned char* ws; };

__device__ __forceinline__ void ssm_tables(const Args& a, int l, int g, unsigned char* ws, LAS unsigned char* lds, int tid) {
    typedef float f2 __attribute__((ext_vector_type(2)));
    LAS f2* P = (LAS f2*)lds;
    LAS f2* Qv = P + 17 * 64;
    LAS f2* Bb = Qv + 64;
    LAS f2* Cc = Bb + 64 * 16;
    LAS float* Km = (LAS float*)(Cc + 16 * 64);
    const float* lam_re = a.in[4] + (size_t)(l * NGRP + g) * NST; const float* lam_im = a.in[5] + (size_t)(l * NGRP + g) * NST;
    const float logdt = a.in[6][l * NGRP + g];
    const float* b_re = a.in[7] + (size_t)(l * NGRP + g) * NST * GCH; const float* b_im = a.in[8] + (size_t)(l * NGRP + g) * NST * GCH;
    const float* c_re = a.in[9] + (size_t)(l * NGRP + g) * GCH * NST; const float* c_im = a.in[10] + (size_t)(l * NGRP + g) * GCH * NST;
    const float* dsk = a.in[11] + (size_t)l * SW + g * GCH;
    const double dt = exp((double)logdt);
    for (int it = tid; it < 17 * 64; it += NWAVES * 64) { const int j = it >> 6, p = it & 63;
        const double ar = (double)lam_re[p] * dt, ai = (double)lam_im[p] * dt; const double mg = exp(ar * j), an = ai * j;
        const double pr = mg * cos(an), pi = mg * sin(an); P[it] = (f2){(float)pr, (float)pi};
        if (j == 1) { const double lr = lam_re[p], li = lam_im[p], nr = pr - 1.0, ni = pi, den = lr * lr + li * li;
            Qv[p] = (f2){(float)((nr * lr + ni * li) / den), (float)((ni * lr - nr * li) / den)}; } }
    __syncthreads();
    for (int it = tid; it < 1024; it += NWAVES * 64) { const int p = it >> 4; const f2 q = Qv[p]; const float br = b_re[it], bi = b_im[it];
        Bb[it] = (f2){q.x * br - q.y * bi, q.x * bi + q.y * br}; Cc[it] = (f2){c_re[it], c_im[it]}; }
    __syncthreads();
    for (int e = tid; e < 4096; e += NWAVES * 64) { const int ck = e & 15, c = (e >> 4) & 15, j = e >> 8; float s = 0.f;
#pragma unroll 16
        for (int p = 0; p < 64; ++p) { const f2 cc = Cc[c * 64 + p], pp = P[j * 64 + p], bb = Bb[p * 16 + ck];
            const float xr = cc.x * pp.x - cc.y * pp.y, xi = cc.x * pp.y + cc.y * pp.x; s += xr * bb.x - xi * bb.y; }
        Km[e] = s; }
    __syncthreads();
    bf16* WSB = (bf16*)(ws + WS_WSB + (size_t)l * SSM_W_LAYER) + (size_t)g * 256 * ASK; bf16* WSY = (bf16*)(ws + WS_WSY + (size_t)l * SSM_W_LAYER) + (size_t)g * 256 * ASK;
    for (int q = tid; q < 256 * 48; q += NWAVES * 64) { const int n = q / 48, k0 = (q % 48) * 8; float vy[8], vb[8];
        const int tl = n >> 4, c = n & 15;
        if (k0 < 256) { const int tk = k0 >> 4, ck0 = k0 & 15;
#pragma unroll
            for (int e = 0; e < 8; ++e) { float v = 0.f; if (tk <= tl) { v = Km[((tl - tk) * 16 + c) * 16 + ck0 + e]; if (tk == tl && ck0 + e == c) v += dsk[c]; } vy[e] = v; }
            if (n < 128) { const int p = n & 63; const f2 pw = P[(15 - tk) * 64 + p];
#pragma unroll
                for (int e = 0; e < 8; ++e) { const f2 bb = Bb[p * 16 + ck0 + e]; vb[e] = (n < 64) ? (pw.x * bb.x - pw.y * bb.y) : (pw.x * bb.y + pw.y * bb.x); } }
            else {
#pragma unroll
                for (int e = 0; e < 8; ++e) vb[e] = 0.f; }
        } else { const int p0 = (k0 - 256) & 63; const bool im = k0 >= 320;
#pragma unroll
            for (int e = 0; e < 8; ++e) { const f2 L = P[(tl + 1) * 64 + p0 + e], cc = Cc[c * 64 + p0 + e]; vy[e] = im ? -(cc.x * L.y + cc.y * L.x) : (cc.x * L.x - cc.y * L.y); vb[e] = 0.f; } }
        v4u oy, ob; oy.x = pk2(vy[0], vy[1]); oy.y = pk2(vy[2], vy[3]); oy.z = pk2(vy[4], vy[5]); oy.w = pk2(vy[6], vy[7]);
        ob.x = pk2(vb[0], vb[1]); ob.y = pk2(vb[2], vb[3]); ob.z = pk2(vb[4], vb[5]); ob.w = pk2(vb[6], vb[7]);
        *(v4u*)(WSY + (size_t)n * ASK + k0) = oy; *(v4u*)(WSB + (size_t)n * ASK + k0) = ob; }
    if (tid < 64) ((f2*)(ws + WS_LPOW))[(l * NGRP + g) * 64 + tid] = P[16 * 64 + tid];
    __syncthreads();
}

__device__ __forceinline__ float bperm(int lanesel, float v) { return __int_as_float(__builtin_amdgcn_ds_bpermute(lanesel << 2, __float_as_int(v))); }
template <bool FORGET, int R, bool F32IN>
__device__ __forceinline__ void norm_rows(const float* X, const bf16* XBr, bf16* XBw, const float* gvec, bf16* H, const float* win  , const float* bfg, float* LOGF, int gw, int NGW, int lane) {
    f32x4 gv[4];
#pragma unroll
    for (int j = 0; j < 4; ++j) gv[j] = *((const f32x4*)gvec + lane + 64 * j);
    f32x4 wf[4][4][2];
    if (FORGET) {
#pragma unroll
        for (int j = 0; j < 4; ++j)
#pragma unroll
            for (int e = 0; e < 4; ++e) { const int k = 256 * j + 4 * lane + e; const float* wp = win + (size_t)k * NIN + 1536;
                wf[j][e][0] = *(const f32x4*)wp * gv[j][e]; wf[j][e][1] = *(const f32x4*)(wp + 4) * gv[j][e]; }
    }
    const int hsel = 4 * (lane & 1) + 2 * ((lane >> 1) & 1) + ((lane >> 2) & 1);
    const float bfv = FORGET ? bfg[hsel] : 0.f;
    const bool b0 = lane & 1, b1 = lane & 2, b2 = lane & 4;
    for (int m0 = gw; m0 < M; m0 += NGW * R) {
        f32x4 v[R][4]; float s[R]; size_t mr[R]; bool ok[R];
#pragma unroll
        for (int r = 0; r < R; ++r) { const int m = m0 + r * NGW; ok[r] = m < M; mr[r] = (size_t)(ok[r] ? m : m0); }
        if constexpr (F32IN) {
#pragma unroll
            for (int r = 0; r < R; ++r) { const f32x4* xr = (const f32x4*)(X + mr[r] * DMOD) + lane;
#pragma unroll
                for (int j = 0; j < 4; ++j) v[r][j] = xr[64 * j]; }
#pragma unroll
            for (int r = 0; r < R; ++r) { unsigned long long* xw = (unsigned long long*)(XBw + mr[r] * DMOD) + lane;
#pragma unroll
                for (int j = 0; j < 4; ++j) { const unsigned lo = pk2(v[r][j].x, v[r][j].y), hi = pk2(v[r][j].z, v[r][j].w); if (ok[r]) xw[64 * j] = (unsigned long long)lo | ((unsigned long long)hi << 32);
                    v[r][j] = (f32x4){__uint_as_float(lo << 16), __uint_as_float(lo & 0xffff0000u), __uint_as_float(hi << 16), __uint_as_float(hi & 0xffff0000u)}; } }
        } else {
            unsigned long long w8[R][4];
#pragma unroll
            for (int r = 0; r < R; ++r) { const unsigned long long* xr = (const unsigned long long*)(XBr + mr[r] * DMOD) + lane;
#pragma unroll
                for (int j = 0; j < 4; ++j) w8[r][j] = xr[64 * j]; }
#pragma unroll
            for (int r = 0; r < R; ++r)
#pragma unroll
                for (int j = 0; j < 4; ++j) { const unsigned lo = (unsigned)w8[r][j], hi = (unsigned)(w8[r][j] >> 32);
                    v[r][j] = (f32x4){__uint_as_float(lo << 16), __uint_as_float(lo & 0xffff0000u), __uint_as_float(hi << 16), __uint_as_float(hi & 0xffff0000u)}; }
        }
#pragma unroll
        for (int r = 0; r < R; ++r) { float t = 0.f;
#pragma unroll
            for (int j = 0; j < 4; ++j) t += (v[r][j].x * v[r][j].x + v[r][j].y * v[r][j].y) + (v[r][j].z * v[r][j].z + v[r][j].w * v[r][j].w);
            s[r] = t; }
        f32x4 a0[R], a1[R];
        if (FORGET) {
#pragma unroll
            for (int r = 0; r < R; ++r) { a0[r] = (f32x4){0.f, 0.f, 0.f, 0.f}; a1[r] = (f32x4){0.f, 0.f, 0.f, 0.f};
#pragma unroll
                for (int j = 0; j < 4; ++j)
#pragma unroll
                    for (int e = 0; e < 4; ++e) { a0[r] += wf[j][e][0] * v[r][j][e]; a1[r] += wf[j][e][1] * v[r][j][e]; } }
        }
#pragma unroll
        for (int o = 1; o < 64; o <<= 1)
#pragma unroll
            for (int r = 0; r < R; ++r) s[r] += bperm(lane ^ o, s[r]);
        float rstd[R];
#pragma unroll
        for (int r = 0; r < R; ++r) { rstd[r] = 1.0f / sqrtf(s[r] * (1.f / DMOD) + RMS_EPS);
            unsigned long long* o8 = (unsigned long long*)(H + mr[r] * DMOD) + lane;
#pragma unroll
            for (int j = 0; j < 4; ++j) { const f32x4 h = v[r][j] * rstd[r] * gv[j]; if (ok[r]) o8[64 * j] = (unsigned long long)pk2(h.x, h.y) | ((unsigned long long)pk2(h.z, h.w) << 32); } }
        if (FORGET) {
            float t4[R][4], t2[R][2], w[R];
#pragma unroll
            for (int i = 0; i < 4; ++i)
#pragma unroll
                for (int r = 0; r < R; ++r) { const float snd = b0 ? a0[r][i] : a1[r][i], kp = b0 ? a1[r][i] : a0[r][i]; t4[r][i] = kp + bperm(lane ^ 1, snd); }
#pragma unroll
            for (int i = 0; i < 2; ++i)
#pragma unroll
                for (int r = 0; r < R; ++r) { const float snd = b1 ? t4[r][i] : t4[r][2 + i], kp = b1 ? t4[r][2 + i] : t4[r][i]; t2[r][i] = kp + bperm(lane ^ 2, snd); }
#pragma unroll
            for (int r = 0; r < R; ++r) w[r] = (b2 ? t2[r][1] : t2[r][0]) + bperm(lane ^ 4, b2 ? t2[r][0] : t2[r][1]);
#pragma unroll
            for (int o = 8; o < 64; o <<= 1)
#pragma unroll
                for (int r = 0; r < R; ++r) w[r] += bperm(lane ^ o, w[r]);
#pragma unroll
            for (int r = 0; r < R; ++r) if (lane < 8 && ok[r]) { const float z = w[r] * rstd[r] + bfv;
                const float ls = fminf(z, 0.f) - 0.6931471805599453f * __builtin_amdgcn_logf(1.0f + __builtin_amdgcn_exp2f(-fabsf(z) * 1.4426950408889634f));
                LOGF[mr[r] * 8 + hsel] = ls; }
        }
    }
}
template <int R>
__device__ __forceinline__ void norm_rows_final(const bf16* XBr, float* OUT, const float* gvec, int gw, int NGW, int lane) {
    f32x4 gv[4];
#pragma unroll
    for (int j = 0; j < 4; ++j) gv[j] = *((const f32x4*)gvec + lane + 64 * j);
    for (int m0 = gw; m0 < M; m0 += NGW * R) {
        f32x4 v[R][4]; float s[R];
#pragma unroll
        for (int r = 0; r < R; ++r) { const int m = m0 + r * NGW; const unsigned long long* xr = (const unsigned long long*)(XBr + (size_t)(m < M ? m : m0) * DMOD) + lane;
#pragma unroll
            for (int j = 0; j < 4; ++j) { const unsigned long long w = xr[64 * j]; const unsigned lo = (unsigned)w, hi = (unsigned)(w >> 32);
                v[r][j] = (f32x4){__uint_as_float(lo << 16), __uint_as_float(lo & 0xffff0000u), __uint_as_float(hi << 16), __uint_as_float(hi & 0xffff0000u)}; } }
#pragma unroll
        for (int r = 0; r < R; ++r) { float t = 0.f;
#pragma unroll
            for (int j = 0; j < 4; ++j) t += (v[r][j].x * v[r][j].x + v[r][j].y * v[r][j].y) + (v[r][j].z * v[r][j].z + v[r][j].w * v[r][j].w);
            s[r] = t; }
#pragma unroll
        for (int o = 1; o < 64; o <<= 1)
#pragma unroll
            for (int r = 0; r < R; ++r) s[r] += bperm(lane ^ o, s[r]);
#pragma unroll
        for (int r = 0; r < R; ++r) { const int m = m0 + r * NGW; if (m >= M) break;
            const float rstd = 1.0f / sqrtf(s[r] * (1.f / DMOD) + RMS_EPS); f32x4* xw = (f32x4*)(OUT + (size_t)m * DMOD) + lane;
#pragma unroll
            for (int j = 0; j < 4; ++j) xw[64 * j] = v[r][j] * rstd * gv[j]; }
    }
}

#define XB_TMO      128
#define XB_XCNT(j)  (256  + 64 * (j))
#define XB_XSUB(j)  (1280 + 64 * (j))
#define XB_XGEN(j)  (2304 + 64 * (j))
#define XB_TOP      3328
#define XB_TOPGEN   3392
#define XCD_BAR_WORDS 3456
#define XB_SPIN_CAP (1u << 18)

__device__ __forceinline__ unsigned xb_ld(unsigned* p)              { return __hip_atomic_load(p, __ATOMIC_RELAXED, __HIP_MEMORY_SCOPE_AGENT); }
__device__ __forceinline__ unsigned xb_add(unsigned* p, unsigned v) { return __hip_atomic_fetch_add(p, v, __ATOMIC_RELAXED, __HIP_MEMORY_SCOPE_AGENT); }
__device__ __forceinline__ unsigned xb_xcc_id() { return (unsigned)__builtin_amdgcn_s_getreg((3 << 11) | 20) & 0xFu; }
#define XB_SPIN(cond, bar) do { unsigned _sp = 0; while (cond) { __builtin_amdgcn_s_sleep(1); \
    if ((++_sp & 255u) == 0u) { if (xb_ld(&(bar)[XB_TMO])) break; if (_sp > XB_SPIN_CAP) { atomicAdd(&(bar)[XB_TMO], 1u); break; } } } } while (0)

struct XcdBarrier {
    unsigned* bar; unsigned x;
    volatile LAS unsigned* st;
};

__device__ __forceinline__ XcdBarrier xcd_barrier_post(unsigned* bar, volatile LAS unsigned* st) {
    XcdBarrier b; b.bar = bar; b.x = xb_xcc_id(); b.st = st;
    if (threadIdx.x == 0) (void)xb_add(&bar[XB_XCNT(b.x)], 1u);
    return b;
}
__device__ __forceinline__ void xcd_barrier_complete(unsigned* bar, unsigned x, unsigned& nloc, unsigned& nx) {
    const unsigned G = gridDim.x * gridDim.y * gridDim.z;
    unsigned sum, cnt, mine, sp = 0u;
    for (;;) {
        sum = 0u; cnt = 0u; mine = 0u;
#pragma unroll
        for (unsigned j = 0; j < 16; ++j) { const unsigned c = xb_ld(&bar[XB_XCNT(j)]); sum += c; cnt += (c > 0u) ? 1u : 0u; mine = (j == x) ? c : mine; }
        if (sum == G) break;
        __builtin_amdgcn_s_sleep(1);
        if ((++sp & 255u) == 0u) { if (xb_ld(&bar[XB_TMO])) break; if (sp > XB_SPIN_CAP) { atomicAdd(&bar[XB_TMO], 1u); break; } }
    }
    nloc = mine > 0u ? mine : 1u; nx = cnt > 0u ? cnt : 1u;
}

__device__ __forceinline__ void xcd_barrier(const XcdBarrier& b) {
    asm volatile("s_waitcnt vmcnt(0)" ::: "memory");
    __syncthreads();
    if (threadIdx.x == 0) {
        unsigned* bar = b.bar;
        __builtin_amdgcn_s_waitcnt(0);
        unsigned nloc = b.st[0], nx = b.st[1];
        if (nloc == 0u) { xcd_barrier_complete(bar, b.x, nloc, nx); b.st[0] = nloc; b.st[1] = nx; }
        const unsigned old = xb_add(&bar[XB_XSUB(b.x)], 1u);
        const unsigned gen = old / nloc;
        if (old + 1u == (gen + 1u) * nloc) {
            __builtin_amdgcn_fence(__ATOMIC_RELEASE, "agent");
            asm volatile("s_waitcnt vmcnt(0)" ::: "memory");
            const unsigned og = xb_add(&bar[XB_TOP], 1u);
            const unsigned tg = og / nx;
            if (og + 1u == (tg + 1u) * nx) xb_add(&bar[XB_TOPGEN], 1u);
            else XB_SPIN(xb_ld(&bar[XB_TOPGEN]) == tg, bar);
            __builtin_amdgcn_fence(__ATOMIC_ACQUIRE, "agent");
            xb_add(&bar[XB_XGEN(b.x)], 1u);
            asm volatile("s_waitcnt vmcnt(0)" ::: "memory");
        } else {
            XB_SPIN(xb_ld(&bar[XB_XGEN(b.x)]) == gen, bar);
            __builtin_amdgcn_fence(__ATOMIC_ACQUIRE, "agent");
            asm volatile("s_waitcnt vmcnt(0)" ::: "memory");
        }
    }
    __syncthreads();
}
#ifndef PHMASK
#define PHMASK 0xFFFF
#endif
#ifndef SMALLK_ALIGN
#define SMALLK_ALIGN true
#endif
#ifndef BIGK_ALIGN
#define BIGK_ALIGN true
#endif
#ifndef DUPMASK
#define DUPMASK 0
#endif
__global__ void __launch_bounds__(NWAVES * 64, 2) fwd_megakernel(Args args) {
    extern __shared__ __attribute__((aligned(16))) unsigned char lds[];
    cg::grid_group grid = cg::this_grid();
    {
        volatile LAS unsigned* misc = (volatile LAS unsigned*)((LAS unsigned char*)lds + MISC_OFF);
        if (threadIdx.x < 32) misc[threadIdx.x] = 0u;
        __syncthreads();
    }
    XcdBarrier xbar = xcd_barrier_post((unsigned*)(args.ws + WS_CTL + WS_BARW), (volatile LAS unsigned*)((LAS unsigned char*)lds + MISC_OFF) + 8);
    if (args.ws == nullptr) grid.sync();
    LAS unsigned char* L = (LAS unsigned char*)lds;
    const int G = gridDim.x, bx = blockIdx.x, NGW = G * NWAVES;
#define TID_OPAQUE() int tid_ = threadIdx.x; asm volatile("" : "+v"(tid_)); const int tid = tid_, lane = tid & 63, wave = __builtin_amdgcn_readfirstlane(tid >> 6), gw = bx * NWAVES + wave; (void)tid; (void)lane; (void)gw
    float* out = args.out;
#define GASP __attribute__((address_space(1)))
#define WS_OPAQUE() GASP unsigned char* ws = (GASP unsigned char*)args.ws; asm volatile("" : "+s"(ws))
#define WSP(T, off) ((T*)(GASP T*)(ws + (off)))
#define GRID_SYNC1() xcd_barrier(xbar)
#ifdef DUPSYNC
#define GRID_SYNC() do { GRID_SYNC1(); GRID_SYNC1(); } while (0)
#else
#define GRID_SYNC() GRID_SYNC1()
#endif
    { TID_OPAQUE(); WS_OPAQUE(); for (int it = bx; it < DEPTH * NGRP; it += G) ssm_tables(args, it >> 5, it & 31, (unsigned char*)ws, L, tid); }
    for (int l_ = 0; l_ < DEPTH; ++l_) {
        int l = l_; asm volatile("" : "+s"(l));
#if (PHMASK >> 0) & 1
        for (int rep_ = 0; rep_ < (int)((DUPMASK >> 0) & 1) + 1; ++rep_) {
        {
            TID_OPAQUE(); WS_OPAQUE(); bf16* Win_t = WSP(bf16, WS_WIN); bf16* Wup_t = WSP(bf16, WS_WUP); bf16* Wdn_t = WSP(bf16, WS_WDN); bf16* Wout_t = WSP(bf16, WS_WOUT);
            bf16* Wa_t = WSP(bf16, WS_WA); bf16* Wb_t = WSP(bf16, WS_WB); bf16* Wglu_t = WSP(bf16, WS_WGLU); bf16* H = WSP(bf16, WS_H); float* LOGF = WSP(float, WS_LOGF);
            LAS float* scr = (LAS float*)(L + wave * 16384);
            const float* w_in = args.in[2] + (size_t)l * DMOD * NIN; const float* w_glu = args.in[12] + (size_t)l * SW * SW;
            const float* w_a = args.in[14] + (size_t)l * AW * DMOD; const float* w_b = args.in[15] + (size_t)l * SW * DMOD; const float* w_out = args.in[16] + (size_t)l * DMOD * DMOD;
            const float* w_up = args.in[18] + (size_t)l * DMOD * FF; const float* w_dn = args.in[19] + (size_t)l * FF * DMOD;
            constexpr int I_IN = 16 * 128, I_GLU = 8 * 16, I_A = 8 * 32, I_B = 8 * 32, I_OUT = 16 * 32, I_UP = 16 * 128, I_DN = 64 * 32;
            constexpr int NITEMS = I_IN + I_GLU + I_A + I_B + I_OUT + I_UP + I_DN;
            for (int it = gw; it < NITEMS; it += NGW) {
                int r = it;
                if (r < I_IN) { const int nb = r % 128; const int sc0 = (nb >= 48) ? 8 : 0;
                    transpose_item(w_in, NIN, DMOD, 128, Win_t, 0, sc0, scr, r, lane); continue; } r -= I_IN;
                if (r < I_GLU) { transpose_item(w_glu, SW, SW, 16, Wglu_t, 0, 0, scr, r, lane); continue; } r -= I_GLU;
                if (r < I_A) { transpose_item(w_a, DMOD, AW, 32, Wa_t, 0, 0, scr, r, lane); continue; } r -= I_A;
                if (r < I_B) { transpose_item(w_b, DMOD, SW, 32, Wb_t, 0, 0, scr, r, lane); continue; } r -= I_B;
                if (r < I_OUT) { transpose_item(w_out, DMOD, DMOD, 32, Wout_t, 0, 0, scr, r, lane); continue; } r -= I_OUT;
                if (r < I_UP) { transpose_item(w_up, FF, DMOD, 128, Wup_t, 0, 0, scr, r, lane); continue; } r -= I_UP;
                transpose_item(w_dn, DMOD, FF, 32, Wdn_t, 0, 0, scr, r, lane);
            }
            if (l == 0) norm_rows<true, 2, true>(args.in[0], nullptr, WSP(bf16, WS_XB), args.in[1] + (size_t)l * DMOD, H, w_in, args.in[3] + (size_t)l * NHEADS, LOGF, gw, NGW, lane);
            else norm_rows<true, 2, false>(nullptr, WSP(bf16, WS_XB), nullptr, args.in[1] + (size_t)l * DMOD, H, w_in, args.in[3] + (size_t)l * NHEADS, LOGF, gw, NGW, lane);
        }
        }
#endif
        GRID_SYNC();
#if (PHMASK >> 1) & 1
        for (int rep_ = 0; rep_ < (int)((DUPMASK >> 1) & 1) + 1; ++rep_) {
        {
            WS_OPAQUE(); bf16* H = WSP(bf16, WS_H); bf16* Win_t = WSP(bf16, WS_WIN); bf16* Qb = WSP(bf16, WS_Q); bf16* AS = WSP(bf16, WS_AS); bf16* GA = WSP(bf16, WS_GA);
            static_assert(WS_V - WS_K == WS_K - WS_Q, "Q|K|V equally spaced");
            pg8::Gemm g{H, Win_t, M, 4096, DMOD}; pg8::StaticOrder S; S.init(M, 4096, G, bx);
            pg8::EpiInProj E{Qb, AS, GA, (size_t)(WS_K - WS_Q) / 2, (size_t)(WS_GB - WS_GA) / 2};
            pg8::gemm_phase<pg8::EpiInProj, pg8::StaticOrder, BIGK_ALIGN, true>(L, g, S, E);
        }
        }
#endif
        GRID_SYNC();
#if (PHMASK >> 2) & 1
        for (int rep_ = 0; rep_ < (int)((DUPMASK >> 2) & 1) + 1; ++rep_) {
        {
            WS_OPAQUE(); bf16* AS = WSP(bf16, WS_AS); bf16* WSB_t = WSP(bf16, WS_WSB + (size_t)l * SSM_W_LAYER); float* SLOC = WSP(float, WS_SLOC);
            pg8::Gemm g{AS, WSB_t, NGRP * NCR, NGRP * 256, 256, ASK}; pg8::SsmOrder S{G, bx};
            pg8::EpiSsmState E{SLOC};
            pg8::gemm_phase<pg8::EpiSsmState, pg8::SsmOrder, SMALLK_ALIGN, true>(L, g, S, E);
        }
        }
#endif
#if (PHMASK >> 3) & 1
        for (int rep_ = 0; rep_ < (int)((DUPMASK >> 3) & 1) + 1; ++rep_) {
        {
            typedef float f2 __attribute__((ext_vector_type(2)));
            TID_OPAQUE(); WS_OPAQUE(); bf16* AS = WSP(bf16, WS_AS); float* SLOC = WSP(float, WS_SLOC); float* LOGF = WSP(float, WS_LOGF); float* BIAS = WSP(float, WS_BIAS);
            if ((wave & 1) == 0) {
                for (int i = 0; i * G + bx < NGRP * BATCH; ++i) { if (wave != ((2 * i) & 7)) continue; const int it = i * G + bx; const int g = it >> 4, b = it & 15;
                    const f2 l16 = WSP(const f2, WS_LPOW)[(l * NGRP + g) * 64 + lane];
                    const float* sl = SLOC + ((size_t)(g * NCR + b * 256)) * 128 + lane; bf16* as = AS + ((size_t)(g * NCR + b * 256)) * ASK + 256 + lane;
                    float sr = 0.f, si = 0.f;
                    for (int ch0 = 0; ch0 < 256; ch0 += 32) {
                        float ar[32], ai[32];
#pragma unroll
                        for (int i = 0; i < 32; ++i) { ar[i] = sl[(size_t)(ch0 + i) * 128]; ai[i] = sl[(size_t)(ch0 + i) * 128 + 64]; }
#pragma unroll
                        for (int i = 0; i < 32; ++i) { as[(size_t)(ch0 + i) * ASK] = (bf16)f2bf(sr); as[(size_t)(ch0 + i) * ASK + 64] = (bf16)f2bf(si);
                            const float nr = l16.x * sr - l16.y * si + ar[i], ni = l16.x * si + l16.y * sr + ai[i]; sr = nr; si = ni; } } }
            } else if ((gw & 3) == 1) {
                for (int sq = gw >> 2; sq < BATCH * NHEADS; sq += NGW >> 2) { const int b = sq >> 3, h = sq & 7;
                    const float* lf = LOGF + ((size_t)b * SEQ + lane * 64) * 8 + h; float tot = 0.f; float vals[64];
#pragma unroll
                    for (int i = 0; i < 64; ++i) vals[i] = lf[i * 8];
#pragma unroll
                    for (int i = 0; i < 64; ++i) tot += vals[i];
                    float incl = tot;
#pragma unroll
                    for (int o = 1; o < 64; o <<= 1) { const float t = __int_as_float(__builtin_amdgcn_ds_bpermute((lane - o) << 2, __float_as_int(incl))); if (lane >= o) incl += t; }
                    float run = incl - tot; float* bo = BIAS + (size_t)sq * SEQ + lane * 64;
#pragma unroll
                    for (int i = 0; i < 64; ++i) { run += vals[i]; bo[i] = -run * 1.4426950408889634f; } }
            }
        }
        }
#endif
        GRID_SYNC();
#if (PHMASK >> 4) & 1
        for (int rep_ = 0; rep_ < (int)((DUPMASK >> 4) & 1) + 1; ++rep_) {
        {
            WS_OPAQUE(); bf16* AS = WSP(bf16, WS_AS); bf16* WSY_t = WSP(bf16, WS_WSY + (size_t)l * SSM_W_LAYER); bf16* YB = WSP(bf16, WS_YB);
            pg8::Gemm g{AS, WSY_t, NGRP * NCR, NGRP * 256, ASK}; pg8::SsmOrder S{G, bx};
            pg8::EpiSsmY E{YB};
            pg8::gemm_phase<pg8::EpiSsmY, pg8::SsmOrder, SMALLK_ALIGN, true>(L, g, S, E);
        }
        {
            WS_OPAQUE(); bf16* Qb = WSP(bf16, WS_Q); bf16* Kb = WSP(bf16, WS_K); bf16* Vb = WSP(bf16, WS_V); float* BIAS = WSP(float, WS_BIAS);
            const attn_body::AttnTensors AT{(const attn_body::bf16*)Qb, (const attn_body::bf16*)Kb, (const attn_body::bf16*)Vb, (attn_body::bf16*)WSP(bf16, WS_H), BIAS};
            const attn_body::StaticOrder S(G, bx);
#ifndef NO_ATTN
            attn_body::attn_phase<attn_body::StaticOrder>((char*)lds, AT, S);
        }
#endif
        }
#endif
        GRID_SYNC();
#if (PHMASK >> 5) & 1
        for (int rep_ = 0; rep_ < (int)((DUPMASK >> 5) & 1) + 1; ++rep_) {
        {
            WS_OPAQUE(); bf16* YB = WSP(bf16, WS_YB); bf16* YB2 = WSP(bf16, WS_YB2); bf16* Wglu_t = WSP(bf16, WS_WGLU);
            pg8::Gemm g{YB, Wglu_t, M, SW, SW}; pg8::StaticOrder S; S.init(M, SW, G, bx);
            pg8::EpiGlu E{YB, YB2, args.in[13] + (size_t)l * SW};
            pg8::gemm_phase<pg8::EpiGlu, pg8::StaticOrder, SMALLK_ALIGN, true>(L, g, S, E);
        }
        }
#endif
#if (PHMASK >> 6) & 1
        for (int rep_ = 0; rep_ < (int)((DUPMASK >> 6) & 1) + 1; ++rep_) {
        {
            WS_OPAQUE(); bf16* Qb = WSP(bf16, WS_H)  ; bf16* Wa_t = WSP(bf16, WS_WA); bf16* GA = WSP(bf16, WS_GA); bf16* MIXED = WSP(bf16, WS_K)  ;
            pg8::Gemm g{Qb, Wa_t, M, DMOD, AW}; pg8::StaticOrder S; S.init(M, DMOD, G, bx);
            pg8::EpiGate<false> E{GA, MIXED};
            pg8::gemm_phase<pg8::EpiGate<false>, pg8::StaticOrder, SMALLK_ALIGN, true>(L, g, S, E);
        }
        }
#endif
        GRID_SYNC();
#if (PHMASK >> 7) & 1
        for (int rep_ = 0; rep_ < (int)((DUPMASK >> 7) & 1) + 1; ++rep_) {
        {
            WS_OPAQUE(); bf16* YB2 = WSP(bf16, WS_YB2); bf16* Wb_t = WSP(bf16, WS_WB); bf16* GB = WSP(bf16, WS_GB); bf16* MIXED = WSP(bf16, WS_K);
            pg8::Gemm g{YB2, Wb_t, M, DMOD, SW}; pg8::StaticOrder S; S.init(M, DMOD, G, bx);
            pg8::EpiGate<true> E{GB, rep_ ? WSP(bf16, WS_H) : MIXED};
            pg8::gemm_phase<pg8::EpiGate<true>, pg8::StaticOrder, SMALLK_ALIGN, true>(L, g, S, E);
        }
        }
#endif
        GRID_SYNC();
#if (PHMASK >> 8) & 1
        for (int rep_ = 0; rep_ < (int)((DUPMASK >> 8) & 1) + 1; ++rep_) {
        {
            WS_OPAQUE(); bf16* MIXED = WSP(bf16, WS_K); bf16* Wout_t = WSP(bf16, WS_WOUT);
            pg8::Gemm g{MIXED, Wout_t, M, DMOD, DMOD}; pg8::StaticOrder S; S.init(M, DMOD, G, bx);
            pg8::EpiResid E{rep_ ? WSP(bf16, WS_H) : WSP(bf16, WS_XB)};
            pg8::gemm_phase<pg8::EpiResid, pg8::StaticOrder, BIGK_ALIGN, true>(L, g, S, E);
        }
        }
#endif
        GRID_SYNC();
#if (PHMASK >> 9) & 1
        for (int rep_ = 0; rep_ < (int)((DUPMASK >> 9) & 1) + 1; ++rep_) {
        { TID_OPAQUE(); WS_OPAQUE(); norm_rows<false, 4, false>(nullptr, WSP(bf16, WS_XB), nullptr, args.in[17] + (size_t)l * DMOD, WSP(bf16, WS_H), nullptr, nullptr, nullptr, gw, NGW, lane); }
        }
#endif
        GRID_SYNC();
#if (PHMASK >> 10) & 1
        for (int rep_ = 0; rep_ < (int)((DUPMASK >> 10) & 1) + 1; ++rep_) {
        {
            WS_OPAQUE(); bf16* H = WSP(bf16, WS_H); bf16* Wup_t = WSP(bf16, WS_WUP); bf16* HID = WSP(bf16, WS_HID);
            pg8::Gemm g{H, Wup_t, M, FF, DMOD}; pg8::StaticOrder S; S.init(M, FF, G, bx);
            pg8::EpiRelu2 E{HID};
            pg8::gemm_phase<pg8::EpiRelu2, pg8::StaticOrder, BIGK_ALIGN, true>(L, g, S, E);
        }
        }
#endif
        GRID_SYNC();
#if (PHMASK >> 11) & 1
        for (int rep_ = 0; rep_ < (int)((DUPMASK >> 11) & 1) + 1; ++rep_) {
        {
            WS_OPAQUE(); bf16* HID = WSP(bf16, WS_HID); bf16* Wdn_t = WSP(bf16, WS_WDN);
            pg8::Gemm g{HID, Wdn_t, M, DMOD, FF}; pg8::StaticOrder S; S.init(M, DMOD, G, bx);
            pg8::EpiResid E{rep_ ? WSP(bf16, WS_H) : WSP(bf16, WS_XB)};
            pg8::gemm_phase<pg8::EpiResid, pg8::StaticOrder, BIGK_ALIGN, true>(L, g, S, E);
        }
        }
#endif
        GRID_SYNC();
    }
    { TID_OPAQUE(); WS_OPAQUE(); norm_rows_final<4>(WSP(bf16, WS_XB), out, args.in[20], gw, NGW, lane); }
}

extern "C" void kernel_launch(void* const* d_in, const int* in_sizes, int n_in, void* d_out, int out_size, void* d_ws, size_t ws_size, hipStream_t stream) {
    static int grid = 0;
    if (grid == 0) {
        if (n_in != 21 || in_sizes[0] != M * DMOD || out_size != M * DMOD || ws_size < WS_END) {
            fprintf(stderr, "kernel_launch: unexpected shapes: n_in %d in0 %d out %d ws %zu (need %zu)\n", n_in, n_in > 0 ? in_sizes[0] : -1, out_size, ws_size, (size_t)WS_END); grid = -1; return; }
        int dev = 0, cus = 0, per_cu = 0;
        hipGetDevice(&dev); hipDeviceGetAttribute(&cus, hipDeviceAttributeMultiprocessorCount, dev);
        if (hipFuncSetAttribute((const void*)fwd_megakernel, hipFuncAttributeMaxDynamicSharedMemorySize, LDS_BYTES) != hipSuccess) { fprintf(stderr, "kernel_launch: hipFuncSetAttribute failed\n"); grid = -1; return; }
        if (hipOccupancyMaxActiveBlocksPerMultiprocessor(&per_cu, (const void*)fwd_megakernel, NWAVES * 64, LDS_BYTES) != hipSuccess || per_cu < 1) per_cu = 1;
        (void)hipGetLastError();
        grid = cus * per_cu;
    }
    if (grid < 0) return;
    if (hipMemsetAsync((char*)d_ws + WS_CTL, 0, CTL_ZERO_BYTES, stream) != hipSuccess) { fprintf(stderr, "kernel_launch: hipMemsetAsync failed\n"); return; }
    Args a{};
    for (int i = 0; i < 21; ++i) a.in[i] = (const float*)d_in[i];
    a.out = (float*)d_out; a.ws = (unsigned char*)d_ws;
    void* kargs[] = {&a};
    hipError_t e = hipLaunchCooperativeKernel((const void*)fwd_megakernel, dim3(grid), dim3(NWAVES * 64), kargs, LDS_BYTES, stream);
    if (e != hipSuccess) fprintf(stderr, "cooperative launch failed: %s (grid %d)\n", hipGetErrorString(e), grid);
}
```
